# Optimizing an MI355X kernel written in HIP

```python
import math
import jax, jax.numpy as jnp
from jax import lax
import numpy as np

D_MODEL = 1024
BATCH = 8
SEQ = 2048
DEPTH = 1
DEC_BATCH = 128
DEC_SEQ = 1
PAST_LEN = 8192
PAGE_SIZE = 128

GDN_HEADS = 8
GDN_DK = 128
GDN_DV = 128
GDN_CONV = 4
GDN_CHUNK = 64
GDN_QK = GDN_HEADS * GDN_DK
GDN_V = GDN_HEADS * GDN_DV
GDN_CONV_CH = 2 * GDN_QK + GDN_V
SWA_Q_HEADS = 16
SWA_KV_HEADS = 4
SWA_GROUP = SWA_Q_HEADS // SWA_KV_HEADS
SWA_HD = 64
SWA_Q = SWA_Q_HEADS * SWA_HD
SWA_KV = SWA_KV_HEADS * SWA_HD
WINDOW = 128
D_FF = 2816
FFN_CONV = 3
IN_WIDTHS = (GDN_CONV_CH, GDN_V, GDN_HEADS, GDN_HEADS, SWA_Q, SWA_KV, SWA_KV, D_MODEL, D_MODEL)
IN_WIDTH = GDN_CONV_CH + GDN_V + 2 * GDN_HEADS + SWA_Q + 2 * SWA_KV + 2 * D_MODEL
EPS = 1e-6

kernel_name = "hybrid_gdn_swa_convffn_adaln_step"


def _rmsnorm(x, w):
    xf = x.astype(jnp.float32)
    y = xf * lax.rsqrt(jnp.mean(xf * xf, axis=-1, keepdims=True) + EPS)
    return (y * w.astype(jnp.float32)).astype(x.dtype)


def _l2norm(x):
    return x * lax.rsqrt(jnp.sum(x * x, axis=-1, keepdims=True) + EPS)


def _adaln(c, w_mod, b_mod):
    m = jax.nn.silu(c) @ w_mod + b_mod
    return jnp.split(m[:, None, :], 6, axis=-1)


def _split_in(z):
    parts, o = [], 0
    for w_ in IN_WIDTHS:
        parts.append(z[..., o:o + w_])
        o += w_
    return parts


def _causal_dwconv(x_ext, w, n_out):
    width = w.shape[0]
    return sum(w[j] * x_ext[:, j:j + n_out] for j in range(width))


def _gdn_features(qkv_conv, beta_raw, a_raw, a_log, dt_bias):
    f32 = jnp.float32
    B_, L = qkv_conv.shape[:2]
    act = jax.nn.silu(qkv_conv).astype(f32)
    q = act[..., :GDN_QK].reshape(B_, L, GDN_HEADS, GDN_DK)
    k = act[..., GDN_QK:2 * GDN_QK].reshape(B_, L, GDN_HEADS, GDN_DK)
    v = act[..., 2 * GDN_QK:].reshape(B_, L, GDN_HEADS, GDN_DV)
    q = _l2norm(q) * (GDN_DK ** -0.5)
    k = _l2norm(k)
    beta = jax.nn.sigmoid(beta_raw.astype(f32))
    g = -jnp.exp(a_log.astype(f32)) * jax.nn.softplus(a_raw.astype(f32) + dt_bias.astype(f32))
    return q, k, v, beta, g


def _gdn_chunked(q, k, v, beta, g):
    f32 = jnp.float32
    B_, L = q.shape[:2]
    C = GDN_CHUNK
    N = L // C

    def blk(t):
        return jnp.moveaxis(t.reshape((B_, N, C) + t.shape[2:]), 3, 1)

    q, k, v, beta, g = blk(q), blk(k), blk(v), blk(beta), blk(g)
    decay = jnp.cumsum(g, axis=-1)
    idx = jnp.arange(C)
    tril = idx[:, None] >= idx[None, :]
    strict = idx[:, None] > idx[None, :]
    diff = decay[..., :, None] - decay[..., None, :]
    gam = jnp.where(tril, jnp.exp(jnp.where(tril, diff, 0.0)), 0.0)
    kb = k * beta[..., None]
    m = jnp.where(strict, jnp.einsum('bhnik,bhnjk->bhnij', kb, k) * gam, 0.0)
    eye = jnp.eye(C, dtype=f32)
    t_inv = lax.linalg.triangular_solve(eye + m, jnp.broadcast_to(eye, m.shape),
                                        left_side=True, lower=True, unit_diagonal=True)
    u = jnp.einsum('bhnij,bhnjv->bhniv', t_inv, v * beta[..., None])
    w = jnp.einsum('bhnij,bhnjk->bhnik', t_inv, kb * jnp.exp(decay)[..., None])
    a_intra = jnp.where(tril, jnp.einsum('bhnik,bhnjk->bhnij', q, k) * gam, 0.0)
    q_dec = q * jnp.exp(decay)[..., None]
    k_dec = k * jnp.exp(decay[..., -1:] - decay)[..., None]
    last = jnp.exp(decay[..., -1])
    xs = tuple(jnp.moveaxis(t, 2, 0) for t in (u, w, a_intra, q_dec, k_dec, last))

    def step(S, inp):
        u_n, w_n, a_n, qd_n, kd_n, last_n = inp
        v_new = u_n - jnp.einsum('bhck,bhkv->bhcv', w_n, S)
        o = jnp.einsum('bhck,bhkv->bhcv', qd_n, S) + jnp.einsum('bhij,bhjv->bhiv', a_n, v_new)
        S = S * last_n[..., None, None] + jnp.einsum('bhck,bhcv->bhkv', kd_n, v_new)
        return S, o

    S0 = jnp.zeros((B_, GDN_HEADS, GDN_DK, GDN_DV), f32)
    S, o = lax.scan(step, S0, xs)
    o = jnp.transpose(o, (1, 0, 3, 2, 4)).reshape(B_, L, GDN_HEADS, GDN_DV)
    return o, S


def _gdn_recurrent(q, k, v, beta, g, S0):
    xs = tuple(jnp.moveaxis(t, 1, 0) for t in (q, k, v, beta, g))

    def step(S, inp):
        q_t, k_t, v_t, b_t, g_t = inp
        S = S * jnp.exp(g_t)[..., None, None]
        delta = (v_t - jnp.einsum('bhk,bhkv->bhv', k_t, S)) * b_t[..., None]
        S = S + jnp.einsum('bhk,bhv->bhkv', k_t, delta)
        return S, jnp.einsum('bhk,bhkv->bhv', q_t, S)

    S, o = lax.scan(step, S0.astype(jnp.float32), xs)
    return jnp.moveaxis(o, 0, 1), S


def _gdn_out(o, gate, w):
    B_, L = o.shape[:2]
    on = o * lax.rsqrt(jnp.mean(o * o, axis=-1, keepdims=True) + EPS) * w.astype(jnp.float32)
    gf = jax.nn.silu(gate.astype(jnp.float32)).reshape(B_, L, GDN_HEADS, GDN_DV)
    return (on * gf).reshape(B_, L, GDN_V).astype(gate.dtype)


def _sink_attention(qg, kb, vb, mask, sinks):
    s = jnp.einsum('...qhgd,...khd->...hgqk', qg, kb).astype(jnp.float32) * (SWA_HD ** -0.5)
    s = jnp.where(mask, s, -jnp.inf)
    sink = jnp.broadcast_to(sinks.astype(jnp.float32).reshape(SWA_KV_HEADS, SWA_GROUP, 1, 1),
                            s.shape[:-1] + (1,))
    p = jax.nn.softmax(jnp.concatenate([s, sink], axis=-1), axis=-1)[..., :-1]
    return jnp.einsum('...hgqk,...khd->...qhgd', p.astype(vb.dtype), vb)


def _swa_banded(qg, k, v, sinks):
    B_, L = qg.shape[:2]
    nb = L // WINDOW
    qb = qg.reshape(B_, nb, WINDOW, SWA_KV_HEADS, SWA_GROUP, SWA_HD)

    def band(t):
        tp = jnp.concatenate([jnp.zeros_like(t[:, :WINDOW]), t], axis=1)
        tp = tp.reshape(B_, nb + 1, WINDOW, SWA_KV_HEADS, SWA_HD)
        return jnp.concatenate([tp[:, :-1], tp[:, 1:]], axis=2)

    blocks = jnp.arange(nb)[:, None]
    qabs = blocks * WINDOW + jnp.arange(WINDOW)[None, :]
    kabs = (blocks - 1) * WINDOW + jnp.arange(2 * WINDOW)[None, :]
    d = qabs[:, :, None] - kabs[:, None, :]
    mask = (d >= 0) & (d < WINDOW) & (kabs[:, None, :] >= 0)
    o = _sink_attention(qb, band(k), band(v), mask[None, :, None, None], sinks)
    return o.reshape(B_, L, SWA_Q)


def _layer(x, c, lp, st):
    B_, L, _ = x.shape
    sh1, sc1, gt1, sh2, sc2, gt2 = _adaln(c, lp['w_mod'], lp['b_mod'])
    h = _rmsnorm(x, lp['norm1_w']) * (1 + sc1) + sh1
    qkv, gdn_gate, beta_raw, a_raw, sq, sk, sv, ga, gb = _split_in(h @ lp['w_in'])

    if st is None:
        conv_prev = jnp.zeros((B_, GDN_CONV - 1, GDN_CONV_CH), qkv.dtype)
    else:
        conv_prev = st['gdn_conv'].astype(qkv.dtype)
    qkv_ext = jnp.concatenate([conv_prev, qkv], axis=1)
    new_gdn_conv = qkv_ext[:, -(GDN_CONV - 1):]
    q, k, v, beta, g = _gdn_features(_causal_dwconv(qkv_ext, lp['gdn_conv_w'], L),
                                     beta_raw, a_raw, lp['gdn_a_log'], lp['gdn_dt_bias'])
    if st is None:
        o_a, S = _gdn_chunked(q, k, v, beta, g)
    else:
        o_a, S = _gdn_recurrent(q, k, v, beta, g, st['gdn_S'])
    y_a = _gdn_out(o_a, gdn_gate, lp['gdn_onorm_w']) @ lp['w_gdn_out']

    qg = sq.reshape(B_, L, SWA_KV_HEADS, SWA_GROUP, SWA_HD)
    kk = sk.reshape(B_, L, SWA_KV_HEADS, SWA_HD)
    vv = sv.reshape(B_, L, SWA_KV_HEADS, SWA_HD)
    if st is None:
        o_b = _swa_banded(qg, kk, vv, lp['swa_sinks'])
        new_k, new_v = kk[:, -WINDOW:], vv[:, -WINDOW:]
    else:
        kc = jnp.concatenate([st['k'].astype(kk.dtype), kk], axis=1)
        vc = jnp.concatenate([st['v'].astype(vv.dtype), vv], axis=1)
        qpos = WINDOW + jnp.arange(L)
        kpos = jnp.arange(WINDOW + L)
        d = qpos[:, None] - kpos[None, :]
        mask = (d >= 0) & (d < WINDOW)
        o_b = _sink_attention(qg, kc, vc, mask[None, None, None], lp['swa_sinks']).reshape(B_, L, SWA_Q)
        new_k, new_v = kc[:, -WINDOW:], vc[:, -WINDOW:]
    y_b = o_b @ lp['w_swa_out']

    mix = (jax.nn.sigmoid(ga) * y_a + jax.nn.sigmoid(gb) * y_b) @ lp['w_o']
    x = x + gt1 * mix

    h2 = _rmsnorm(x, lp['norm2_w']) * (1 + sc2) + sh2
    gate = h2 @ lp['w_ffn_gate']
    up = h2 @ lp['w_ffn_up']
    if st is None:
        ffn_prev = jnp.zeros((B_, FFN_CONV - 1, D_FF), gate.dtype)
    else:
        ffn_prev = st['ffn_conv'].astype(gate.dtype)
    gate_ext = jnp.concatenate([ffn_prev, gate], axis=1)
    new_ffn_conv = gate_ext[:, -(FFN_CONV - 1):]
    gc = _causal_dwconv(gate_ext, lp['ffn_conv_w'], L) + lp['ffn_conv_b']
    x = x + gt2 * ((jax.nn.silu(gc) * up) @ lp['w_ffn_down'])
    return x, (S.astype(x.dtype), new_gdn_conv, new_k, new_v, new_ffn_conv)


def setup_inputs(seed: int = 0) -> dict:
    key = jax.random.key(seed)
    ks = jax.random.split(key, 32)
    f32 = jnp.float32
    D = D_MODEL

    def nrm(k, shape, s=1.0):
        return jax.random.normal(k, shape, f32) * s

    dt = jnp.exp(jax.random.uniform(ks[12], (DEPTH, GDN_HEADS), f32, math.log(1e-3), math.log(1e-1)))
    return {
        'x_prompt': nrm(ks[0], (BATCH, SEQ, D)),
        'x_sample': nrm(ks[1], (DEC_BATCH, DEC_SEQ, D)),
        'c_prompt': nrm(ks[2], (BATCH, D)),
        'c_sample': nrm(ks[3], (DEC_BATCH, D)),
        'state_gdn_S': nrm(ks[4], (DEPTH, DEC_BATCH, GDN_HEADS, GDN_DK, GDN_DV), 0.1),
        'state_gdn_conv': nrm(ks[5], (DEPTH, DEC_BATCH, GDN_CONV - 1, GDN_CONV_CH)),
        'cache_swa_k': nrm(ks[6], (DEPTH, DEC_BATCH, WINDOW, SWA_KV_HEADS, SWA_HD)),
        'cache_swa_v': nrm(ks[7], (DEPTH, DEC_BATCH, WINDOW, SWA_KV_HEADS, SWA_HD)),
        'state_ffn_conv': nrm(ks[8], (DEPTH, DEC_BATCH, FFN_CONV - 1, D_FF)),
        'w_mod': nrm(ks[9], (DEPTH, D, 6 * D), 0.5 * D ** -0.5),
        'b_mod': nrm(ks[10], (DEPTH, 6 * D), 0.02),
        'norm1_w': 1.0 + nrm(ks[11], (DEPTH, D), 0.05),
        'norm2_w': 1.0 + nrm(ks[13], (DEPTH, D), 0.05),
        'w_in': nrm(ks[14], (DEPTH, D, IN_WIDTH), D ** -0.5),
        'gdn_conv_w': nrm(ks[15], (DEPTH, GDN_CONV, GDN_CONV_CH), GDN_CONV ** -0.5),
        'gdn_a_log': jnp.log(jax.random.uniform(ks[16], (DEPTH, GDN_HEADS), f32, 1.0, 16.0)),
        'gdn_dt_bias': dt + jnp.log(-jnp.expm1(-dt)),
        'gdn_onorm_w': 1.0 + nrm(ks[17], (DEPTH, GDN_DV), 0.05),
        'w_gdn_out': nrm(ks[18], (DEPTH, GDN_V, D), GDN_V ** -0.5),
        'swa_sinks': nrm(ks[19], (DEPTH, SWA_Q_HEADS)),
        'w_swa_out': nrm(ks[20], (DEPTH, SWA_Q, D), SWA_Q ** -0.5),
        'w_o': nrm(ks[21], (DEPTH, D, D), D ** -0.5),
        'w_ffn_gate': nrm(ks[22], (DEPTH, D, D_FF), D ** -0.5),
        'w_ffn_up': nrm(ks[23], (DEPTH, D, D_FF), D ** -0.5),
        'ffn_conv_w': nrm(ks[24], (DEPTH, FFN_CONV, D_FF), FFN_CONV ** -0.5),
        'ffn_conv_b': nrm(ks[25], (DEPTH, D_FF), 0.02),
        'w_ffn_down': nrm(ks[26], (DEPTH, D_FF, D), D_FF ** -0.5),
        'final_norm_w': 1.0 + nrm(ks[27], (D,), 0.05),
    }


def reference(x_prompt, x_sample, c_prompt, c_sample, state_gdn_S, state_gdn_conv, cache_swa_k,
              cache_swa_v, state_ffn_conv, w_mod, b_mod, norm1_w, norm2_w, w_in, gdn_conv_w,
              gdn_a_log, gdn_dt_bias, gdn_onorm_w, w_gdn_out, swa_sinks, w_swa_out, w_o,
              w_ffn_gate, w_ffn_up, ffn_conv_w, ffn_conv_b, w_ffn_down, final_norm_w):
    xp, xs = x_prompt, x_sample
    new_p = [[] for _ in range(5)]
    new_s = [[] for _ in range(5)]
    for l in range(DEPTH):
        lp = dict(w_mod=w_mod[l], b_mod=b_mod[l], norm1_w=norm1_w[l], norm2_w=norm2_w[l],
                  w_in=w_in[l], gdn_conv_w=gdn_conv_w[l], gdn_a_log=gdn_a_log[l],
                  gdn_dt_bias=gdn_dt_bias[l], gdn_onorm_w=gdn_onorm_w[l], w_gdn_out=w_gdn_out[l],
                  swa_sinks=swa_sinks[l], w_swa_out=w_swa_out[l], w_o=w_o[l],
                  w_ffn_gate=w_ffn_gate[l], w_ffn_up=w_ffn_up[l], ffn_conv_w=ffn_conv_w[l],
                  ffn_conv_b=ffn_conv_b[l], w_ffn_down=w_ffn_down[l])
        st = dict(gdn_S=state_gdn_S[l], gdn_conv=state_gdn_conv[l], k=cache_swa_k[l],
                  v=cache_swa_v[l], ffn_conv=state_ffn_conv[l])
        xp, sp = _layer(xp, c_prompt, lp, None)
        xs, ss = _layer(xs, c_sample, lp, st)
        for i in range(5):
            new_p[i].append(sp[i])
            new_s[i].append(ss[i])
    y_prompt = _rmsnorm(xp, final_norm_w)
    y_sample = _rmsnorm(xs, final_norm_w)
    gS_p, gc_p, k_p, v_p, f_p = [jnp.stack(a) for a in new_p]
    gS_s, gc_s, k_s, v_s, f_s = [jnp.stack(a) for a in new_s]
    return (y_prompt, y_sample, gS_p, gS_s, gc_p, gc_s, k_p, k_s, v_p, v_s, f_p, f_s)
```

```cpp
#include <hip/hip_runtime.h>
#include <hip/hip_cooperative_groups.h>
#include <cstdio>
namespace cg = cooperative_groups;
__device__ __forceinline__ int otid() { int t = threadIdx.x; asm volatile("" : "+v"(t)); return t; }
namespace pg8 {
#define PG8_LAS __attribute__((address_space(3)))
typedef unsigned short bf16_t;
typedef short bf16x8 __attribute__((ext_vector_type(8)));
typedef float f32x4 __attribute__((ext_vector_type(4)));
typedef unsigned u32x4 __attribute__((ext_vector_type(4)));
constexpr int BM = 256, BK = 64, HALF = 128, HTB = HALF * BK * 2  , STAGE_BYTES = 8 * HTB, NXCD = 8, WGM = 8;

__host__ __device__ __forceinline__ int lds_byte(int r, int c) { const int st = (r >> 4) * 2 + (c >> 5), rr = r & 15, cc = c & 31, ob = rr * 64 + cc * 2; return st * 1024 + (ob ^ (((ob >> 9) & 1) << 5)); }
__host__ __device__ __forceinline__ void stage_rc(int b, int& R, int& C) { const int st = b / 1024, sb = b % 1024, swz = sb ^ (((sb >> 9) & 1) << 5); R = (st >> 1) * 16 + swz / 64; C = (st & 1) * 32 + (swz % 64) / 2; }
__host__ __device__ __forceinline__ int perm32(int rho) { const int n = rho >> 4, i = rho & 15; return 8 * (i >> 2) + 4 * n + (i & 3); }

struct Unit { int pm, pn; };
struct Gemm { const bf16_t* A; const bf16_t* Bt; int M, N, K, lda, ldb; };

struct StaticOrder {
    int nM, nN, nwg, G, c;
    __host__ __device__ void init(int M, int N, int G_, int c_) { nM = M / BM; nN = N / BM; nwg = nM * nN; G = G_; c = c_; }
    __host__ __device__ bool next(int i, Unit& u) const {
        const long L = (long)i * G + c; if (L >= nwg) return false;
        int wgid = (int)L; { const int q = nwg / NXCD, r = nwg % NXCD, xcd = wgid % NXCD, off = wgid / NXCD; wgid = (xcd < r ? xcd * (q + 1) : r * (q + 1) + (xcd - r) * q) + off; }
        const int nig = WGM * nN, gid = wgid / nig, fm = gid * WGM, gsz = (nM - fm) < WGM ? (nM - fm) : WGM;
        u.pm = fm + ((wgid % nig) % gsz); u.pn = (wgid % nig) / gsz; return true;
    }
    __device__ __forceinline__ void a_ready(const Unit&) const {}
    __device__ __forceinline__ void done(const Unit&) const {}
};

template <class Epi, class Sched, bool STAMP = false>
__device__ __forceinline__ void gemm_phase(PG8_LAS unsigned char* lds, const Gemm g, const Sched& S, const Epi& E, unsigned long long* stamps) {
    const int tid = otid(), wid = __builtin_amdgcn_readfirstlane(tid >> 6), lane = tid & 63, wr = wid >> 2, wc = wid & 3, fr = lane & 15, fq = lane >> 4;
    const int K = g.K, nt = K / BK;
    int ts_lo = 0, ts_hi = 0, nts = 0; const unsigned long long rt_entry = STAMP ? (unsigned long long)wall_clock64() : 0ull;
#define PG8_STAMP() do { if (STAMP && wid == 0 && nts < 64) { const unsigned long long _c = (unsigned long long)clock64(); \
        ts_lo = (lane == nts) ? (int)(unsigned)_c : ts_lo; ts_hi = (lane == nts) ? (int)(unsigned)(_c >> 32) : ts_hi; ++nts; } } while (0)
    PG8_STAMP();
    unsigned voffA[2], voffB[2];
#pragma unroll
    for (int i = 0; i < 2; ++i) { int R, C; stage_rc(tid * 16 + i * 8192, R, C); const int Rb = Epi::PERM ? ((R & ~31) + perm32(R & 31)) : R;
        voffA[i] = (unsigned)(R * g.lda + C) * 2u; voffB[i] = (unsigned)(Rb * g.ldb + C) * 2u; }
    const size_t kstep = (size_t)(BK * 2);
    const size_t hstepA = (size_t)HALF * g.lda * 2, hstepB = (size_t)HALF * g.ldb * 2;
    const size_t tstepA = 2 * hstepA, tstepB = 2 * hstepB;
    const unsigned ldsw = (unsigned)wid * 1024u;
    const int aoff = lds_byte(wr * 64 + fr, fq * 8), boff = lds_byte(wc * 32 + fr, fq * 8);
#define PG8_SA(b, h) (((b) * 2 + (h)) * HTB)
#define PG8_SB(b, h) ((4 + (b) * 2 + (h)) * HTB)
#define PG8_STAGE(bufoff, gbase, voff) do { _Pragma("unroll") for (int _i = 0; _i < 2; ++_i) \
        __builtin_amdgcn_global_load_lds((const unsigned*)((const char*)(gbase) + (voff)[_i]), (PG8_LAS unsigned*)(lds + (bufoff) + ldsw + _i * 8192), 16, 0, 0); } while (0)
#define PG8_LDA(dst, b, h) do { _Pragma("unroll") for (int m = 0; m < 4; ++m) _Pragma("unroll") for (int k = 0; k < 2; ++k) dst[m][k] = *(const PG8_LAS bf16x8*)(lds + PG8_SA(b, h) + aoff + m * 2048 + k * 1024); } while (0)
#define PG8_LDB(dst, b, h) do { _Pragma("unroll") for (int n = 0; n < 2; ++n) _Pragma("unroll") for (int k = 0; k < 2; ++k) dst[n][k] = *(const PG8_LAS bf16x8*)(lds + PG8_SB(b, h) + boff + n * 2048 + k * 1024); } while (0)
#define PG8_MMA(ai, bj, At, Bt) do { __builtin_amdgcn_s_setprio(1); _Pragma("unroll") for (int m = 0; m < 4; ++m) _Pragma("unroll") for (int n = 0; n < 2; ++n) _Pragma("unroll") for (int k = 0; k < 2; ++k) \
        acc[ai][bj][m][n] = __builtin_amdgcn_mfma_f32_16x16x32_bf16(Bt[n][k], At[m][k], acc[ai][bj][m][n], 0, 0, 0); __builtin_amdgcn_s_setprio(0); } while (0)
#define PG8_WAIT_V(n) asm volatile("s_waitcnt vmcnt(" #n ")" ::: "memory")
#define PG8_WAIT_L(n) asm volatile("s_waitcnt lgkmcnt(" #n ")" ::: "memory")
#define PG8_BAR __builtin_amdgcn_s_barrier()
#define PG8_SCHED __builtin_amdgcn_sched_barrier(0)
    Unit cur, nxt; int ui = 0;
    if (!S.next(0, cur)) return;
    f32x4 acc[2][2][4][2];
#pragma unroll
    for (int a = 0; a < 2; ++a)
#pragma unroll
        for (int b = 0; b < 2; ++b)
#pragma unroll
            for (int m = 0; m < 4; ++m)
#pragma unroll
                for (int n = 0; n < 2; ++n) acc[a][b][m][n] = (f32x4){0.f, 0.f, 0.f, 0.f};
    bf16x8 At[4][2], B0[2][2], B1[2][2];
    const char* cA = (const char*)g.A + (size_t)cur.pm * tstepA; const char* cB = (const char*)g.Bt + (size_t)cur.pn * tstepB;
    S.a_ready(cur);
    PG8_STAGE(PG8_SB(0, 0), cB, voffB); PG8_STAGE(PG8_SA(0, 0), cA, voffA); PG8_STAGE(PG8_SB(0, 1), cB + hstepB, voffB); PG8_STAGE(PG8_SA(0, 1), cA + hstepA, voffA);
    if (wr == 1) PG8_BAR;
    PG8_WAIT_V(4); PG8_BAR;
    PG8_STAGE(PG8_SB(1, 0), cB + kstep, voffB); PG8_STAGE(PG8_SA(1, 0), cA + kstep, voffA); PG8_STAGE(PG8_SB(1, 1), cB + hstepB + kstep, voffB);
    PG8_WAIT_V(6); PG8_BAR;
    PG8_STAMP();
    for (;;) {
        const bool has_next = S.next(ui + 1, nxt);
        const char* nA = has_next ? (const char*)g.A + (size_t)nxt.pm * tstepA : cA; const char* nB = has_next ? (const char*)g.Bt + (size_t)nxt.pn * tstepB : cB;
        for (int t = 0; t < nt; t += 2) {
            const bool last = (t == nt - 2);
            const char* a1 = cA + (size_t)(t + 1) * kstep;
            const char* a2 = last ? nA : cA + (size_t)(t + 2) * kstep; const char* b2 = last ? nB : cB + (size_t)(t + 2) * kstep;
            const char* a3 = a2 + kstep; const char* b3 = b2 + kstep;
            if (last && has_next) S.a_ready(nxt);
            PG8_LDB(B0, 0, 0); PG8_SCHED; PG8_LDA(At, 0, 0); PG8_STAGE(PG8_SA(1, 1), a1 + hstepA, voffA);
            PG8_WAIT_L(8); PG8_BAR; PG8_WAIT_L(0); PG8_MMA(0, 0, At, B0); PG8_BAR; PG8_SCHED;
            PG8_LDB(B1, 0, 1); PG8_STAGE(PG8_SB(0, 0), b2, voffB);
            PG8_BAR; PG8_WAIT_L(0); PG8_MMA(0, 1, At, B1); PG8_BAR;
            PG8_LDA(At, 0, 1); PG8_STAGE(PG8_SA(0, 0), a2, voffA);
            PG8_BAR; PG8_WAIT_L(0); PG8_MMA(1, 0, At, B0); PG8_BAR; PG8_SCHED;
            PG8_STAGE(PG8_SB(0, 1), b2 + hstepB, voffB);
            PG8_WAIT_V(6); PG8_BAR; PG8_MMA(1, 1, At, B1); PG8_BAR;
            PG8_LDB(B0, 1, 0); PG8_SCHED; PG8_LDA(At, 1, 0); PG8_STAGE(PG8_SA(0, 1), a2 + hstepA, voffA);
            PG8_WAIT_L(8); PG8_BAR; PG8_WAIT_L(0); PG8_MMA(0, 0, At, B0); PG8_BAR; PG8_SCHED;
            PG8_LDB(B1, 1, 1); PG8_STAGE(PG8_SB(1, 0), b3, voffB);
            PG8_BAR; PG8_WAIT_L(0); PG8_MMA(0, 1, At, B1); PG8_BAR;
            PG8_LDA(At, 1, 1); PG8_STAGE(PG8_SA(1, 0), a3, voffA);
            PG8_BAR; PG8_WAIT_L(0); PG8_MMA(1, 0, At, B0); PG8_BAR; PG8_SCHED;
            PG8_STAGE(PG8_SB(1, 1), b3 + hstepB, voffB);
            PG8_WAIT_V(6); PG8_BAR; PG8_MMA(1, 1, At, B1); PG8_BAR;
        }
        PG8_STAMP();
        if constexpr (!Epi::AFTER_DRAIN) { E(acc, cur, wr, wc, fr, fq); S.done(cur); }
        PG8_STAMP();
        if (!has_next) break;
#pragma unroll
        for (int a = 0; a < 2; ++a)
#pragma unroll
            for (int b = 0; b < 2; ++b)
#pragma unroll
                for (int m = 0; m < 4; ++m)
#pragma unroll
                    for (int n = 0; n < 2; ++n) acc[a][b][m][n] = (f32x4){0.f, 0.f, 0.f, 0.f};
        cur = nxt; cA = nA; cB = nB; ++ui;
    }
    PG8_WAIT_V(0);
    if (wr == 0) PG8_BAR;
    PG8_BAR;
    if constexpr (Epi::AFTER_DRAIN) { E.fused(acc, cur, wr, wc, fr, fq, lds, wid, lane); S.done(cur); }
    PG8_STAMP();
    if (STAMP && wid == 0) { stamps[lane] = lane < nts ? (((unsigned long long)(unsigned)ts_hi << 32) | (unsigned)ts_lo) : 0ull;
        if (lane == 62) stamps[62] = rt_entry; if (lane == 63) stamps[63] = (unsigned long long)wall_clock64(); }
#undef PG8_STAMP
#undef PG8_SA
#undef PG8_SB
#undef PG8_STAGE
#undef PG8_LDA
#undef PG8_LDB
#undef PG8_MMA
#undef PG8_WAIT_V
#undef PG8_WAIT_L
#undef PG8_BAR
#undef PG8_SCHED
}
}


typedef unsigned short u16;
typedef short bf16x8 __attribute__((ext_vector_type(8)));
typedef float f32x4 __attribute__((ext_vector_type(4)));
typedef unsigned u32x4 __attribute__((ext_vector_type(4)));
typedef unsigned u32x2 __attribute__((ext_vector_type(2)));
#define LAS __attribute__((address_space(3)))
#define DI __device__ __forceinline__
#define MFMA16(a, b, c) __builtin_amdgcn_mfma_f32_16x16x32_bf16((a), (b), (c), 0, 0, 0)

constexpr int NP = 16384, NS = 128, NR = 16512, MP = 16640;
constexpr int ZLD = 5632, FF = 2816, N1 = 7936;
constexpr int ZQ = 0, ZK = 1024, ZV = 2048, ZG = 3072, ZSQ = 4096, ZSK = 5120, ZSV = 5376;
constexpr float EPS = 1e-6f;
constexpr size_t WS_RA = 0;
constexpr size_t WS_WA = WS_RA + 16777216;
constexpr size_t WS_WB = WS_WA + 2097152;
constexpr size_t WS_WO = WS_WB + 2097152;
constexpr size_t WS_WG = WS_WO + 2097152;
constexpr size_t WS_WU = WS_WG + 5767168;
constexpr size_t WS_WD = WS_WU + 5767168;
constexpr size_t WS_MOD = WS_WD + 5767168;
constexpr size_t WS_ZB = WS_MOD + 3342336;
constexpr size_t WS_HALO = WS_ZB + 1064960;
constexpr size_t WS_LAST = WS_HALO + 4718592;
constexpr size_t WS_H = WS_LAST + 8192;
constexpr size_t WS_Z = WS_H + 34078720;
constexpr size_t WS_END = WS_Z + 187432960;
constexpr size_t OFF_YS = 16777216, OFF_GSP = 16908288, OFF_GSS = 17956864, OFF_GCP = 34734080, OFF_GCS = 34807808, OFF_KP = 35987456,
                 OFF_KS = 36249600, OFF_VP = 40443904, OFF_VS = 40706048, OFF_FP = 44900352, OFF_FS = 44945408;
constexpr int LDS_BYTES = 147456;

struct Args { const float* in[28]; float* out; unsigned char* ws; };

DI u16 f2bf(float f) { unsigned u = __float_as_uint(f); u += 0x7FFFu + ((u >> 16) & 1u); return (u16)(u >> 16); }
DI float bf2f(u16 b) { return __uint_as_float(((unsigned)b) << 16); }
DI unsigned pack2(float a, float b) { return (unsigned)f2bf(a) | ((unsigned)f2bf(b) << 16); }
DI float bflo(unsigned w) { return __uint_as_float(w << 16); }
DI float bfhi(unsigned w) { return __uint_as_float(w & 0xFFFF0000u); }
DI float sigm(float x) { return 1.f / (1.f + __expf(-x)); }
DI float silu(float x) { return x / (1.f + __expf(-x)); }
DI float softplus(float x) { return x > 20.f ? x : log1pf(__expf(x)); }
DI f32x4 zero4() { return (f32x4){0.f, 0.f, 0.f, 0.f}; }
DI u32x4 pack8(f32x4 a, f32x4 b) { u32x4 w; w.x = pack2(a[0], a[1]); w.y = pack2(a[2], a[3]); w.z = pack2(b[0], b[1]); w.w = pack2(b[2], b[3]); return w; }
DI int row_bidx(int row) { return row < NP ? (row >> 11) : 8 + row - NP; }

struct EpiZ {
    static constexpr bool PERM = true, AFTER_DRAIN = false;
    u16* z; u16* gab; float* zb; u16* halo;
    DI void operator()(const f32x4 (&acc)[2][2][4][2], const pg8::Unit& u, int wr, int wc, int fr, int fq) const {
        const int row0 = u.pm * 256 + wr * 64 + fr;
        if (u.pn < 22) {
            const int col0 = u.pn * 256 + wc * 32 + 8 * fq;
#pragma unroll
            for (int ai = 0; ai < 2; ++ai)
#pragma unroll
                for (int m = 0; m < 4; ++m) {
                    const int row = row0 + ai * 128 + m * 16;
                    u16* rowp = z + (size_t)row * ZLD + col0;
                    const bool hal = (u.pn < 12) && (row < NP) && ((row & 63) >= 61);
#pragma unroll
                    for (int bj = 0; bj < 2; ++bj) {
                        const u32x4 w = pack8(acc[ai][bj][m][0], acc[ai][bj][m][1]);
                        *(u32x4*)(rowp + bj * 128) = w;
                        if (hal) *(u32x4*)(halo + ((size_t)(row >> 6) * 3 + ((row & 63) - 61)) * 3072 + col0 + bj * 128) = w;
                    }
                }
        } else if (u.pn < 30) {
            const int col0 = (u.pn - 22) * 256 + wc * 32 + 8 * fq;
#pragma unroll
            for (int ai = 0; ai < 2; ++ai)
#pragma unroll
                for (int m = 0; m < 4; ++m) {
                    const int row = row0 + ai * 128 + m * 16;
                    if (row < NR) {
                        u16* rowp = gab + (size_t)row * 2048 + col0;
#pragma unroll
                        for (int bj = 0; bj < 2; ++bj) *(u32x4*)(rowp + bj * 128) = pack8(acc[ai][bj][m][0], acc[ai][bj][m][1]);
                    }
                }
        } else if (wc == 0 && fq < 2) {
#pragma unroll
            for (int ai = 0; ai < 2; ++ai)
#pragma unroll
                for (int m = 0; m < 4; ++m) {
                    const int row = row0 + ai * 128 + m * 16;
#pragma unroll
                    for (int n = 0; n < 2; ++n) *(f32x4*)(zb + (size_t)row * 16 + 8 * fq + 4 * n) = acc[ai][0][m][n];
                }
        }
    }
};
template <int WHICH> struct EpiMix {
    static constexpr bool PERM = true, AFTER_DRAIN = false;
    u16* mix; const u16* gab;
    DI void operator()(const f32x4 (&acc)[2][2][4][2], const pg8::Unit& u, int wr, int wc, int fr, int fq) const {
        const int row0 = u.pm * 256 + wr * 64 + fr, col0 = u.pn * 256 + wc * 32 + 8 * fq;
#pragma unroll
        for (int ai = 0; ai < 2; ++ai)
#pragma unroll
            for (int m = 0; m < 4; ++m) {
                const int row = row0 + ai * 128 + m * 16;
#pragma unroll
                for (int bj = 0; bj < 2; ++bj) {
                    const int c = col0 + bj * 128;
                    u16* mp = mix + (size_t)row * 1024 + c;
                    u32x4 gv = (u32x4){0u, 0u, 0u, 0u};
                    if (row < NR) gv = *(const u32x4*)(gab + (size_t)row * 2048 + WHICH * 1024 + c);
                    f32x4 a0 = acc[ai][bj][m][0], a1 = acc[ai][bj][m][1];
                    a0[0] *= sigm(bflo(gv.x)); a0[1] *= sigm(bfhi(gv.x)); a0[2] *= sigm(bflo(gv.y)); a0[3] *= sigm(bfhi(gv.y));
                    a1[0] *= sigm(bflo(gv.z)); a1[1] *= sigm(bfhi(gv.z)); a1[2] *= sigm(bflo(gv.w)); a1[3] *= sigm(bfhi(gv.w));
                    if (WHICH == 1) {
                        const u32x4 pv = *(const u32x4*)mp;
                        a0[0] += bflo(pv.x); a0[1] += bfhi(pv.x); a0[2] += bflo(pv.y); a0[3] += bfhi(pv.y);
                        a1[0] += bflo(pv.z); a1[1] += bfhi(pv.z); a1[2] += bflo(pv.w); a1[3] += bfhi(pv.w);
                    }
                    *(u32x4*)mp = pack8(a0, a1);
                }
            }
    }
};
template <int WHICH> struct EpiRes {
    static constexpr bool PERM = false, AFTER_DRAIN = false;
    float* out; const float* xp; const float* xs; const float* mod;
    DI void operator()(const f32x4 (&acc)[2][2][4][2], const pg8::Unit& u, int wr, int wc, int fr, int fq) const {
        const int row0 = u.pm * 256 + wr * 64 + fr, col0 = u.pn * 256 + wc * 32 + 4 * fq;
#pragma unroll
        for (int ai = 0; ai < 2; ++ai)
#pragma unroll
            for (int m = 0; m < 4; ++m) {
                const int row = row0 + ai * 128 + m * 16;
                if (row < NR) {
                    float* op = out + (size_t)row * 1024 + col0;
                    const float* xr = WHICH ? op : ((row < NP ? xp + (size_t)row * 1024 : xs + (size_t)(row - NP) * 1024) + col0);
                    const float* gt = mod + (size_t)row_bidx(row) * 6144 + (WHICH ? 5120 : 2048) + col0;
#pragma unroll
                    for (int bj = 0; bj < 2; ++bj)
#pragma unroll
                        for (int n = 0; n < 2; ++n) {
                            const int o = bj * 128 + n * 16;
                            *(f32x4*)(op + o) = *(const f32x4*)(xr + o) + *(const f32x4*)(gt + o) * acc[ai][bj][m][n];
                        }
                }
            }
    }
};
struct EpiPlain {
    static constexpr bool PERM = true, AFTER_DRAIN = false;
    u16* o; int ld;
    DI void operator()(const f32x4 (&acc)[2][2][4][2], const pg8::Unit& u, int wr, int wc, int fr, int fq) const {
        const int row0 = u.pm * 256 + wr * 64 + fr, col0 = u.pn * 256 + wc * 32 + 8 * fq;
#pragma unroll
        for (int ai = 0; ai < 2; ++ai)
#pragma unroll
            for (int m = 0; m < 4; ++m) {
                u16* rowp = o + (size_t)(row0 + ai * 128 + m * 16) * ld + col0;
#pragma unroll
                for (int bj = 0; bj < 2; ++bj) *(u32x4*)(rowp + bj * 128) = pack8(acc[ai][bj][m][0], acc[ai][bj][m][1]);
            }
    }
};
template <class Epi> DI void run_gemm(LAS unsigned char* lds, const u16* A, int lda, const u16* Bt, int ldb, int N, int K, const Epi& E) {
    pg8::Gemm g; g.A = A; g.Bt = Bt; g.M = MP; g.N = N; g.K = K; g.lda = lda; g.ldb = ldb;
    pg8::StaticOrder S; S.init(MP, N, (int)gridDim.x, (int)blockIdx.x);
    pg8::gemm_phase<Epi, pg8::StaticOrder, false>((PG8_LAS unsigned char*)lds, g, S, E, nullptr);
}

DI void phase0(const Args& a, LAS unsigned char* lds) {
    const int tid = otid(), lane = tid & 63, wid = tid >> 6, r16 = lane & 15, g = lane >> 4;
    float* mod = (float*)(a.ws + WS_MOD);
    const float* wmod = a.in[9]; const float* bmod = a.in[10];
    LAS float* red = (LAS float*)lds;
    for (int task = blockIdx.x; task < 384; task += gridDim.x) {
        const int n0 = task * 16;
        f32x4 acc[9];
#pragma unroll
        for (int mt = 0; mt < 9; ++mt) acc[mt] = zero4();
#pragma unroll 1
        for (int ks = 0; ks < 4; ++ks) {
            const int k0 = wid * 128 + ks * 32 + g * 8;
            bf16x8 bfr;
#pragma unroll
            for (int j = 0; j < 8; ++j) bfr[j] = (short)f2bf(wmod[(size_t)(k0 + j) * 6144 + n0 + r16]);
#pragma unroll
            for (int mt = 0; mt < 9; ++mt) {
                const int r = mt * 16 + r16;
                bf16x8 af = (bf16x8){0, 0, 0, 0, 0, 0, 0, 0};
                if (r < 136) {
                    const float* cp = (r < 8 ? a.in[2] + r * 1024 : a.in[3] + (r - 8) * 1024) + k0;
                    const f32x4 v0 = *(const f32x4*)cp, v1 = *(const f32x4*)(cp + 4);
#pragma unroll
                    for (int j = 0; j < 4; ++j) { af[j] = (short)f2bf(silu(v0[j])); af[4 + j] = (short)f2bf(silu(v1[j])); }
                }
                acc[mt] = MFMA16(af, bfr, acc[mt]);
            }
        }
#pragma unroll
        for (int mt = 0; mt < 9; ++mt) *(LAS f32x4*)(red + ((wid * 9 + mt) * 64 + lane) * 4) = acc[mt];
        __syncthreads();
        for (int idx = tid; idx < 2304; idx += 512) {
            const int mt = idx >> 8, rem = idx & 255, l = rem >> 2, i = rem & 3;
            float s = 0.f;
#pragma unroll
            for (int w = 0; w < 8; ++w) s += red[((w * 9 + mt) * 64 + l) * 4 + i];
            const int row = mt * 16 + 4 * (l >> 4) + i, col = n0 + (l & 15);
            if (row < 136) mod[(size_t)row * 6144 + col] = s + bmod[col];
        }
        __syncthreads();
    }
    LAS u16* T = (LAS u16*)lds;
    for (int t = blockIdx.x; t < 4864; t += gridDim.x) {
        const float* src; u16* dst; int ldsrc, K, tl = t, mode = 0;
        if (tl < 1984) { src = a.in[13]; ldsrc = 7696; K = 1024; dst = (u16*)(a.ws + WS_RA); mode = 1; }
        else if ((tl -= 1984) < 256) { src = a.in[18]; ldsrc = 1024; K = 1024; dst = (u16*)(a.ws + WS_WA); }
        else if ((tl -= 256) < 256) { src = a.in[20]; ldsrc = 1024; K = 1024; dst = (u16*)(a.ws + WS_WB); }
        else if ((tl -= 256) < 256) { src = a.in[21]; ldsrc = 1024; K = 1024; dst = (u16*)(a.ws + WS_WO); }
        else if ((tl -= 256) < 704) { src = a.in[22]; ldsrc = 2816; K = 1024; dst = (u16*)(a.ws + WS_WG); }
        else if ((tl -= 704) < 704) { src = a.in[23]; ldsrc = 2816; K = 1024; dst = (u16*)(a.ws + WS_WU); }
        else { tl -= 704; src = a.in[26]; ldsrc = 1024; K = 2816; dst = (u16*)(a.ws + WS_WD); }
        const int ktiles = K >> 6, nt = tl / ktiles, kt = tl - nt * ktiles, n0 = nt * 64, k0 = kt * 64;
        {
            const int k = tid >> 3, n8 = (tid & 7) * 8, n = n0 + n8;
            int sc = n; bool valid = true;
            if (mode == 1) { if (n < 4096) sc = n; else if (n < 7680) sc = n + 16; else if (n < 7696) sc = 4096 + (n - 7680); else valid = false; }
            f32x4 v0 = zero4(), v1 = zero4();
            if (valid) { const float* p = src + (size_t)(k0 + k) * ldsrc + sc; v0 = *(const f32x4*)p; v1 = *(const f32x4*)(p + 4); }
#pragma unroll
            for (int j = 0; j < 4; ++j) { T[(n8 + j) * 72 + k] = f2bf(v0[j]); T[(n8 + 4 + j) * 72 + k] = f2bf(v1[j]); }
        }
        __syncthreads();
        {
            const int n = tid >> 3, k8 = (tid & 7) * 8;
            *(u32x4*)(dst + (size_t)(n0 + n) * K + k0 + k8) = *(LAS u32x4*)(T + n * 72 + k8);
        }
        __syncthreads();
    }
}

template <int WHICH> DI void phase_norm(const Args& a) {
    const int tid = otid(), lane = tid & 63, gw = blockIdx.x * 8 + (tid >> 6), nw = gridDim.x * 8;
    u16* hb = (u16*)(a.ws + WS_H);
    const float* mod = (const float*)(a.ws + WS_MOD);
    const float* nwt = a.in[WHICH ? 12 : 11];
    for (int row = gw; row < MP; row += nw) {
        u16* hp = hb + (size_t)row * 1024;
        if (row >= NR) {
#pragma unroll
            for (int i = 0; i < 4; ++i) *(u32x2*)(hp + lane * 4 + 256 * i) = (u32x2){0u, 0u};
            continue;
        }
        const float* xr = WHICH ? a.out + (size_t)row * 1024 : (row < NP ? a.in[0] + (size_t)row * 1024 : a.in[1] + (size_t)(row - NP) * 1024);
        const float* mr = mod + (size_t)row_bidx(row) * 6144 + (WHICH ? 3072 : 0);
        f32x4 v[4]; float ss = 0.f;
#pragma unroll
        for (int i = 0; i < 4; ++i) { v[i] = *(const f32x4*)(xr + lane * 4 + 256 * i); ss += v[i][0] * v[i][0] + v[i][1] * v[i][1] + v[i][2] * v[i][2] + v[i][3] * v[i][3]; }
#pragma unroll
        for (int o = 1; o < 64; o <<= 1) ss += __shfl_xor(ss, o);
        const float rstd = rsqrtf(ss * (1.f / 1024.f) + EPS);
#pragma unroll
        for (int i = 0; i < 4; ++i) {
            const int c = lane * 4 + 256 * i;
            const f32x4 w = *(const f32x4*)(nwt + c), sh = *(const f32x4*)(mr + c), sc = *(const f32x4*)(mr + 1024 + c);
            f32x4 y;
#pragma unroll
            for (int j = 0; j < 4; ++j) y[j] = v[i][j] * rstd * w[j] * (1.f + sc[j]) + sh[j];
            *(u32x2*)(hp + c) = (u32x2){pack2(y[0], y[1]), pack2(y[2], y[3])};
        }
    }
}
DI void phase_final(const Args& a) {
    const int tid = otid(), lane = tid & 63, gw = blockIdx.x * 8 + (tid >> 6), nw = gridDim.x * 8;
    const float* fw = a.in[27];
    for (int row = gw; row < NR; row += nw) {
        float* xr = a.out + (size_t)row * 1024;
        f32x4 v[4]; float ss = 0.f;
#pragma unroll
        for (int i = 0; i < 4; ++i) { v[i] = *(const f32x4*)(xr + lane * 4 + 256 * i); ss += v[i][0] * v[i][0] + v[i][1] * v[i][1] + v[i][2] * v[i][2] + v[i][3] * v[i][3]; }
#pragma unroll
        for (int o = 1; o < 64; o <<= 1) ss += __shfl_xor(ss, o);
        const float rstd = rsqrtf(ss * (1.f / 1024.f) + EPS);
#pragma unroll
        for (int i = 0; i < 4; ++i) { const int c = lane * 4 + 256 * i; *(f32x4*)(xr + c) = v[i] * rstd * *(const f32x4*)(fw + c); }
    }
}

DI void phase_act(const Args& a) {
    const u16* gate = (const u16*)(a.ws + WS_Z);
    u16* up = (u16*)(a.ws + WS_Z) + (size_t)MP * FF;
    const float* cw = a.in[24]; const float* cb = a.in[25]; const float* sf = a.in[8];
    const int nthr = gridDim.x * 512;
    for (int idx = blockIdx.x * 512 + otid(); idx < NR * 352; idx += nthr) {
        const int row = idx / 352, c = (idx - row * 352) * 8;
        float gm2[8], gm1[8], g0[8];
        const u32x4 gv = *(const u32x4*)(gate + (size_t)row * FF + c);
        g0[0] = bflo(gv.x); g0[1] = bfhi(gv.x); g0[2] = bflo(gv.y); g0[3] = bfhi(gv.y); g0[4] = bflo(gv.z); g0[5] = bfhi(gv.z); g0[6] = bflo(gv.w); g0[7] = bfhi(gv.w);
#pragma unroll
        for (int j = 0; j < 8; ++j) { gm1[j] = 0.f; gm2[j] = 0.f; }
        if (row < NP) {
            const int t = row & 2047;
            if (t >= 1) { const u32x4 q = *(const u32x4*)(gate + (size_t)(row - 1) * FF + c);
                gm1[0] = bflo(q.x); gm1[1] = bfhi(q.x); gm1[2] = bflo(q.y); gm1[3] = bfhi(q.y); gm1[4] = bflo(q.z); gm1[5] = bfhi(q.z); gm1[6] = bflo(q.w); gm1[7] = bfhi(q.w); }
            if (t >= 2) { const u32x4 q = *(const u32x4*)(gate + (size_t)(row - 2) * FF + c);
                gm2[0] = bflo(q.x); gm2[1] = bfhi(q.x); gm2[2] = bflo(q.y); gm2[3] = bfhi(q.y); gm2[4] = bflo(q.z); gm2[5] = bfhi(q.z); gm2[6] = bflo(q.w); gm2[7] = bfhi(q.w); }
            if (t >= 2046) { float* fp = a.out + OFF_FP + ((size_t)(row >> 11) * 2 + (t - 2046)) * FF + c;
                *(f32x4*)fp = (f32x4){g0[0], g0[1], g0[2], g0[3]}; *(f32x4*)(fp + 4) = (f32x4){g0[4], g0[5], g0[6], g0[7]}; }
        } else {
            const int b = row - NP;
            const float* s0 = sf + ((size_t)b * 2) * FF + c;
            const f32x4 p0 = *(const f32x4*)s0, p1 = *(const f32x4*)(s0 + 4), q0 = *(const f32x4*)(s0 + FF), q1 = *(const f32x4*)(s0 + FF + 4);
#pragma unroll
            for (int j = 0; j < 4; ++j) { gm2[j] = p0[j]; gm2[4 + j] = p1[j]; gm1[j] = q0[j]; gm1[4 + j] = q1[j]; }
            float* fp = a.out + OFF_FS + ((size_t)b * 2) * FF + c;
            *(f32x4*)fp = q0; *(f32x4*)(fp + 4) = q1;
            *(f32x4*)(fp + FF) = (f32x4){g0[0], g0[1], g0[2], g0[3]}; *(f32x4*)(fp + FF + 4) = (f32x4){g0[4], g0[5], g0[6], g0[7]};
        }
        u16* upp = up + (size_t)row * FF + c;
        const u32x4 uv = *(const u32x4*)upp;
        float uu[8] = {bflo(uv.x), bfhi(uv.x), bflo(uv.y), bfhi(uv.y), bflo(uv.z), bfhi(uv.z), bflo(uv.w), bfhi(uv.w)};
        float r[8];
#pragma unroll
        for (int j = 0; j < 8; ++j) {
            const float gc = cw[c + j] * gm2[j] + cw[FF + c + j] * gm1[j] + cw[2 * FF + c + j] * g0[j] + cb[c + j];
            r[j] = silu(gc) * uu[j];
        }
        *(u32x4*)upp = (u32x4){pack2(r[0], r[1]), pack2(r[2], r[3]), pack2(r[4], r[5]), pack2(r[6], r[7])};
    }
}

DI void phase_prep(const Args& a, LAS unsigned char* lds) {
    const int tid = otid(), lane = tid & 63, wid = tid >> 6, r16 = lane & 15, g = lane >> 4;
    u16* z = (u16*)(a.ws + WS_Z);
    const float* zb = (const float*)(a.ws + WS_ZB);
    const u16* halo = (const u16*)(a.ws + WS_HALO);
    u16* wbuf = (u16*)(a.ws + WS_H);
    u16* abuf = (u16*)(a.ws + WS_RA);
    float* Mbuf = a.out + OFF_KS;
    float* lastbuf = (float*)(a.ws + WS_LAST);
    const float* cw = a.in[14];
    LAS float* dec = (LAS float*)lds;
    LAS float* bet = dec + 512;
    LAS u16* qn = (LAS u16*)(lds + 4096);
    LAS u16* kn = qn + 64 * 136;
    for (int item = blockIdx.x; item < 256; item += gridDim.x) {
        const int b = item >> 5, ck = item & 31, R0 = b * 2048 + ck * 64;
        {
            const int h = wid;
            const float* zr = zb + (size_t)(R0 + lane) * 16;
            const float be = sigm(zr[h]);
            float s = -__expf(a.in[15][h]) * softplus(zr[8 + h] + a.in[16][h]);
#pragma unroll
            for (int off = 1; off < 64; off <<= 1) { const float t = __shfl_up(s, off); if (lane >= off) s += t; }
            dec[h * 64 + lane] = s; bet[h * 64 + lane] = be;
            if (lane == 63) lastbuf[item * 8 + h] = __expf(s);
        }
        __syncthreads();
#pragma unroll 1
        for (int h = 0; h < 8; ++h) {
            int tok = tid >> 3, cgp = tid & 7; asm volatile("" : "+v"(tok), "+v"(cgp));
            const float dtok = dec[h * 64 + tok], ed = __expf(dtok), edl = __expf(dec[h * 64 + 63] - dtok), be = bet[h * 64 + tok];
            u32x4 oq0, oq1, ok0, ok1, okb0, okb1, ov0, ov1;
#pragma unroll
            for (int part = 0; part < 3; ++part) {
                const int col = part * 1024 + h * 128 + cgp * 16;
                float v[16];
#pragma unroll
                for (int c = 0; c < 16; ++c) v[c] = 0.f;
#pragma unroll
                for (int j = 0; j < 4; ++j) {
                    const int srow = tok - 3 + j, pos = ck * 64 + srow;
                    u32x4 x0 = (u32x4){0u, 0u, 0u, 0u}, x1 = x0;
                    if (pos >= 0) {
                        const u16* p = (srow < 0) ? halo + ((size_t)((b * 32 + ck - 1) * 3 + 3 + srow)) * 3072 + col : z + (size_t)(R0 + srow) * ZLD + col;
                        x0 = *(const u32x4*)p; x1 = *(const u32x4*)(p + 8);
                    }
                    const float* wp = cw + j * 3072 + col;
                    const f32x4 w0 = *(const f32x4*)wp, w1 = *(const f32x4*)(wp + 4), w2 = *(const f32x4*)(wp + 8), w3 = *(const f32x4*)(wp + 12);
                    v[0] += w0[0] * bflo(x0.x); v[1] += w0[1] * bfhi(x0.x); v[2] += w0[2] * bflo(x0.y); v[3] += w0[3] * bfhi(x0.y);
                    v[4] += w1[0] * bflo(x0.z); v[5] += w1[1] * bfhi(x0.z); v[6] += w1[2] * bflo(x0.w); v[7] += w1[3] * bfhi(x0.w);
                    v[8] += w2[0] * bflo(x1.x); v[9] += w2[1] * bfhi(x1.x); v[10] += w2[2] * bflo(x1.y); v[11] += w2[3] * bfhi(x1.y);
                    v[12] += w3[0] * bflo(x1.z); v[13] += w3[1] * bfhi(x1.z); v[14] += w3[2] * bflo(x1.w); v[15] += w3[3] * bfhi(x1.w);
                }
                float ss = 0.f;
#pragma unroll
                for (int c = 0; c < 16; ++c) { v[c] = silu(v[c]); ss += v[c] * v[c]; }
                if (part < 2) {
                    ss += __shfl_xor(ss, 1); ss += __shfl_xor(ss, 2); ss += __shfl_xor(ss, 4);
                    const float sc = rsqrtf(ss + EPS) * (part == 0 ? 0.08838834764831845f : 1.f);
#pragma unroll
                    for (int c = 0; c < 16; ++c) v[c] *= sc;
                    LAS u16* dstl = (part == 0 ? qn : kn) + tok * 136 + cgp * 16;
                    *(LAS u32x4*)dstl = (u32x4){pack2(v[0], v[1]), pack2(v[2], v[3]), pack2(v[4], v[5]), pack2(v[6], v[7])};
                    *(LAS u32x4*)(dstl + 8) = (u32x4){pack2(v[8], v[9]), pack2(v[10], v[11]), pack2(v[12], v[13]), pack2(v[14], v[15])};
                }
                if (part == 0) {
                    oq0 = (u32x4){pack2(v[0] * ed, v[1] * ed), pack2(v[2] * ed, v[3] * ed), pack2(v[4] * ed, v[5] * ed), pack2(v[6] * ed, v[7] * ed)};
                    oq1 = (u32x4){pack2(v[8] * ed, v[9] * ed), pack2(v[10] * ed, v[11] * ed), pack2(v[12] * ed, v[13] * ed), pack2(v[14] * ed, v[15] * ed)};
                } else if (part == 1) {
                    ok0 = (u32x4){pack2(v[0] * edl, v[1] * edl), pack2(v[2] * edl, v[3] * edl), pack2(v[4] * edl, v[5] * edl), pack2(v[6] * edl, v[7] * edl)};
                    ok1 = (u32x4){pack2(v[8] * edl, v[9] * edl), pack2(v[10] * edl, v[11] * edl), pack2(v[12] * edl, v[13] * edl), pack2(v[14] * edl, v[15] * edl)};
                    const float kb = be * ed;
                    okb0 = (u32x4){pack2(v[0] * kb, v[1] * kb), pack2(v[2] * kb, v[3] * kb), pack2(v[4] * kb, v[5] * kb), pack2(v[6] * kb, v[7] * kb)};
                    okb1 = (u32x4){pack2(v[8] * kb, v[9] * kb), pack2(v[10] * kb, v[11] * kb), pack2(v[12] * kb, v[13] * kb), pack2(v[14] * kb, v[15] * kb)};
                } else {
                    ov0 = (u32x4){pack2(v[0] * be, v[1] * be), pack2(v[2] * be, v[3] * be), pack2(v[4] * be, v[5] * be), pack2(v[6] * be, v[7] * be)};
                    ov1 = (u32x4){pack2(v[8] * be, v[9] * be), pack2(v[10] * be, v[11] * be), pack2(v[12] * be, v[13] * be), pack2(v[14] * be, v[15] * be)};
                }
            }
            __syncthreads();
            {
                u16* zr = z + (size_t)(R0 + tok) * ZLD + h * 128 + cgp * 16;
                *(u32x4*)(zr + ZQ) = oq0; *(u32x4*)(zr + ZQ + 8) = oq1;
                *(u32x4*)(zr + ZK) = ok0; *(u32x4*)(zr + ZK + 8) = ok1;
                *(u32x4*)(zr + ZV) = ov0; *(u32x4*)(zr + ZV + 8) = ov1;
                u16* wr_ = wbuf + ((size_t)(item * 8 + h) * 64 + tok) * 128 + cgp * 16;
                *(u32x4*)wr_ = okb0; *(u32x4*)(wr_ + 8) = okb1;
            }
            {
                const int which = wid >> 2, mi = wid & 3;
                LAS u16* As = which ? qn : kn;
                f32x4 acc[4];
#pragma unroll
                for (int ni = 0; ni < 4; ++ni) acc[ni] = zero4();
#pragma unroll
                for (int ks = 0; ks < 4; ++ks) {
                    const bf16x8 af = *(LAS bf16x8*)(As + (16 * mi + r16) * 136 + ks * 32 + g * 8);
#pragma unroll
                    for (int ni = 0; ni < 4; ++ni) acc[ni] = MFMA16(af, *(LAS bf16x8*)(kn + (16 * ni + r16) * 136 + ks * 32 + g * 8), acc[ni]);
                }
#pragma unroll
                for (int ni = 0; ni < 4; ++ni)
#pragma unroll
                    for (int i = 0; i < 4; ++i) {
                        const int ti = 16 * mi + 4 * g + i, tj = 16 * ni + r16;
                        const float e = (ti >= tj) ? __expf(dec[h * 64 + ti] - dec[h * 64 + tj]) : 0.f;
                        if (which == 0) Mbuf[((size_t)(item * 8 + h) * 64 + ti) * 64 + tj] = (ti > tj) ? bet[h * 64 + ti] * acc[ni][i] * e : 0.f;
                        else abuf[((size_t)(item * 8 + h) * 64 + ti) * 64 + tj] = f2bf(acc[ni][i] * e);
                    }
            }
            __syncthreads();
        }
        {
            const int h = wid;
            LAS float* Ml = (LAS float*)(lds + 4096 + wid * 17408);
            const float* Mg = Mbuf + (size_t)(item * 8 + h) * 4096;
#pragma unroll
            for (int it = 0; it < 16; ++it) { const int idx = it * 64 + lane; *(LAS f32x4*)(Ml + (idx >> 4) * 68 + (idx & 15) * 4) = *(const f32x4*)(Mg + idx * 4); }
            Ml[lane] = (lane == 0) ? 1.f : 0.f;
#pragma unroll 1
            for (int i = 1; i < 64; ++i) {
                float s = (lane == i) ? 1.f : 0.f;
                const int i4 = i & ~3;
#pragma unroll 1
                for (int j = 0; j < i4; j += 4) {
                    const f32x4 m = *(LAS f32x4*)(Ml + i * 68 + j);
                    s -= m[0] * Ml[j * 68 + lane]; s -= m[1] * Ml[(j + 1) * 68 + lane]; s -= m[2] * Ml[(j + 2) * 68 + lane]; s -= m[3] * Ml[(j + 3) * 68 + lane];
                }
                for (int j = i4; j < i; ++j) s -= Ml[i * 68 + j] * Ml[j * 68 + lane];
                Ml[i * 68 + lane] = s;
            }
            bf16x8 at[4][2];
#pragma unroll
            for (int mt = 0; mt < 4; ++mt)
#pragma unroll
                for (int ks = 0; ks < 2; ++ks) {
                    const f32x4 t0 = *(LAS f32x4*)(Ml + (16 * mt + r16) * 68 + ks * 32 + g * 8), t1 = *(LAS f32x4*)(Ml + (16 * mt + r16) * 68 + ks * 32 + g * 8 + 4);
                    const u32x4 pk = pack8(t0, t1);
                    at[mt][ks] = __builtin_bit_cast(bf16x8, pk);
                }
#pragma unroll 1
            for (int pass = 0; pass < 2; ++pass) {
                u16* base = pass == 0 ? z + (size_t)R0 * ZLD + ZV + h * 128 : wbuf + (size_t)(item * 8 + h) * 64 * 128;
                const unsigned ld = pass == 0 ? ZLD : 128;
#pragma unroll 1
                for (int nt = 0; nt < 8; ++nt) {
                    u16* cp = base + nt * 16;
                    const unsigned o0 = (unsigned)(g * 8) * ld + r16, o1 = o0 + 32u * ld;
                    bf16x8 b0, b1;
#pragma unroll
                    for (int j = 0; j < 8; ++j) { b0[j] = (short)cp[o0 + j * ld]; b1[j] = (short)cp[o1 + j * ld]; }
                    f32x4 c[4];
#pragma unroll
                    for (int mt = 0; mt < 4; ++mt) { c[mt] = MFMA16(at[mt][0], b0, zero4()); c[mt] = MFMA16(at[mt][1], b1, c[mt]); }
                    const unsigned os = (unsigned)(4 * g) * ld + r16;
#pragma unroll
                    for (int mt = 0; mt < 4; ++mt)
#pragma unroll
                        for (int i = 0; i < 4; ++i) cp[os + (16 * mt + i) * ld] = f2bf(c[mt][i]);
                }
            }
        }
        __syncthreads();
    }
}

DI void phase_scan(const Args& a, LAS unsigned char* lds, int s) {
    const int tid = otid(), lane = tid & 63, wid = tid >> 6, r16 = lane & 15, g = lane >> 4;
    const int b = s >> 3, h = s & 7;
    u16* z = (u16*)(a.ws + WS_Z);
    const u16* wbuf = (const u16*)(a.ws + WS_H);
    const u16* abuf = (const u16*)(a.ws + WS_RA);
    const float* lastbuf = (const float*)(a.ws + WS_LAST);
    const float* onw = a.in[17];
    LAS u16* Wl = (LAS u16*)lds;
    LAS u16* Ql = Wl + 64 * 136;
    LAS u16* Al = Ql + 64 * 136;
    LAS u16* KT = Al + 64 * 72;
    LAS u16* STl = KT + 128 * 72;
    LAS u16* VT = STl + 128 * 136;
    LAS float* ssq = (LAS float*)(VT + 128 * 72);
    f32x4 st[8];
#pragma unroll
    for (int nt = 0; nt < 8; ++nt) st[nt] = zero4();
    const int dvc = 16 * wid + r16;
    const float ow = onw[dvc];
    u32x4 pw0, pw1, pq0, pq1, pa, pk0, pk1; u16 pu[16], pg[16];
    const int t0 = tid >> 4, c80 = (tid & 15) * 8;
    const int ta = tid >> 3, ca = (tid & 7) * 8;
#define SCAN_LOAD(n_) do { const int R0_ = b * 2048 + (n_) * 64; const size_t ci_ = (size_t)((b * 32 + (n_)) * 8 + h); \
        const u16* wp_ = wbuf + ci_ * 8192; pw0 = *(const u32x4*)(wp_ + t0 * 128 + c80); pw1 = *(const u32x4*)(wp_ + (t0 + 32) * 128 + c80); \
        const u16* zq_ = z + (size_t)R0_ * ZLD + h * 128 + c80; \
        pq0 = *(const u32x4*)(zq_ + (size_t)t0 * ZLD + ZQ); pq1 = *(const u32x4*)(zq_ + (size_t)(t0 + 32) * ZLD + ZQ); \
        pk0 = *(const u32x4*)(zq_ + (size_t)t0 * ZLD + ZK); pk1 = *(const u32x4*)(zq_ + (size_t)(t0 + 32) * ZLD + ZK); \
        pa = *(const u32x4*)(abuf + ci_ * 4096 + ta * 64 + ca); \
        _Pragma("unroll") for (int mt_ = 0; mt_ < 4; ++mt_) _Pragma("unroll") for (int i_ = 0; i_ < 4; ++i_) { \
            const u16* zr_ = z + (size_t)(R0_ + 16 * mt_ + 4 * g + i_) * ZLD + h * 128 + dvc; pu[mt_ * 4 + i_] = zr_[ZV]; pg[mt_ * 4 + i_] = zr_[ZG]; } } while (0)
    SCAN_LOAD(0);
#pragma unroll 1
    for (int n = 0; n < 32; ++n) {
        const int R0 = b * 2048 + n * 64;
        *(LAS u32x4*)(Wl + t0 * 136 + c80) = pw0; *(LAS u32x4*)(Wl + (t0 + 32) * 136 + c80) = pw1;
        *(LAS u32x4*)(Ql + t0 * 136 + c80) = pq0; *(LAS u32x4*)(Ql + (t0 + 32) * 136 + c80) = pq1;
        *(LAS u32x4*)(Al + ta * 72 + ca) = pa;
        {
            const unsigned e0[4] = {pk0.x, pk0.y, pk0.z, pk0.w}, e1[4] = {pk1.x, pk1.y, pk1.z, pk1.w};
#pragma unroll
            for (int j = 0; j < 4; ++j) {
                KT[(c80 + 2 * j) * 72 + t0] = (u16)(e0[j] & 0xFFFFu); KT[(c80 + 2 * j + 1) * 72 + t0] = (u16)(e0[j] >> 16);
                KT[(c80 + 2 * j) * 72 + t0 + 32] = (u16)(e1[j] & 0xFFFFu); KT[(c80 + 2 * j + 1) * 72 + t0 + 32] = (u16)(e1[j] >> 16);
            }
        }
        float uu[16], gg[16];
#pragma unroll
        for (int i = 0; i < 16; ++i) { uu[i] = bf2f(pu[i]); gg[i] = bf2f(pg[i]); }
        const float last = lastbuf[(b * 32 + n) * 8 + h];
        __syncthreads();
        if (n + 1 < 32) SCAN_LOAD(n + 1);
#pragma unroll
        for (int nt = 0; nt < 8; ++nt)
#pragma unroll
            for (int i = 0; i < 4; ++i) STl[(16 * wid + 4 * g + i) * 136 + 16 * nt + r16] = f2bf(st[nt][i]);
        bf16x8 sb[4];
#pragma unroll
        for (int ks = 0; ks < 4; ++ks) sb[ks] = *(LAS bf16x8*)(STl + (16 * wid + r16) * 136 + ks * 32 + g * 8);
#pragma unroll
        for (int mt = 0; mt < 4; ++mt) {
            f32x4 c = zero4();
#pragma unroll
            for (int ks = 0; ks < 4; ++ks) c = MFMA16(*(LAS bf16x8*)(Wl + (16 * mt + r16) * 136 + ks * 32 + g * 8), sb[ks], c);
            *(LAS u32x2*)(VT + (16 * wid + r16) * 72 + 16 * mt + 4 * g) = (u32x2){pack2(uu[mt * 4] - c[0], uu[mt * 4 + 1] - c[1]), pack2(uu[mt * 4 + 2] - c[2], uu[mt * 4 + 3] - c[3])};
        }
        bf16x8 vb[2];
#pragma unroll
        for (int ks = 0; ks < 2; ++ks) vb[ks] = *(LAS bf16x8*)(VT + (16 * wid + r16) * 72 + ks * 32 + g * 8);
        f32x4 oa[4];
#pragma unroll
        for (int mt = 0; mt < 4; ++mt) {
            f32x4 c = zero4();
#pragma unroll
            for (int ks = 0; ks < 4; ++ks) c = MFMA16(*(LAS bf16x8*)(Ql + (16 * mt + r16) * 136 + ks * 32 + g * 8), sb[ks], c);
#pragma unroll
            for (int ks = 0; ks < 2; ++ks) c = MFMA16(*(LAS bf16x8*)(Al + (16 * mt + r16) * 72 + ks * 32 + g * 8), vb[ks], c);
            oa[mt] = c;
        }
#pragma unroll
        for (int nt = 0; nt < 8; ++nt) {
            f32x4 c = st[nt] * last;
#pragma unroll
            for (int ks = 0; ks < 2; ++ks) c = MFMA16(vb[ks], *(LAS bf16x8*)(KT + (16 * nt + r16) * 72 + ks * 32 + g * 8), c);
            st[nt] = c;
        }
#pragma unroll
        for (int mt = 0; mt < 4; ++mt)
#pragma unroll
            for (int i = 0; i < 4; ++i) {
                float p = oa[mt][i] * oa[mt][i];
                p += __shfl_xor(p, 1); p += __shfl_xor(p, 2); p += __shfl_xor(p, 4); p += __shfl_xor(p, 8);
                if (r16 == 0) ssq[(16 * mt + 4 * g + i) * 8 + wid] = p;
            }
        __syncthreads();
#pragma unroll
        for (int mt = 0; mt < 4; ++mt)
#pragma unroll
            for (int i = 0; i < 4; ++i) {
                const int tok = 16 * mt + 4 * g + i;
                const f32x4 s0 = *(LAS f32x4*)(ssq + tok * 8), s1 = *(LAS f32x4*)(ssq + tok * 8 + 4);
                const float rstd = rsqrtf((s0[0] + s0[1] + s0[2] + s0[3] + s1[0] + s1[1] + s1[2] + s1[3]) * (1.f / 128.f) + EPS);
                z[(size_t)(R0 + tok) * ZLD + ZG + h * 128 + dvc] = f2bf(oa[mt][i] * rstd * ow * silu(gg[mt * 4 + i]));
            }
    }
#undef SCAN_LOAD
    float* So = a.out + OFF_GSP + (size_t)(b * 8 + h) * 16384;
#pragma unroll
    for (int nt = 0; nt < 8; ++nt) *(f32x4*)(So + (size_t)(16 * nt + r16) * 128 + 16 * wid + 4 * g) = st[nt];
}

DI void swa_prompt_item(const Args& a, LAS unsigned char* lds, int it) {
    const int tid = otid(), lane = tid & 63, wid = tid >> 6, r16 = lane & 15, g = lane >> 4;
    const int b = it >> 6, kvh = (it >> 4) & 3, n = it & 15;
    u16* z = (u16*)(a.ws + WS_Z);
    LAS u16* Kl = (LAS u16*)lds;
    LAS u16* VTl = Kl + 256 * 72;
    LAS u16* Pl = VTl + 64 * 280 + wid * (16 * 168);
#pragma unroll
    for (int i = 0; i < 4; ++i) {
        const int p = tid + 512 * i, key = p >> 3, d8 = (p & 7) * 8, srow = (n - 1) * 128 + key;
        u32x4 kv = (u32x4){0u, 0u, 0u, 0u}, vv = kv;
        if (srow >= 0) { const u16* base = z + (size_t)(b * 2048 + srow) * ZLD + kvh * 64 + d8; kv = *(const u32x4*)(base + ZSK); vv = *(const u32x4*)(base + ZSV); }
        *(LAS u32x4*)(Kl + key * 72 + d8) = kv;
        const unsigned e[4] = {vv.x, vv.y, vv.z, vv.w};
#pragma unroll
        for (int j = 0; j < 4; ++j) { VTl[(d8 + 2 * j) * 280 + key] = (u16)(e[j] & 0xFFFFu); VTl[(d8 + 2 * j + 1) * 280 + key] = (u16)(e[j] >> 16); }
    }
    for (int idx = tid; idx < 1536; idx += 512) { const int d = idx / 24; VTl[d * 280 + 256 + (idx - d * 24)] = 0; }
    __syncthreads();
    const int gq = wid >> 1, th = wid & 1, qh = kvh * 4 + gq;
    const float sink = a.in[19][qh];
#pragma unroll 1
    for (int mtl = 0; mtl < 4; ++mtl) {
        const int mt = th * 4 + mtl, tq0 = 16 * mt;
        const size_t rowA = (size_t)(b * 2048 + n * 128 + tq0);
        bf16x8 qf[2];
#pragma unroll
        for (int ks = 0; ks < 2; ++ks) qf[ks] = *(const bf16x8*)(z + (rowA + r16) * ZLD + ZSQ + qh * 64 + ks * 32 + g * 8);
        f32x4 sc[9];
#pragma unroll
        for (int j = 0; j < 9; ++j) {
            f32x4 c = zero4();
#pragma unroll
            for (int ks = 0; ks < 2; ++ks) c = MFMA16(qf[ks], *(LAS bf16x8*)(Kl + (16 * (mt + j) + r16) * 72 + ks * 32 + g * 8), c);
            sc[j] = c;
        }
        float mx[4], sm[4];
#pragma unroll
        for (int i = 0; i < 4; ++i) mx[i] = sink;
#pragma unroll
        for (int j = 0; j < 9; ++j)
#pragma unroll
            for (int i = 0; i < 4; ++i) {
                const int tq = tq0 + 4 * g + i, kk = 16 * (mt + j) + r16;
                const bool valid = (kk > tq) && (kk <= tq + 128) && (n > 0 || kk >= 128);
                const float sv = valid ? sc[j][i] * 0.125f : -1e30f;
                sc[j][i] = sv; mx[i] = fmaxf(mx[i], sv);
            }
#pragma unroll
        for (int i = 0; i < 4; ++i) {
            float m = mx[i];
            m = fmaxf(m, __shfl_xor(m, 1)); m = fmaxf(m, __shfl_xor(m, 2)); m = fmaxf(m, __shfl_xor(m, 4)); m = fmaxf(m, __shfl_xor(m, 8));
            mx[i] = m; sm[i] = 0.f;
        }
#pragma unroll
        for (int j = 0; j < 9; ++j)
#pragma unroll
            for (int i = 0; i < 4; ++i) {
                const float p = (sc[j][i] > -1e29f) ? __expf(sc[j][i] - mx[i]) : 0.f;
                sm[i] += p;
                Pl[(4 * g + i) * 168 + 16 * j + r16] = f2bf(p);
            }
#pragma unroll
        for (int i = 0; i < 4; ++i) {
            Pl[(4 * g + i) * 168 + 144 + r16] = 0;
            float s = sm[i];
            s += __shfl_xor(s, 1); s += __shfl_xor(s, 2); s += __shfl_xor(s, 4); s += __shfl_xor(s, 8);
            sm[i] = 1.f / (s + __expf(sink - mx[i]));
        }
        f32x4 o[4];
#pragma unroll
        for (int nd = 0; nd < 4; ++nd) o[nd] = zero4();
#pragma unroll
        for (int ks = 0; ks < 5; ++ks) {
            const bf16x8 pa = *(LAS bf16x8*)(Pl + r16 * 168 + ks * 32 + g * 8);
#pragma unroll
            for (int nd = 0; nd < 4; ++nd) o[nd] = MFMA16(pa, *(LAS bf16x8*)(VTl + (16 * nd + r16) * 280 + 16 * mt + ks * 32 + g * 8), o[nd]);
        }
#pragma unroll
        for (int nd = 0; nd < 4; ++nd)
#pragma unroll
            for (int i = 0; i < 4; ++i) z[(rowA + 4 * g + i) * ZLD + ZSQ + qh * 64 + 16 * nd + r16] = f2bf(o[nd][i] * sm[i]);
    }
    __syncthreads();
}

DI void swa_sample_item(const Args& a, LAS unsigned char* lds, int it) {
    const int tid = otid(), lane = tid & 63, wid = tid >> 6;
    const int b = it >> 2, kvh = it & 3;
    u16* z = (u16*)(a.ws + WS_Z);
    u16* zr = z + (size_t)(NP + b) * ZLD;
    LAS float* ql = (LAS float*)lds;
    LAS float* pl = ql + 256;
    LAS float* red = pl + 512;
    LAS float* po = red + 16;
    if (tid < 256) ql[tid] = bf2f(zr[ZSQ + kvh * 256 + tid]);
    __syncthreads();
    const int gq = tid >> 7, key = tid & 127;
    float s = 0.f;
    if (key < 127) {
        const float* kp = a.in[6] + ((size_t)(b * 128 + key + 1) * 4 + kvh) * 64;
#pragma unroll
        for (int d = 0; d < 64; d += 4) { const f32x4 kv = *(const f32x4*)(kp + d); s += ql[gq * 64 + d] * kv[0] + ql[gq * 64 + d + 1] * kv[1] + ql[gq * 64 + d + 2] * kv[2] + ql[gq * 64 + d + 3] * kv[3]; }
    } else {
#pragma unroll
        for (int d = 0; d < 64; ++d) s += ql[gq * 64 + d] * bf2f(zr[ZSK + kvh * 64 + d]);
    }
    s *= 0.125f;
    const float sink = a.in[19][kvh * 4 + gq];
    float m = s;
#pragma unroll
    for (int o = 1; o < 64; o <<= 1) m = fmaxf(m, __shfl_xor(m, o));
    if (lane == 0) red[wid] = m;
    __syncthreads();
    m = fmaxf(fmaxf(red[2 * gq], red[2 * gq + 1]), sink);
    const float p = __expf(s - m);
    float ps = p;
#pragma unroll
    for (int o = 1; o < 64; o <<= 1) ps += __shfl_xor(ps, o);
    if (lane == 0) red[8 + wid] = ps;
    __syncthreads();
    const float den = red[8 + 2 * gq] + red[8 + 2 * gq + 1] + __expf(sink - m);
    pl[gq * 128 + key] = p / den;
    __syncthreads();
    const int half = (tid >> 6) & 1, d = tid & 63;
    float acc = 0.f;
#pragma unroll 4
    for (int kk = 0; kk < 64; ++kk) {
        const int kx = half * 64 + kk;
        const float vv = (kx < 127) ? a.in[7][((size_t)(b * 128 + kx + 1) * 4 + kvh) * 64 + d] : bf2f(zr[ZSV + kvh * 64 + d]);
        acc += pl[gq * 128 + kx] * vv;
    }
    po[tid] = acc;
    __syncthreads();
    if (half == 0) zr[ZSQ + (kvh * 4 + gq) * 64 + d] = f2bf(po[tid] + po[tid + 64]);
    __syncthreads();
}

DI void gdn_sample_item(const Args& a, LAS unsigned char* lds, int it) {
    const int tid = otid(), lane = tid & 63, wid = tid >> 6;
    const int b = it >> 3, h = it & 7, row = NP + b;
    u16* zr = (u16*)(a.ws + WS_Z) + (size_t)row * ZLD;
    const float* zb = (const float*)(a.ws + WS_ZB) + (size_t)row * 16;
    const float* cw = a.in[14];
    LAS float* act = (LAS float*)lds;
    LAS float* nrm = act + 384;
    LAS float* pkl = act + 512;
    LAS float* pql = pkl + 2048;
    if (tid < 384) {
        const int col = (tid >> 7) * 1024 + h * 128 + (tid & 127);
        float x = cw[3 * 3072 + col] * bf2f(zr[col]);
#pragma unroll
        for (int j = 0; j < 3; ++j) x += cw[j * 3072 + col] * a.in[5][((size_t)b * 3 + j) * 3072 + col];
        act[tid] = silu(x);
    }
    __syncthreads();
    if (wid < 3) {
        const int o0 = wid == 2 ? 0 : wid * 128, o1 = wid == 2 ? 128 : wid * 128;
        float ss = act[o0 + lane] * act[o1 + lane] + act[o0 + 64 + lane] * act[o1 + 64 + lane];
#pragma unroll
        for (int o = 1; o < 64; o <<= 1) ss += __shfl_xor(ss, o);
        if (lane == 0) nrm[wid] = ss;
    }
    __syncthreads();
    const float qs = rsqrtf(nrm[0] + EPS) * 0.08838834764831845f, ksc = rsqrtf(nrm[1] + EPS), qk = nrm[2] * qs * ksc;
    const float beta = sigm(zb[h]);
    const float eg = __expf(-__expf(a.in[15][h]) * softplus(zb[8 + h] + a.in[16][h]));
    const int dv4 = (tid & 31) * 4, dk0 = tid >> 5;
    const float* S0 = a.in[4] + (size_t)(b * 8 + h) * 16384;
    float* S1 = a.out + OFF_GSS + (size_t)(b * 8 + h) * 16384;
    f32x4 sd[8], pk = zero4(), pq = zero4();
#pragma unroll
    for (int i = 0; i < 8; ++i) {
        const int dk = dk0 + 16 * i;
        sd[i] = *(const f32x4*)(S0 + (size_t)dk * 128 + dv4) * eg;
        pk += sd[i] * (act[128 + dk] * ksc); pq += sd[i] * (act[dk] * qs);
    }
    *(LAS f32x4*)(pkl + dk0 * 128 + dv4) = pk; *(LAS f32x4*)(pql + dk0 * 128 + dv4) = pq;
    __syncthreads();
    f32x4 ksum = zero4(), qsum = zero4();
#pragma unroll
    for (int r = 0; r < 16; ++r) { ksum += *(LAS f32x4*)(pkl + r * 128 + dv4); qsum += *(LAS f32x4*)(pql + r * 128 + dv4); }
    f32x4 delta;
#pragma unroll
    for (int c = 0; c < 4; ++c) delta[c] = (act[256 + dv4 + c] - ksum[c]) * beta;
#pragma unroll
    for (int i = 0; i < 8; ++i) { const int dk = dk0 + 16 * i; *(f32x4*)(S1 + (size_t)dk * 128 + dv4) = sd[i] + delta * (act[128 + dk] * ksc); }
    if (tid < 32) {
        const f32x4 o = qsum + delta * qk;
        float ss = o[0] * o[0] + o[1] * o[1] + o[2] * o[2] + o[3] * o[3];
#pragma unroll
        for (int m = 1; m < 32; m <<= 1) ss += __shfl_xor(ss, m);
        const float rstd = rsqrtf(ss * (1.f / 128.f) + EPS);
        u16* gp = zr + ZG + h * 128 + dv4;
        const u32x2 gv = *(const u32x2*)gp;
        const float g0 = bflo(gv.x), g1 = bfhi(gv.x), g2 = bflo(gv.y), g3 = bfhi(gv.y);
        const f32x4 w = *(const f32x4*)(a.in[17] + dv4);
        *(u32x2*)gp = (u32x2){pack2(o[0] * rstd * w[0] * silu(g0), o[1] * rstd * w[1] * silu(g1)), pack2(o[2] * rstd * w[2] * silu(g2), o[3] * rstd * w[3] * silu(g3))};
    }
    __syncthreads();
}

DI void state_copies(const Args& a, int vt, int nvt) {
    const u16* z = (const u16*)(a.ws + WS_Z);
    const u16* halo = (const u16*)(a.ws + WS_HALO);
    float* out = a.out;
    for (int i = vt; i < 8 * 3 * 3072; i += nvt) { const int b = i / 9216, r = i - b * 9216; out[OFF_GCP + i] = bf2f(halo[(size_t)((b * 32 + 31) * 3) * 3072 + r]); }
    for (int i = vt; i < 128 * 3 * 3072; i += nvt) {
        const int b = i / 9216, r = i - b * 9216, j = r / 3072, c = r - j * 3072;
        out[OFF_GCS + i] = (j < 2) ? a.in[5][((size_t)b * 3 + j + 1) * 3072 + c] : bf2f(z[(size_t)(NP + b) * ZLD + c]);
    }
    for (int i = vt; i < 8 * 128 * 256; i += nvt) {
        const int b = i >> 15, w = (i >> 8) & 127, c = i & 255;
        const u16* zr = z + (size_t)(b * 2048 + 1920 + w) * ZLD;
        out[OFF_KP + i] = bf2f(zr[ZSK + c]); out[OFF_VP + i] = bf2f(zr[ZSV + c]);
    }
    for (int i = vt; i < 128 * 128 * 64; i += nvt) {
        const int b = i >> 13, w = (i >> 6) & 127, c = (i & 63) * 4;
        f32x4 kv, vv;
        if (w < 127) { const size_t o = ((size_t)b * 128 + w + 1) * 256 + c; kv = *(const f32x4*)(a.in[6] + o); vv = *(const f32x4*)(a.in[7] + o); }
        else { const u16* zr = z + (size_t)(NP + b) * ZLD;
            kv = (f32x4){bf2f(zr[ZSK + c]), bf2f(zr[ZSK + c + 1]), bf2f(zr[ZSK + c + 2]), bf2f(zr[ZSK + c + 3])};
            vv = (f32x4){bf2f(zr[ZSV + c]), bf2f(zr[ZSV + c + 1]), bf2f(zr[ZSV + c + 2]), bf2f(zr[ZSV + c + 3])}; }
        *(f32x4*)(out + OFF_KS + (size_t)i * 4) = kv; *(f32x4*)(out + OFF_VS + (size_t)i * 4) = vv;
    }
}

__global__ void __launch_bounds__(512, 2) fwd_megakernel(Args a) {
    extern __shared__ __attribute__((aligned(16))) unsigned char smem[];
    LAS unsigned char* lds = (LAS unsigned char*)smem;
    cg::grid_group grid = cg::this_grid();
    u16* H = (u16*)(a.ws + WS_H);
    u16* Z = (u16*)(a.ws + WS_Z);
    phase0(a, lds);
    grid.sync();
    phase_norm<0>(a);
    grid.sync();
    { EpiZ e; e.z = Z; e.gab = (u16*)a.out; e.zb = (float*)(a.ws + WS_ZB); e.halo = (u16*)(a.ws + WS_HALO);
      run_gemm(lds, H, 1024, (const u16*)(a.ws + WS_RA), 1024, N1, 1024, e); }
    grid.sync();
    phase_prep(a, lds);
    grid.sync();
    if (blockIdx.x < 64) phase_scan(a, lds, blockIdx.x);
    else {
        const int v = blockIdx.x - 64, nv = gridDim.x - 64;
        for (int it = v; it < 512; it += nv) swa_prompt_item(a, lds, it);
        for (int it = v; it < 1024; it += nv) gdn_sample_item(a, lds, it);
        for (int it = v; it < 512; it += nv) swa_sample_item(a, lds, it);
        state_copies(a, v * 512 + otid(), nv * 512);
    }
    grid.sync();
    { EpiMix<0> e; e.mix = H; e.gab = (const u16*)a.out; run_gemm(lds, Z + ZG, ZLD, (const u16*)(a.ws + WS_WA), 1024, 1024, 1024, e); }
    { EpiMix<1> e; e.mix = H; e.gab = (const u16*)a.out; run_gemm(lds, Z + ZSQ, ZLD, (const u16*)(a.ws + WS_WB), 1024, 1024, 1024, e); }
    grid.sync();
    { EpiRes<0> e; e.out = a.out; e.xp = a.in[0]; e.xs = a.in[1]; e.mod = (const float*)(a.ws + WS_MOD); run_gemm(lds, H, 1024, (const u16*)(a.ws + WS_WO), 1024, 1024, 1024, e); }
    grid.sync();
    phase_norm<1>(a);
    grid.sync();
    { EpiPlain e; e.o = Z; e.ld = FF; run_gemm(lds, H, 1024, (const u16*)(a.ws + WS_WG), 1024, FF, 1024, e); }
    { EpiPlain e; e.o = Z + (size_t)MP * FF; e.ld = FF; run_gemm(lds, H, 1024, (const u16*)(a.ws + WS_WU), 1024, FF, 1024, e); }
    grid.sync();
    phase_act(a);
    grid.sync();
    { EpiRes<1> e; e.out = a.out; e.xp = a.in[0]; e.xs = a.in[1]; e.mod = (const float*)(a.ws + WS_MOD); run_gemm(lds, Z + (size_t)MP * FF, FF, (const u16*)(a.ws + WS_WD), FF, 1024, FF, e); }
    grid.sync();
    phase_final(a);
}

extern "C" void kernel_launch(void* const* d_in, const int* in_sizes, int n_in, void* d_out, int out_size, void* d_ws, size_t ws_size, hipStream_t stream) {
    static int grid = 0;
    if (grid == 0) {
        if (n_in != 28 || ws_size < WS_END) { fprintf(stderr, "kernel_launch: expected 28 inputs and >= %zu bytes of workspace (got %d, %zu)\n", (size_t)WS_END, n_in, ws_size); grid = -1; return; }
        int dev = 0, cus = 0, per_cu = 0;
        hipGetDevice(&dev);
        hipDeviceGetAttribute(&cus, hipDeviceAttributeMultiprocessorCount, dev);
        if (hipFuncSetAttribute((const void*)fwd_megakernel, hipFuncAttributeMaxDynamicSharedMemorySize, LDS_BYTES) != hipSuccess) { fprintf(stderr, "kernel_launch: hipFuncSetAttribute failed\n"); grid = -1; return; }
        hipOccupancyMaxActiveBlocksPerMultiprocessor(&per_cu, (const void*)fwd_megakernel, 512, LDS_BYTES);
        if (per_cu < 1) fprintf(stderr, "kernel_launch: occupancy query says %d blocks per CU\n", per_cu);
        (void)hipGetLastError();
        grid = cus;
    }
    if (grid < 0) return;
    Args a{};
    for (int i = 0; i < 28; ++i) a.in[i] = (const float*)d_in[i];
    a.out = (float*)d_out; a.ws = (unsigned char*)d_ws;
    void* args[] = {&a};
    hipError_t e = hipLaunchCooperativeKernel((const void*)fwd_megakernel, dim3(grid), dim3(512), args, LDS_BYTES, stream);
    if (e != hipSuccess) fprintf(stderr, "cooperative launch failed: %s (grid %d)\n", hipGetErrorString(e), grid);
}
```

```cpp
#include <hip/hip_runtime.h>
#include <hip/hip_cooperative_groups.h>
#include <cstdio>
namespace cg = cooperative_groups;
__device__ __forceinline__ int otid() { int t = threadIdx.x; asm volatile("" : "+v"(t)); return t; }
namespace pg8 {
#define PG8_LAS __attribute__((address_space(3)))
typedef unsigned short bf16_t;
typedef short bf16x8 __attribute__((ext_vector_type(8)));
typedef float f32x4 __attribute__((ext_vector_type(4)));
typedef unsigned u32x4 __attribute__((ext_vector_type(4)));
constexpr int BM = 256, BK = 64, HALF = 128, HTB = HALF * BK * 2  , STAGE_BYTES = 8 * HTB, NXCD = 8, WGM = 8;

__host__ __device__ __forceinline__ int lds_byte(int r, int c) { const int st = (r >> 4) * 2 + (c >> 5), rr = r & 15, cc = c & 31, ob = rr * 64 + cc * 2; return st * 1024 + (ob ^ (((ob >> 9) & 1) << 5)); }
__host__ __device__ __forceinline__ void stage_rc(int b, int& R, int& C) { const int st = b / 1024, sb = b % 1024, swz = sb ^ (((sb >> 9) & 1) << 5); R = (st >> 1) * 16 + swz / 64; C = (st & 1) * 32 + (swz % 64) / 2; }
__host__ __device__ __forceinline__ int perm32(int rho) { const int n = rho >> 4, i = rho & 15; return 8 * (i >> 2) + 4 * n + (i & 3); }

struct Unit { int pm, pn, sel = 0; };
struct Gemm { const bf16_t* A; const bf16_t* Bt; int M, N, K, lda, ldb; const bf16_t* A2 = nullptr; const bf16_t* Bt2 = nullptr; };

struct StaticOrder {
    int nM, nN, nwg, G, c;
    __host__ __device__ void init(int M, int N, int G_, int c_) { nM = M / BM; nN = N / BM; nwg = nM * nN; G = G_; c = c_; }
    __host__ __device__ bool next(int i, Unit& u) const {
        const long L = (long)i * G + c; if (L >= nwg) return false;
        int wgid = (int)L; { const int q = nwg / NXCD, r = nwg % NXCD, xcd = wgid % NXCD, off = wgid / NXCD; wgid = (xcd < r ? xcd * (q + 1) : r * (q + 1) + (xcd - r) * q) + off; }
        const int nig = WGM * nN, gid = wgid / nig, fm = gid * WGM, gsz = (nM - fm) < WGM ? (nM - fm) : WGM;
        u.pm = fm + ((wgid % nig) % gsz); u.pn = (wgid % nig) / gsz; return true;
    }
    __device__ __forceinline__ void a_ready(const Unit&) const {}
    __device__ __forceinline__ void done(const Unit&) const {}
};

template <class Epi, class Sched, bool STAMP = false>
__device__ __forceinline__ void gemm_phase(PG8_LAS unsigned char* lds, const Gemm g, const Sched& S, const Epi& E, unsigned long long* stamps) {
    const int tid = otid(), wid = __builtin_amdgcn_readfirstlane(tid >> 6), lane = tid & 63, wr = wid >> 2, wc = wid & 3, fr = lane & 15, fq = lane >> 4;
    const int K = g.K, nt = K / BK;
    int ts_lo = 0, ts_hi = 0, nts = 0; const unsigned long long rt_entry = STAMP ? (unsigned long long)wall_clock64() : 0ull;
#define PG8_STAMP() do { if (STAMP && wid == 0 && nts < 64) { const unsigned long long _c = (unsigned long long)clock64(); \
        ts_lo = (lane == nts) ? (int)(unsigned)_c : ts_lo; ts_hi = (lane == nts) ? (int)(unsigned)(_c >> 32) : ts_hi; ++nts; } } while (0)
    PG8_STAMP();
    unsigned voffA[2], voffB[2];
#pragma unroll
    for (int i = 0; i < 2; ++i) { int R, C; stage_rc(tid * 16 + i * 8192, R, C); const int Rb = Epi::PERM ? ((R & ~31) + perm32(R & 31)) : R;
        voffA[i] = (unsigned)(R * g.lda + C) * 2u; voffB[i] = (unsigned)(Rb * g.ldb + C) * 2u; }
    const size_t kstep = (size_t)(BK * 2);
    const size_t hstepA = (size_t)HALF * g.lda * 2, hstepB = (size_t)HALF * g.ldb * 2;
    const size_t tstepA = 2 * hstepA, tstepB = 2 * hstepB;
    const unsigned ldsw = (unsigned)wid * 1024u;
    const int aoff = lds_byte(wr * 64 + fr, fq * 8), boff = lds_byte(wc * 32 + fr, fq * 8);
#define PG8_SA(b, h) (((b) * 2 + (h)) * HTB)
#define PG8_SB(b, h) ((4 + (b) * 2 + (h)) * HTB)
#define PG8_STAGE(bufoff, gbase, voff) do { _Pragma("unroll") for (int _i = 0; _i < 2; ++_i) \
        __builtin_amdgcn_global_load_lds((const unsigned*)((const char*)(gbase) + (voff)[_i]), (PG8_LAS unsigned*)(lds + (bufoff) + ldsw + _i * 8192), 16, 0, 0); } while (0)
#define PG8_LDA(dst, b, h) do { _Pragma("unroll") for (int m = 0; m < 4; ++m) _Pragma("unroll") for (int k = 0; k < 2; ++k) dst[m][k] = *(const PG8_LAS bf16x8*)(lds + PG8_SA(b, h) + aoff + m * 2048 + k * 1024); } while (0)
#define PG8_LDB(dst, b, h) do { _Pragma("unroll") for (int n = 0; n < 2; ++n) _Pragma("unroll") for (int k = 0; k < 2; ++k) dst[n][k] = *(const PG8_LAS bf16x8*)(lds + PG8_SB(b, h) + boff + n * 2048 + k * 1024); } while (0)
#define PG8_MMA(ai, bj, At, Bt) do { __builtin_amdgcn_s_setprio(1); _Pragma("unroll") for (int m = 0; m < 4; ++m) _Pragma("unroll") for (int n = 0; n < 2; ++n) _Pragma("unroll") for (int k = 0; k < 2; ++k) \
        acc[ai][bj][m][n] = __builtin_amdgcn_mfma_f32_16x16x32_bf16(Bt[n][k], At[m][k], acc[ai][bj][m][n], 0, 0, 0); __builtin_amdgcn_s_setprio(0); } while (0)
#define PG8_WAIT_V(n) asm volatile("s_waitcnt vmcnt(" #n ")" ::: "memory")
#define PG8_WAIT_L(n) asm volatile("s_waitcnt lgkmcnt(" #n ")" ::: "memory")
#define PG8_BAR __builtin_amdgcn_s_barrier()
#define PG8_SCHED __builtin_amdgcn_sched_barrier(0)
    Unit cur, nxt; int ui = 0;
    if (!S.next(0, cur)) return;
    f32x4 acc[2][2][4][2];
#pragma unroll
    for (int a = 0; a < 2; ++a)
#pragma unroll
        for (int b = 0; b < 2; ++b)
#pragma unroll
            for (int m = 0; m < 4; ++m)
#pragma unroll
                for (int n = 0; n < 2; ++n) acc[a][b][m][n] = (f32x4){0.f, 0.f, 0.f, 0.f};
    bf16x8 At[4][2], B0[2][2], B1[2][2];
    const char* cA = (const char*)(cur.sel ? g.A2 : g.A) + (size_t)cur.pm * tstepA; const char* cB = (const char*)(cur.sel ? g.Bt2 : g.Bt) + (size_t)cur.pn * tstepB;
    S.a_ready(cur);
    PG8_STAGE(PG8_SB(0, 0), cB, voffB); PG8_STAGE(PG8_SA(0, 0), cA, voffA); PG8_STAGE(PG8_SB(0, 1), cB + hstepB, voffB); PG8_STAGE(PG8_SA(0, 1), cA + hstepA, voffA);
    if (wr == 1) PG8_BAR;
    PG8_WAIT_V(4); PG8_BAR;
    PG8_STAGE(PG8_SB(1, 0), cB + kstep, voffB); PG8_STAGE(PG8_SA(1, 0), cA + kstep, voffA); PG8_STAGE(PG8_SB(1, 1), cB + hstepB + kstep, voffB);
    PG8_WAIT_V(6); PG8_BAR;
    PG8_STAMP();
    for (;;) {
        const bool has_next = S.next(ui + 1, nxt);
        const char* nA = has_next ? (const char*)(nxt.sel ? g.A2 : g.A) + (size_t)nxt.pm * tstepA : cA; const char* nB = has_next ? (const char*)(nxt.sel ? g.Bt2 : g.Bt) + (size_t)nxt.pn * tstepB : cB;
        for (int t = 0; t < nt; t += 2) {
            const bool last = (t == nt - 2);
            const char* a1 = cA + (size_t)(t + 1) * kstep;
            const char* a2 = last ? nA : cA + (size_t)(t + 2) * kstep; const char* b2 = last ? nB : cB + (size_t)(t + 2) * kstep;
            const char* a3 = a2 + kstep; const char* b3 = b2 + kstep;
            if (last && has_next) S.a_ready(nxt);
            PG8_LDB(B0, 0, 0); PG8_SCHED; PG8_LDA(At, 0, 0); PG8_STAGE(PG8_SA(1, 1), a1 + hstepA, voffA);
            PG8_WAIT_L(8); PG8_BAR; PG8_WAIT_L(0); PG8_MMA(0, 0, At, B0); PG8_BAR; PG8_SCHED;
            PG8_LDB(B1, 0, 1); PG8_STAGE(PG8_SB(0, 0), b2, voffB);
            PG8_BAR; PG8_WAIT_L(0); PG8_MMA(0, 1, At, B1); PG8_BAR;
            PG8_LDA(At, 0, 1); PG8_STAGE(PG8_SA(0, 0), a2, voffA);
            PG8_BAR; PG8_WAIT_L(0); PG8_MMA(1, 0, At, B0); PG8_BAR; PG8_SCHED;
            PG8_STAGE(PG8_SB(0, 1), b2 + hstepB, voffB);
            PG8_WAIT_V(6); PG8_BAR; PG8_MMA(1, 1, At, B1); PG8_BAR;
            PG8_LDB(B0, 1, 0); PG8_SCHED; PG8_LDA(At, 1, 0); PG8_STAGE(PG8_SA(0, 1), a2 + hstepA, voffA);
            PG8_WAIT_L(8); PG8_BAR; PG8_WAIT_L(0); PG8_MMA(0, 0, At, B0); PG8_BAR; PG8_SCHED;
            PG8_LDB(B1, 1, 1); PG8_STAGE(PG8_SB(1, 0), b3, voffB);
            PG8_BAR; PG8_WAIT_L(0); PG8_MMA(0, 1, At, B1); PG8_BAR;
            PG8_LDA(At, 1, 1); PG8_STAGE(PG8_SA(1, 0), a3, voffA);
            PG8_BAR; PG8_WAIT_L(0); PG8_MMA(1, 0, At, B0); PG8_BAR; PG8_SCHED;
            PG8_STAGE(PG8_SB(1, 1), b3 + hstepB, voffB);
            PG8_WAIT_V(6); PG8_BAR; PG8_MMA(1, 1, At, B1); PG8_BAR;
        }
        PG8_STAMP();
        if constexpr (!Epi::AFTER_DRAIN) { E(acc, cur, wr, wc, fr, fq); S.done(cur); }
        PG8_STAMP();
        if (!has_next) break;
#pragma unroll
        for (int a = 0; a < 2; ++a)
#pragma unroll
            for (int b = 0; b < 2; ++b)
#pragma unroll
                for (int m = 0; m < 4; ++m)
#pragma unroll
                    for (int n = 0; n < 2; ++n) acc[a][b][m][n] = (f32x4){0.f, 0.f, 0.f, 0.f};
        cur = nxt; cA = nA; cB = nB; ++ui;
    }
    PG8_WAIT_V(0);
    if (wr == 0) PG8_BAR;
    PG8_BAR;
    if constexpr (Epi::AFTER_DRAIN) { E.fused(acc, cur, wr, wc, fr, fq, lds, wid, lane); S.done(cur); }
    PG8_STAMP();
    if (STAMP && wid == 0) { stamps[lane] = lane < nts ? (((unsigned long long)(unsigned)ts_hi << 32) | (unsigned)ts_lo) : 0ull;
        if (lane == 62) stamps[62] = rt_entry; if (lane == 63) stamps[63] = (unsigned long long)wall_clock64(); }
#undef PG8_STAMP
#undef PG8_SA
#undef PG8_SB
#undef PG8_STAGE
#undef PG8_LDA
#undef PG8_LDB
#undef PG8_MMA
#undef PG8_WAIT_V
#undef PG8_WAIT_L
#undef PG8_BAR
#undef PG8_SCHED
}
}


typedef unsigned short u16;
typedef short bf16x8 __attribute__((ext_vector_type(8)));
typedef float f32x4 __attribute__((ext_vector_type(4)));
typedef unsigned u32x4 __attribute__((ext_vector_type(4)));
typedef unsigned u32x2 __attribute__((ext_vector_type(2)));
#define LAS __attribute__((address_space(3)))
#define DI __device__ __forceinline__
#define MFMA16(a, b, c) __builtin_amdgcn_mfma_f32_16x16x32_bf16((a), (b), (c), 0, 0, 0)

#define XB_TMO      128
#define XB_XCNT(j)  (256  + 64 * (j))
#define XB_XSUB(j)  (1280 + 64 * (j))
#define XB_XGEN(j)  (2304 + 64 * (j))
#define XB_TOP      3328
#define XB_TOPGEN   3392
#define XCD_BAR_WORDS 3456
#define XB_SPIN_CAP (1u << 18)

__device__ __forceinline__ unsigned xb_ld(unsigned* p)              { return __hip_atomic_load(p, __ATOMIC_RELAXED, __HIP_MEMORY_SCOPE_AGENT); }
__device__ __forceinline__ unsigned xb_add(unsigned* p, unsigned v) { return __hip_atomic_fetch_add(p, v, __ATOMIC_RELAXED, __HIP_MEMORY_SCOPE_AGENT); }
__device__ __forceinline__ unsigned xb_xcc_id() { return (unsigned)__builtin_amdgcn_s_getreg((3 << 11) | 20) & 0xFu; }
#define XB_SPIN(cond, bar) do { unsigned _sp = 0; while (cond) { __builtin_amdgcn_s_sleep(1); \
    if ((++_sp & 255u) == 0u) { if (xb_ld(&(bar)[XB_TMO])) break; if (_sp > XB_SPIN_CAP) { atomicAdd(&(bar)[XB_TMO], 1u); break; } } } } while (0)

struct XcdBarrier {
    unsigned* bar; unsigned x;
    volatile LAS unsigned* st;
};

__device__ __forceinline__ XcdBarrier xcd_barrier_post(unsigned* bar, volatile LAS unsigned* st) {
    XcdBarrier b; b.bar = bar; b.x = xb_xcc_id(); b.st = st;
    if (threadIdx.x == 0) (void)xb_add(&bar[XB_XCNT(b.x)], 1u);
    return b;
}
__device__ __forceinline__ void xcd_barrier_complete(unsigned* bar, unsigned x, unsigned& nloc, unsigned& nx) {
    const unsigned G = gridDim.x * gridDim.y * gridDim.z;
    unsigned sum, cnt, mine, sp = 0u;
    for (;;) {
        sum = 0u; cnt = 0u; mine = 0u;
#pragma unroll
        for (unsigned j = 0; j < 16; ++j) { const unsigned c = xb_ld(&bar[XB_XCNT(j)]); sum += c; cnt += (c > 0u) ? 1u : 0u; mine = (j == x) ? c : mine; }
        if (sum == G) break;
        __builtin_amdgcn_s_sleep(1);
        if ((++sp & 255u) == 0u) { if (xb_ld(&bar[XB_TMO])) break; if (sp > XB_SPIN_CAP) { atomicAdd(&bar[XB_TMO], 1u); break; } }
    }
    nloc = mine > 0u ? mine : 1u; nx = cnt > 0u ? cnt : 1u;
}

__device__ __forceinline__ void xcd_barrier(const XcdBarrier& b) {
    asm volatile("s_waitcnt vmcnt(0)" ::: "memory");
    __syncthreads();
    if (threadIdx.x == 0) {
        unsigned* bar = b.bar;
        __builtin_amdgcn_s_waitcnt(0);
        unsigned nloc = b.st[0], nx = b.st[1];
        if (nloc == 0u) { xcd_barrier_complete(bar, b.x, nloc, nx); b.st[0] = nloc; b.st[1] = nx; }
        const unsigned old = xb_add(&bar[XB_XSUB(b.x)], 1u);
        const unsigned gen = old / nloc;
        if (old + 1u == (gen + 1u) * nloc) {
            __builtin_amdgcn_fence(__ATOMIC_RELEASE, "agent");
            asm volatile("s_waitcnt vmcnt(0)" ::: "memory");
            const unsigned og = xb_add(&bar[XB_TOP], 1u);
            const unsigned tg = og / nx;
            if (og + 1u == (tg + 1u) * nx) xb_add(&bar[XB_TOPGEN], 1u);
            else XB_SPIN(xb_ld(&bar[XB_TOPGEN]) == tg, bar);
            __builtin_amdgcn_fence(__ATOMIC_ACQUIRE, "agent");
            xb_add(&bar[XB_XGEN(b.x)], 1u);
            asm volatile("s_waitcnt vmcnt(0)" ::: "memory");
        } else {
            XB_SPIN(xb_ld(&bar[XB_XGEN(b.x)]) == gen, bar);
            __builtin_amdgcn_fence(__ATOMIC_ACQUIRE, "agent");
            asm volatile("s_waitcnt vmcnt(0)" ::: "memory");
        }
    }
    __syncthreads();
}


constexpr int NP = 16384, NS = 128, NR = 16512, MP = 16640;
constexpr int ZLD = 5632, FF = 2816, N1 = 7936;
constexpr int ZQ = 0, ZK = 1024, ZV = 2048, ZG = 3072, ZSQ = 4096, ZSK = 5120, ZSV = 5376;
constexpr float EPS = 1e-6f;
constexpr size_t WS_RA = 0;
constexpr size_t WS_WA = WS_RA + 16777216;
constexpr size_t WS_WB = WS_WA + 2097152;
constexpr size_t WS_WO = WS_WB + 2097152;
constexpr size_t WS_WG = WS_WO + 2097152;
constexpr size_t WS_WU = WS_WG + 5767168;
constexpr size_t WS_WD = WS_WU + 5767168;
constexpr size_t WS_MOD = WS_WD + 5767168;
constexpr size_t WS_ZB = WS_MOD + 3342336;
constexpr size_t WS_HALO = WS_ZB + 1064960;
constexpr size_t WS_LAST = WS_HALO + 4718592;
constexpr size_t WS_H = WS_LAST + 8192;
constexpr size_t WS_Z = WS_H + 34078720;
constexpr size_t WS_BAR = WS_Z + 187432960;
constexpr size_t WS_END = WS_BAR + 16384;
constexpr size_t OFF_YS = 16777216, OFF_GSP = 16908288, OFF_GSS = 17956864, OFF_GCP = 34734080, OFF_GCS = 34807808, OFF_KP = 35987456,
                 OFF_KS = 36249600, OFF_VP = 40443904, OFF_VS = 40706048, OFF_FP = 44900352, OFF_FS = 44945408;
constexpr int LDS_BYTES = 155648, LDS_XB = 155632;

struct Args { const float* in[28]; float* out; unsigned char* ws; };

typedef __bf16 bf16x2_t __attribute__((ext_vector_type(2)));
typedef float f32x2_t __attribute__((ext_vector_type(2)));
DI unsigned pack2(float a, float b) { f32x2_t v = {a, b}; bf16x2_t r = __builtin_convertvector(v, bf16x2_t); return __builtin_bit_cast(unsigned, r); }
DI u16 f2bf(float f) { return (u16)(pack2(f, 0.f) & 0xFFFFu); }
DI float bf2f(u16 b) { return __uint_as_float(((unsigned)b) << 16); }
DI float bflo(unsigned w) { return __uint_as_float(w << 16); }
DI float bfhi(unsigned w) { return __uint_as_float(w & 0xFFFF0000u); }
DI float sigm(float x) { return __builtin_amdgcn_rcpf(1.f + __expf(-x)); }
DI float silu(float x) { return x * __builtin_amdgcn_rcpf(1.f + __expf(-x)); }
#define DPP_F(v, ctrl) __builtin_bit_cast(float, __builtin_amdgcn_update_dpp(0, __builtin_bit_cast(int, (v)), (ctrl), 0xF, 0xF, false))
DI float row_sum16(float v) { v += DPP_F(v, 0x128); v += DPP_F(v, 0x124); v += DPP_F(v, 0x122); v += DPP_F(v, 0x121); return v; }
DI float row_max16(float v) { v = fmaxf(v, DPP_F(v, 0x128)); v = fmaxf(v, DPP_F(v, 0x124)); v = fmaxf(v, DPP_F(v, 0x122)); v = fmaxf(v, DPP_F(v, 0x121)); return v; }
DI float softplus(float x) { return x > 20.f ? x : log1pf(__expf(x)); }
DI f32x4 zero4() { return (f32x4){0.f, 0.f, 0.f, 0.f}; }
DI u32x4 pack8(f32x4 a, f32x4 b) { u32x4 w; w.x = pack2(a[0], a[1]); w.y = pack2(a[2], a[3]); w.z = pack2(b[0], b[1]); w.w = pack2(b[2], b[3]); return w; }
DI int row_bidx(int row) { return row < NP ? (row >> 11) : 8 + row - NP; }

struct EpiZ {
    static constexpr bool PERM = true, AFTER_DRAIN = false;
    u16* z; u16* gab; float* zb; u16* halo;
    DI void operator()(const f32x4 (&acc)[2][2][4][2], const pg8::Unit& u, int wr, int wc, int fr, int fq) const {
        const int row0 = u.pm * 256 + wr * 64 + fr;
        if (u.pn < 22) {
            const int col0 = u.pn * 256 + wc * 32 + 8 * fq;
            const bool gatecols = (u.pn >= 12) && (u.pn < 16);
#pragma unroll
            for (int ai = 0; ai < 2; ++ai)
#pragma unroll
                for (int m = 0; m < 4; ++m) {
                    const int row = row0 + ai * 128 + m * 16;
                    u16* rowp = z + (size_t)row * ZLD + col0;
                    const bool hal = (u.pn < 12) && (row < NP) && ((row & 63) >= 61);
#pragma unroll
                    for (int bj = 0; bj < 2; ++bj) {
                        f32x4 v0 = acc[ai][bj][m][0], v1 = acc[ai][bj][m][1];
                        if (gatecols) {
#pragma unroll
                            for (int j = 0; j < 4; ++j) { v0[j] = silu(v0[j]); v1[j] = silu(v1[j]); }
                        }
                        const u32x4 w = pack8(v0, v1);
                        __builtin_nontemporal_store(w, (u32x4*)(rowp + bj * 128));
                        if (hal) *(u32x4*)(halo + ((size_t)(row >> 6) * 3 + ((row & 63) - 61)) * 3072 + col0 + bj * 128) = w;
                    }
                }
        } else if (u.pn < 30) {
            const int col0 = (u.pn - 22) * 256 + wc * 32 + 8 * fq;
#pragma unroll
            for (int ai = 0; ai < 2; ++ai)
#pragma unroll
                for (int m = 0; m < 4; ++m) {
                    const int row = row0 + ai * 128 + m * 16;
                    if (row < NR) {
                        u16* rowp = gab + (size_t)row * 2048 + col0;
#pragma unroll
                        for (int bj = 0; bj < 2; ++bj) *(u32x4*)(rowp + bj * 128) = pack8(acc[ai][bj][m][0], acc[ai][bj][m][1]);
                    }
                }
        } else if (wc == 0 && fq < 2) {
#pragma unroll
            for (int ai = 0; ai < 2; ++ai)
#pragma unroll
                for (int m = 0; m < 4; ++m) {
                    const int row = row0 + ai * 128 + m * 16;
#pragma unroll
                    for (int n = 0; n < 2; ++n) *(f32x4*)(zb + (size_t)row * 16 + 8 * fq + 4 * n) = acc[ai][0][m][n];
                }
        }
    }
};
template <int WHICH> struct EpiMix {
    static constexpr bool PERM = true, AFTER_DRAIN = false;
    u16* mix; const u16* gab;
    DI void operator()(const f32x4 (&acc)[2][2][4][2], const pg8::Unit& u, int wr, int wc, int fr, int fq) const {
        const int row0 = u.pm * 256 + wr * 64 + fr, col0 = u.pn * 256 + wc * 32 + 8 * fq;
#pragma unroll
        for (int ai = 0; ai < 2; ++ai)
#pragma unroll
            for (int mp = 0; mp < 4; mp += 2) {
                u32x4 gv[2][2], pv[2][2];
#pragma unroll
                for (int mm = 0; mm < 2; ++mm) {
                    const int row = row0 + ai * 128 + (mp + mm) * 16;
#pragma unroll
                    for (int bj = 0; bj < 2; ++bj) {
                        gv[mm][bj] = (u32x4){0u, 0u, 0u, 0u}; pv[mm][bj] = gv[mm][bj];
                        if (row < NR) gv[mm][bj] = *(const u32x4*)(gab + (size_t)row * 2048 + WHICH * 1024 + col0 + bj * 128);
                        if (WHICH == 1) pv[mm][bj] = *(const u32x4*)(mix + (size_t)row * 1024 + col0 + bj * 128);
                    }
                }
#pragma unroll
                for (int mm = 0; mm < 2; ++mm) {
                    const int row = row0 + ai * 128 + (mp + mm) * 16;
#pragma unroll
                    for (int bj = 0; bj < 2; ++bj) {
                        const u32x4 g_ = gv[mm][bj], p_ = pv[mm][bj];
                        f32x4 a0 = acc[ai][bj][mp + mm][0], a1 = acc[ai][bj][mp + mm][1];
                        a0[0] *= sigm(bflo(g_.x)); a0[1] *= sigm(bfhi(g_.x)); a0[2] *= sigm(bflo(g_.y)); a0[3] *= sigm(bfhi(g_.y));
                        a1[0] *= sigm(bflo(g_.z)); a1[1] *= sigm(bfhi(g_.z)); a1[2] *= sigm(bflo(g_.w)); a1[3] *= sigm(bfhi(g_.w));
                        if (WHICH == 1) {
                            a0[0] += bflo(p_.x); a0[1] += bfhi(p_.x); a0[2] += bflo(p_.y); a0[3] += bfhi(p_.y);
                            a1[0] += bflo(p_.z); a1[1] += bfhi(p_.z); a1[2] += bflo(p_.w); a1[3] += bfhi(p_.w);
                        }
                        *(u32x4*)(mix + (size_t)row * 1024 + col0 + bj * 128) = pack8(a0, a1);
                    }
                }
            }
    }
};
template <int WHICH> struct EpiRes {
    static constexpr bool PERM = false, AFTER_DRAIN = false;
    float* out; const float* xp; const float* xs; const float* mod;
    DI void operator()(const f32x4 (&acc)[2][2][4][2], const pg8::Unit& u, int wr, int wc, int fr, int fq) const {
        const int row0 = u.pm * 256 + wr * 64 + fr, col0 = u.pn * 256 + wc * 32 + 4 * fq;
        constexpr int GOFF = WHICH ? 5120 : 2048;
        if (u.pm < 64) {
            f32x4 gtv[2][2];
            const float* gt = mod + (size_t)(u.pm >> 3) * 6144 + GOFF + col0;
#pragma unroll
            for (int bj = 0; bj < 2; ++bj)
#pragma unroll
                for (int n = 0; n < 2; ++n) gtv[bj][n] = *(const f32x4*)(gt + bj * 128 + n * 16);
#pragma unroll
            for (int ai = 0; ai < 2; ++ai)
#pragma unroll
                for (int mp = 0; mp < 4; mp += 2) {
                    f32x4 xv[2][2][2];
#pragma unroll
                    for (int mm = 0; mm < 2; ++mm) {
                        const size_t ro = (size_t)(row0 + ai * 128 + (mp + mm) * 16) * 1024 + col0;
                        const float* xr = WHICH ? out + ro : xp + ro;
#pragma unroll
                        for (int bj = 0; bj < 2; ++bj)
#pragma unroll
                            for (int n = 0; n < 2; ++n) xv[mm][bj][n] = *(const f32x4*)(xr + bj * 128 + n * 16);
                    }
#pragma unroll
                    for (int mm = 0; mm < 2; ++mm) {
                        float* op = out + (size_t)(row0 + ai * 128 + (mp + mm) * 16) * 1024 + col0;
#pragma unroll
                        for (int bj = 0; bj < 2; ++bj)
#pragma unroll
                            for (int n = 0; n < 2; ++n) *(f32x4*)(op + bj * 128 + n * 16) = xv[mm][bj][n] + gtv[bj][n] * acc[ai][bj][mp + mm][n];
                    }
                }
        } else {
#pragma unroll
            for (int ai = 0; ai < 2; ++ai)
#pragma unroll
                for (int m = 0; m < 4; ++m) {
                    const int row = row0 + ai * 128 + m * 16;
                    if (row < NR) {
                        float* op = out + (size_t)row * 1024 + col0;
                        const float* xr = WHICH ? op : (xs + (size_t)(row - NP) * 1024 + col0);
                        const float* gt = mod + (size_t)row_bidx(row) * 6144 + GOFF + col0;
                        f32x4 xv[2][2], gv[2][2];
#pragma unroll
                        for (int bj = 0; bj < 2; ++bj)
#pragma unroll
                            for (int n = 0; n < 2; ++n) { xv[bj][n] = *(const f32x4*)(xr + bj * 128 + n * 16); gv[bj][n] = *(const f32x4*)(gt + bj * 128 + n * 16); }
#pragma unroll
                        for (int bj = 0; bj < 2; ++bj)
#pragma unroll
                            for (int n = 0; n < 2; ++n) *(f32x4*)(op + bj * 128 + n * 16) = xv[bj][n] + gv[bj][n] * acc[ai][bj][m][n];
                    }
                }
        }
    }
};
struct EpiPlain {
    static constexpr bool PERM = true, AFTER_DRAIN = false;
    u16* o; int ld;
    DI void operator()(const f32x4 (&acc)[2][2][4][2], const pg8::Unit& u, int wr, int wc, int fr, int fq) const {
        const int row0 = u.pm * 256 + wr * 64 + fr, col0 = u.pn * 256 + wc * 32 + 8 * fq;
#pragma unroll
        for (int ai = 0; ai < 2; ++ai)
#pragma unroll
            for (int m = 0; m < 4; ++m) {
                u16* rowp = o + (size_t)(row0 + ai * 128 + m * 16) * ld + col0;
#pragma unroll
                for (int bj = 0; bj < 2; ++bj) *(u32x4*)(rowp + bj * 128) = pack8(acc[ai][bj][m][0], acc[ai][bj][m][1]);
            }
    }
};
struct EpiAct {
    static constexpr bool PERM = true, AFTER_DRAIN = false;
    u16* act; const u16* gate; const float* cw; const float* cb; const float* sf; float* out;
    DI void finish(const float (&f0)[8], const float (&f1)[8], const float (&f2)[8], const f32x4 (&w)[8], const f32x4 a0, const f32x4 a1, u16* dst) const {
        float r[8];
#pragma unroll
        for (int j = 0; j < 8; ++j) {
            const float gc = w[(j >> 2)][j & 3] * f2[j] + w[2 + (j >> 2)][j & 3] * f1[j] + w[4 + (j >> 2)][j & 3] * f0[j] + w[6 + (j >> 2)][j & 3];
            r[j] = silu(gc) * (j < 4 ? a0[j & 3] : a1[j & 3]);
        }
        *(u32x4*)dst = (u32x4){pack2(r[0], r[1]), pack2(r[2], r[3]), pack2(r[4], r[5]), pack2(r[6], r[7])};
    }
    DI void operator()(const f32x4 (&acc)[2][2][4][2], const pg8::Unit& u, int wr, int wc, int fr, int fq) const {
        const int row0 = u.pm * 256 + wr * 64 + fr, col0 = u.pn * 256 + wc * 32 + 8 * fq;
#pragma unroll
        for (int bj = 0; bj < 2; ++bj) {
            const int c = col0 + bj * 128;
            f32x4 w[8];
#pragma unroll
            for (int q = 0; q < 3; ++q) { w[2 * q] = *(const f32x4*)(cw + q * FF + c); w[2 * q + 1] = *(const f32x4*)(cw + q * FF + c + 4); }
            w[6] = *(const f32x4*)(cb + c); w[7] = *(const f32x4*)(cb + c + 4);
            if (u.pm < 64) {
#pragma unroll
                for (int ai = 0; ai < 2; ++ai)
#pragma unroll
                    for (int mp = 0; mp < 4; mp += 2) {
                        u32x4 g0[2], g1[2], g2[2];
#pragma unroll
                        for (int mm = 0; mm < 2; ++mm) {
                            const int row = row0 + ai * 128 + (mp + mm) * 16, t = row & 2047;
                            const u16* gp = gate + (size_t)row * FF + c;
                            g0[mm] = *(const u32x4*)gp;
                            g1[mm] = (t >= 1) ? *(const u32x4*)(gp - FF) : (u32x4){0u, 0u, 0u, 0u};
                            g2[mm] = (t >= 2) ? *(const u32x4*)(gp - 2 * FF) : (u32x4){0u, 0u, 0u, 0u};
                        }
#pragma unroll
                        for (int mm = 0; mm < 2; ++mm) {
                            const int row = row0 + ai * 128 + (mp + mm) * 16, t = row & 2047;
                            float f0[8], f1[8], f2[8];
                            f0[0] = bflo(g0[mm].x); f0[1] = bfhi(g0[mm].x); f0[2] = bflo(g0[mm].y); f0[3] = bfhi(g0[mm].y); f0[4] = bflo(g0[mm].z); f0[5] = bfhi(g0[mm].z); f0[6] = bflo(g0[mm].w); f0[7] = bfhi(g0[mm].w);
                            f1[0] = bflo(g1[mm].x); f1[1] = bfhi(g1[mm].x); f1[2] = bflo(g1[mm].y); f1[3] = bfhi(g1[mm].y); f1[4] = bflo(g1[mm].z); f1[5] = bfhi(g1[mm].z); f1[6] = bflo(g1[mm].w); f1[7] = bfhi(g1[mm].w);
                            f2[0] = bflo(g2[mm].x); f2[1] = bfhi(g2[mm].x); f2[2] = bflo(g2[mm].y); f2[3] = bfhi(g2[mm].y); f2[4] = bflo(g2[mm].z); f2[5] = bfhi(g2[mm].z); f2[6] = bflo(g2[mm].w); f2[7] = bfhi(g2[mm].w);
                            if (t >= 2046) { float* fp = out + OFF_FP + ((size_t)(row >> 11) * 2 + (t - 2046)) * FF + c;
                                *(f32x4*)fp = (f32x4){f0[0], f0[1], f0[2], f0[3]}; *(f32x4*)(fp + 4) = (f32x4){f0[4], f0[5], f0[6], f0[7]}; }
                            finish(f0, f1, f2, w, acc[ai][bj][mp + mm][0], acc[ai][bj][mp + mm][1], act + (size_t)row * FF + c);
                        }
                    }
            } else {
#pragma unroll
                for (int ai = 0; ai < 2; ++ai)
#pragma unroll
                    for (int m = 0; m < 4; ++m) {
                        const int row = row0 + ai * 128 + m * 16;
                        if (row >= NR) continue;
                        float f0[8], f1[8], f2[8];
                        const u32x4 g0 = *(const u32x4*)(gate + (size_t)row * FF + c);
                        f0[0] = bflo(g0.x); f0[1] = bfhi(g0.x); f0[2] = bflo(g0.y); f0[3] = bfhi(g0.y); f0[4] = bflo(g0.z); f0[5] = bfhi(g0.z); f0[6] = bflo(g0.w); f0[7] = bfhi(g0.w);
                        const float* sp = sf + (size_t)(row - NP) * 2 * FF + c;
                        const f32x4 p0 = *(const f32x4*)sp, p1 = *(const f32x4*)(sp + 4), q0 = *(const f32x4*)(sp + FF), q1 = *(const f32x4*)(sp + FF + 4);
#pragma unroll
                        for (int j = 0; j < 4; ++j) { f2[j] = p0[j]; f2[4 + j] = p1[j]; f1[j] = q0[j]; f1[4 + j] = q1[j]; }
                        float* fp = out + OFF_FS + (size_t)(row - NP) * 2 * FF + c;
                        *(f32x4*)fp = q0; *(f32x4*)(fp + 4) = q1;
                        *(f32x4*)(fp + FF) = (f32x4){f0[0], f0[1], f0[2], f0[3]}; *(f32x4*)(fp + FF + 4) = (f32x4){f0[4], f0[5], f0[6], f0[7]};
                        finish(f0, f1, f2, w, acc[ai][bj][m][0], acc[ai][bj][m][1], act + (size_t)row * FF + c);
                    }
            }
        }
    }
};
struct MixOrder {
    pg8::StaticOrder base;
    DI bool next(int i, pg8::Unit& u) const { if (!base.next(i >> 1, u)) return false; u.sel = i & 1; return true; }
    DI void a_ready(const pg8::Unit&) const {}
    DI void done(const pg8::Unit&) const {}
};
struct EpiMixBoth {
    static constexpr bool PERM = true, AFTER_DRAIN = false;
    EpiMix<0> e0; EpiMix<1> e1;
    DI void operator()(const f32x4 (&acc)[2][2][4][2], const pg8::Unit& u, int wr, int wc, int fr, int fq) const { if (u.sel) e1(acc, u, wr, wc, fr, fq); else e0(acc, u, wr, wc, fr, fq); }
};
template <class Epi> DI void run_gemm(LAS unsigned char* lds, const u16* A, int lda, const u16* Bt, int ldb, int M, int N, int K, const Epi& E) {
    pg8::Gemm g; g.A = A; g.Bt = Bt; g.M = M; g.N = N; g.K = K; g.lda = lda; g.ldb = ldb;
    pg8::StaticOrder S; S.init(M, N, (int)gridDim.x, (int)blockIdx.x);
    pg8::gemm_phase<Epi, pg8::StaticOrder, false>((PG8_LAS unsigned char*)lds, g, S, E, nullptr);
}

DI f32x4 skinny_part(const u16* A, int lda, const u16* Bt, int ldb, int K, int mt, int nt) {
    const int lane = otid() & 63, wid = otid() >> 6, r16 = lane & 15, g = lane >> 4;
    const int ks = K >> 3;
    const u16* ap = A + (size_t)(16 * mt + r16) * lda + wid * ks + g * 8;
    const u16* bp = Bt + (size_t)(16 * nt + r16) * ldb + wid * ks + g * 8;
    f32x4 c = zero4();
#pragma unroll 11
    for (int k = 0; k < ks; k += 32) c = MFMA16(*(const bf16x8*)(ap + k), *(const bf16x8*)(bp + k), c);
    return c;
}
template <int WHICH> DI void skinny_phase(const Args& a, LAS unsigned char* lds) {
    const int tid = otid(), lane = tid & 63, wid = tid >> 6;
    LAS float* red = (LAS float*)lds;
    const u16* Z = (const u16*)(a.ws + WS_Z);
    for (int t = blockIdx.x; t < 512; t += gridDim.x) {
        const int mt = t & 7, nt = t >> 3;
        f32x4 c0, c1 = zero4();
        if (WHICH == 0) { c0 = skinny_part(Z + (size_t)NP * ZLD + ZG, ZLD, (const u16*)(a.ws + WS_WA), 1024, 1024, mt, nt); c1 = skinny_part(Z + (size_t)NP * ZLD + ZSQ, ZLD, (const u16*)(a.ws + WS_WB), 1024, 1024, mt, nt); }
        else if (WHICH == 1) c0 = skinny_part((const u16*)(a.ws + WS_H) + (size_t)NP * 1024, 1024, (const u16*)(a.ws + WS_WO), 1024, 1024, mt, nt);
        else c0 = skinny_part(Z + (size_t)MP * FF + (size_t)NP * FF, FF, (const u16*)(a.ws + WS_WD), FF, FF, mt, nt);
        *(LAS f32x4*)(red + (wid * 64 + lane) * 4) = c0;
        if (WHICH == 0) *(LAS f32x4*)(red + 2048 + (wid * 64 + lane) * 4) = c1;
        __syncthreads();
        if (tid < 256) {
            const int l = tid >> 2, i = tid & 3, row = 16 * mt + 4 * (l >> 4) + i, col = 16 * nt + (l & 15);
            float s0 = 0.f, s1 = 0.f;
#pragma unroll
            for (int w = 0; w < 8; ++w) { s0 += red[w * 256 + tid]; if (WHICH == 0) s1 += red[2048 + w * 256 + tid]; }
            if (WHICH == 0) {
                const u16* gab = (const u16*)a.out + (size_t)(NP + row) * 2048;
                ((u16*)(a.ws + WS_H))[(size_t)(NP + row) * 1024 + col] = f2bf(sigm(bf2f(gab[col])) * s0 + sigm(bf2f(gab[1024 + col])) * s1);
            } else {
                float* op = a.out + (size_t)(NP + row) * 1024 + col;
                const float base = (WHICH == 2) ? *op : a.in[1][(size_t)row * 1024 + col];
                *op = base + ((const float*)(a.ws + WS_MOD))[(size_t)(8 + row) * 6144 + (WHICH == 2 ? 5120 : 2048) + col] * s0;
            }
        }
        __syncthreads();
    }
}

DI void convert_weights(const Args& a, LAS unsigned char* lds, int tlo, int thi, int v, int nv);
DI void phase0(const Args& a, LAS unsigned char* lds) {
    const int tid = otid(), lane = tid & 63, wid = tid >> 6, r16 = lane & 15, g = lane >> 4;
    float* mod = (float*)(a.ws + WS_MOD);
    const float* wmod = a.in[9]; const float* bmod = a.in[10];
    LAS float* red = (LAS float*)lds;
    for (int task = blockIdx.x; task < 192; task += gridDim.x) {
        const int n0 = task * 32;
        f32x4 acc[2][9];
#pragma unroll
        for (int t = 0; t < 2; ++t)
#pragma unroll
            for (int mt = 0; mt < 9; ++mt) acc[t][mt] = zero4();
#pragma unroll 1
        for (int ks = 0; ks < 4; ++ks) {
            const int k0 = wid * 128 + ks * 32 + g * 8;
            bf16x8 bfr0, bfr1;
#pragma unroll
            for (int j = 0; j < 8; ++j) { const float* wp = wmod + (size_t)(k0 + j) * 6144 + n0 + r16; bfr0[j] = (short)f2bf(wp[0]); bfr1[j] = (short)f2bf(wp[16]); }
#pragma unroll
            for (int mt = 0; mt < 9; ++mt) {
                const int r = mt * 16 + r16;
                bf16x8 af = (bf16x8){0, 0, 0, 0, 0, 0, 0, 0};
                if (r < 136) {
                    const float* cp = (r < 8 ? a.in[2] + r * 1024 : a.in[3] + (r - 8) * 1024) + k0;
                    const f32x4 v0 = *(const f32x4*)cp, v1 = *(const f32x4*)(cp + 4);
#pragma unroll
                    for (int j = 0; j < 4; ++j) { af[j] = (short)f2bf(silu(v0[j])); af[4 + j] = (short)f2bf(silu(v1[j])); }
                }
                acc[0][mt] = MFMA16(af, bfr0, acc[0][mt]);
                acc[1][mt] = MFMA16(af, bfr1, acc[1][mt]);
            }
        }
#pragma unroll
        for (int t = 0; t < 2; ++t) {
#pragma unroll
            for (int mt = 0; mt < 9; ++mt) *(LAS f32x4*)(red + ((wid * 9 + mt) * 64 + lane) * 4) = acc[t][mt];
            __syncthreads();
            for (int idx = tid; idx < 2304; idx += 512) {
                const int mt = idx >> 8, rem = idx & 255, l = rem >> 2, i = rem & 3;
                float s = 0.f;
#pragma unroll
                for (int w = 0; w < 8; ++w) s += red[((w * 9 + mt) * 64 + l) * 4 + i];
                const int row = mt * 16 + 4 * (l >> 4) + i, col = n0 + 16 * t + (l & 15);
                if (row < 136) mod[(size_t)row * 6144 + col] = s + bmod[col];
            }
            __syncthreads();
        }
    }
    convert_weights(a, lds, 0, 4864, blockIdx.x, gridDim.x);
}
DI void convert_weights(const Args& a, LAS unsigned char* lds, int tlo, int thi, int v, int nv) {
    const int tid = otid();
    LAS u16* T = (LAS u16*)lds;
    for (int t0 = tlo + v * 4; t0 < thi; t0 += nv * 4) {
        f32x4 v0[4], v1[4]; u16* dstp[4];
#pragma unroll
        for (int q = 0; q < 4; ++q) {
            const int t = t0 + q;
            const float* src; u16* dst; int ldsrc, K, tl = t, mode = 0;
            if (tl < 1984) { src = a.in[13]; ldsrc = 7696; K = 1024; dst = (u16*)(a.ws + WS_RA); mode = 1; }
            else if ((tl -= 1984) < 256) { src = a.in[18]; ldsrc = 1024; K = 1024; dst = (u16*)(a.ws + WS_WA); }
            else if ((tl -= 256) < 256) { src = a.in[20]; ldsrc = 1024; K = 1024; dst = (u16*)(a.ws + WS_WB); }
            else if ((tl -= 256) < 256) { src = a.in[21]; ldsrc = 1024; K = 1024; dst = (u16*)(a.ws + WS_WO); }
            else if ((tl -= 256) < 704) { src = a.in[22]; ldsrc = 2816; K = 1024; dst = (u16*)(a.ws + WS_WG); }
            else if ((tl -= 704) < 704) { src = a.in[23]; ldsrc = 2816; K = 1024; dst = (u16*)(a.ws + WS_WU); }
            else { tl -= 704; src = a.in[26]; ldsrc = 1024; K = 2816; dst = (u16*)(a.ws + WS_WD); }
            const int ktiles = K >> 6, nt = tl / ktiles, kt = tl - nt * ktiles, n0 = nt * 64, k0 = kt * 64;
            const int k = tid & 63, n8 = (tid >> 6) * 8, n = n0 + n8;
            int sc = n; bool valid = true;
            if (mode == 1) { if (n < 4096) sc = n; else if (n < 7680) sc = n + 16; else if (n < 7696) sc = 4096 + (n - 7680); else valid = false; }
            v0[q] = zero4(); v1[q] = zero4();
            if (valid) { const float* p = src + (size_t)(k0 + k) * ldsrc + sc; v0[q] = *(const f32x4*)p; v1[q] = *(const f32x4*)(p + 4); }
            dstp[q] = dst + (size_t)(n0 + (tid >> 3)) * K + k0 + (tid & 7) * 8;
        }
#pragma unroll
        for (int q = 0; q < 4; ++q) {
            const int k = tid & 63, n8 = (tid >> 6) * 8;
            LAS u16* Tq = T + q * (64 * 72);
#pragma unroll
            for (int j = 0; j < 4; ++j) { Tq[(n8 + j) * 72 + k] = f2bf(v0[q][j]); Tq[(n8 + 4 + j) * 72 + k] = f2bf(v1[q][j]); }
        }
        __syncthreads();
#pragma unroll
        for (int q = 0; q < 4; ++q) *(u32x4*)dstp[q] = *(LAS u32x4*)(T + q * (64 * 72) + (tid >> 3) * 72 + (tid & 7) * 8);
        __syncthreads();
    }
}

template <int WHICH> DI void phase_norm(const Args& a) {
    const int tid = otid(), lane = tid & 63, gw = blockIdx.x * 8 + (tid >> 6), nw = gridDim.x * 8;
    u16* hb = (u16*)(a.ws + WS_H);
    const float* mod = (const float*)(a.ws + WS_MOD);
    const float* nwt = a.in[WHICH ? 12 : 11];
    f32x4 w[4];
#pragma unroll
    for (int i = 0; i < 4; ++i) w[i] = *(const f32x4*)(nwt + lane * 4 + 256 * i);
    for (int row0 = gw; row0 < MP; row0 += 2 * nw) {
        f32x4 v[2][4];
#pragma unroll
        for (int rr = 0; rr < 2; ++rr) {
            const int row = row0 + rr * nw;
            if (row < NR) {
                const float* xr = WHICH ? a.out + (size_t)row * 1024 : (row < NP ? a.in[0] + (size_t)row * 1024 : a.in[1] + (size_t)(row - NP) * 1024);
#pragma unroll
                for (int i = 0; i < 4; ++i) v[rr][i] = *(const f32x4*)(xr + lane * 4 + 256 * i);
            } else {
#pragma unroll
                for (int i = 0; i < 4; ++i) v[rr][i] = zero4();
            }
        }
#pragma unroll
        for (int rr = 0; rr < 2; ++rr) {
            const int row = row0 + rr * nw;
            if (row >= MP) continue;
            u16* hp = hb + (size_t)row * 1024;
            if (row >= NR) {
#pragma unroll
                for (int i = 0; i < 4; ++i) *(u32x2*)(hp + lane * 4 + 256 * i) = (u32x2){0u, 0u};
                continue;
            }
            const float* mr = mod + (size_t)row_bidx(row) * 6144 + (WHICH ? 3072 : 0);
            float ss = 0.f;
#pragma unroll
            for (int i = 0; i < 4; ++i) ss += v[rr][i][0] * v[rr][i][0] + v[rr][i][1] * v[rr][i][1] + v[rr][i][2] * v[rr][i][2] + v[rr][i][3] * v[rr][i][3];
            ss = row_sum16(ss); ss += __shfl_xor(ss, 16); ss += __shfl_xor(ss, 32);
            const float rstd = rsqrtf(ss * (1.f / 1024.f) + EPS);
#pragma unroll
            for (int i = 0; i < 4; ++i) {
                const int c = lane * 4 + 256 * i;
                const f32x4 sh = *(const f32x4*)(mr + c), sc = *(const f32x4*)(mr + 1024 + c);
                f32x4 y;
#pragma unroll
                for (int j = 0; j < 4; ++j) y[j] = v[rr][i][j] * rstd * w[i][j] * (1.f + sc[j]) + sh[j];
                *(u32x2*)(hp + c) = (u32x2){pack2(y[0], y[1]), pack2(y[2], y[3])};
            }
        }
    }
}
DI void phase_final(const Args& a) {
    const int tid = otid(), lane = tid & 63, gw = blockIdx.x * 8 + (tid >> 6), nw = gridDim.x * 8;
    const float* fw = a.in[27];
    f32x4 w[4];
#pragma unroll
    for (int i = 0; i < 4; ++i) w[i] = *(const f32x4*)(fw + lane * 4 + 256 * i);
    for (int row0 = gw; row0 < NR; row0 += 2 * nw) {
        f32x4 v[2][4];
#pragma unroll
        for (int rr = 0; rr < 2; ++rr) {
            const int row = row0 + rr * nw;
#pragma unroll
            for (int i = 0; i < 4; ++i) v[rr][i] = (row < NR) ? *(const f32x4*)(a.out + (size_t)row * 1024 + lane * 4 + 256 * i) : zero4();
        }
#pragma unroll
        for (int rr = 0; rr < 2; ++rr) {
            const int row = row0 + rr * nw;
            if (row >= NR) continue;
            float ss = 0.f;
#pragma unroll
            for (int i = 0; i < 4; ++i) ss += v[rr][i][0] * v[rr][i][0] + v[rr][i][1] * v[rr][i][1] + v[rr][i][2] * v[rr][i][2] + v[rr][i][3] * v[rr][i][3];
            ss = row_sum16(ss); ss += __shfl_xor(ss, 16); ss += __shfl_xor(ss, 32);
            const float rstd = rsqrtf(ss * (1.f / 1024.f) + EPS);
#pragma unroll
            for (int i = 0; i < 4; ++i) *(f32x4*)(a.out + (size_t)row * 1024 + lane * 4 + 256 * i) = v[rr][i] * rstd * w[i];
        }
    }
}

DI void unpack8(const u32x4 q, float (&f)[8]) { f[0] = bflo(q.x); f[1] = bfhi(q.x); f[2] = bflo(q.y); f[3] = bfhi(q.y); f[4] = bflo(q.z); f[5] = bfhi(q.z); f[6] = bflo(q.w); f[7] = bfhi(q.w); }
DI void phase_act(const Args& a) {
    const u16* gate = (const u16*)(a.ws + WS_Z);
    u16* up = (u16*)(a.ws + WS_Z) + (size_t)MP * FF;
    const float* cw = a.in[24]; const float* cb = a.in[25]; const float* sf = a.in[8];
    const int nthr = gridDim.x * 512, t0 = blockIdx.x * 512 + otid();
    for (int idx0 = t0; idx0 < NP * 352; idx0 += 2 * nthr) {
        u32x4 gv[2], g1[2], g2[2], uv[2]; int row[2], c[2]; bool ok[2];
#pragma unroll
        for (int q = 0; q < 2; ++q) {
            const int idx = idx0 + q * nthr;
            ok[q] = idx < NP * 352;
            row[q] = ok[q] ? idx / 352 : 0; c[q] = ok[q] ? (idx - row[q] * 352) * 8 : 0;
            const int t = row[q] & 2047;
            const u16* gp = gate + (size_t)row[q] * FF + c[q];
            gv[q] = *(const u32x4*)gp;
            g1[q] = (t >= 1) ? *(const u32x4*)(gp - FF) : (u32x4){0u, 0u, 0u, 0u};
            g2[q] = (t >= 2) ? *(const u32x4*)(gp - 2 * FF) : (u32x4){0u, 0u, 0u, 0u};
            uv[q] = *(const u32x4*)(up + (size_t)row[q] * FF + c[q]);
        }
#pragma unroll
        for (int q = 0; q < 2; ++q) {
            if (!ok[q]) continue;
            float f0[8], f1[8], f2[8], fu[8], r[8];
            unpack8(gv[q], f0); unpack8(g1[q], f1); unpack8(g2[q], f2); unpack8(uv[q], fu);
            const int t = row[q] & 2047;
            if (t >= 2046) { float* fp = a.out + OFF_FP + ((size_t)(row[q] >> 11) * 2 + (t - 2046)) * FF + c[q];
                *(f32x4*)fp = (f32x4){f0[0], f0[1], f0[2], f0[3]}; *(f32x4*)(fp + 4) = (f32x4){f0[4], f0[5], f0[6], f0[7]}; }
            const float* w0 = cw + c[q];
#pragma unroll
            for (int j = 0; j < 8; ++j) r[j] = silu(w0[j] * f2[j] + w0[FF + j] * f1[j] + w0[2 * FF + j] * f0[j] + cb[c[q] + j]) * fu[j];
            *(u32x4*)(up + (size_t)row[q] * FF + c[q]) = (u32x4){pack2(r[0], r[1]), pack2(r[2], r[3]), pack2(r[4], r[5]), pack2(r[6], r[7])};
        }
    }
    for (int idx = t0; idx < NS * 352; idx += nthr) {
        const int b = idx / 352, c = (idx - b * 352) * 8, row = NP + b;
        float f0[8], fu[8], r[8];
        unpack8(*(const u32x4*)(gate + (size_t)row * FF + c), f0);
        u16* upp = up + (size_t)row * FF + c;
        unpack8(*(const u32x4*)upp, fu);
        const float* s0 = sf + ((size_t)b * 2) * FF + c;
        const f32x4 p0 = *(const f32x4*)s0, p1 = *(const f32x4*)(s0 + 4), q0 = *(const f32x4*)(s0 + FF), q1 = *(const f32x4*)(s0 + FF + 4);
        float* fp = a.out + OFF_FS + ((size_t)b * 2) * FF + c;
        *(f32x4*)fp = q0; *(f32x4*)(fp + 4) = q1;
        *(f32x4*)(fp + FF) = (f32x4){f0[0], f0[1], f0[2], f0[3]}; *(f32x4*)(fp + FF + 4) = (f32x4){f0[4], f0[5], f0[6], f0[7]};
        const float* w0 = cw + c;
#pragma unroll
        for (int j = 0; j < 8; ++j) r[j] = silu(w0[j] * (j < 4 ? p0[j & 3] : p1[j & 3]) + w0[FF + j] * (j < 4 ? q0[j & 3] : q1[j & 3]) + w0[2 * FF + j] * f0[j] + cb[c + j]) * fu[j];
        *(u32x4*)upp = (u32x4){pack2(r[0], r[1]), pack2(r[2], r[3]), pack2(r[4], r[5]), pack2(r[6], r[7])};
    }
}

DI void phase_prep(const Args& a, LAS unsigned char* lds) {
    const int tid = otid(), lane = tid & 63, wid = tid >> 6, r16 = lane & 15, g = lane >> 4;
    u16* z = (u16*)(a.ws + WS_Z);
    const float* zb = (const float*)(a.ws + WS_ZB);
    const u16* halo = (const u16*)(a.ws + WS_HALO);
    u16* wbuf = (u16*)(a.ws + WS_H);
    u16* abuf = (u16*)(a.ws + WS_RA);
    float* Mbuf = a.out + OFF_KS;
    float* lastbuf = (float*)(a.ws + WS_LAST);
    const float* cw = a.in[14];
    LAS float* dec = (LAS float*)lds;
    LAS float* bet = dec + 512;
    LAS u16* qn = (LAS u16*)(lds + 4096);
    LAS u16* kn = qn + 64 * 136;
    const int item = blockIdx.x;
    if (item < 256) {
        const int b = item >> 5, ck = item & 31, R0 = b * 2048 + ck * 64;
        {
            const int h = wid;
            const float* zr = zb + (size_t)(R0 + lane) * 16;
            const float be = sigm(zr[h]);
            float s = -__expf(a.in[15][h]) * softplus(zr[8 + h] + a.in[16][h]);
#pragma unroll
            for (int off = 1; off < 64; off <<= 1) { const float t = __shfl_up(s, off); if (lane >= off) s += t; }
            dec[h * 64 + lane] = s; bet[h * 64 + lane] = be;
            if (lane == 63) lastbuf[item * 8 + h] = __expf(s);
        }
        __syncthreads();
        u32x4 oq0, oq1, ok0, ok1, okb0, okb1, ov0, ov1;
        LAS u16* const qn1 = kn + 64 * 136; LAS u16* const kn1 = qn1 + 64 * 136;
        auto stage1 = [&](const int h, LAS u16* qn, LAS u16* kn) {
            int tok = tid >> 3, cgp = tid & 7; asm volatile("" : "+v"(tok), "+v"(cgp));
            const float dtok = dec[h * 64 + tok], ed = __expf(dtok), edl = __expf(dec[h * 64 + 63] - dtok), be = bet[h * 64 + tok];
            u32x4 tp[2][4][2];
#define PREP_TAPS(set_, part_) _Pragma("unroll") for (int j_ = 0; j_ < 4; ++j_) { const int col_ = (part_) * 1024 + h * 128 + cgp * 16, srow_ = tok - 3 + j_, pos_ = ck * 64 + srow_; \
                tp[set_][j_][0] = (u32x4){0u, 0u, 0u, 0u}; tp[set_][j_][1] = tp[set_][j_][0]; \
                if (pos_ >= 0) { const u16* p_ = (srow_ < 0) ? halo + ((size_t)((b * 32 + ck - 1) * 3 + 3 + srow_)) * 3072 + col_ : z + (size_t)(R0 + srow_) * ZLD + col_; \
                    tp[set_][j_][0] = *(const u32x4*)p_; tp[set_][j_][1] = *(const u32x4*)(p_ + 8); } }
            PREP_TAPS(0, 0);
#pragma unroll
            for (int part = 0; part < 3; ++part) {
                const int col = part * 1024 + h * 128 + cgp * 16;
                if (part < 2) { PREP_TAPS((part + 1) & 1, part + 1); }
                float v[16];
#pragma unroll
                for (int c = 0; c < 16; ++c) v[c] = 0.f;
#pragma unroll
                for (int j = 0; j < 4; ++j) {
                    const u32x4 x0 = tp[part & 1][j][0], x1 = tp[part & 1][j][1];
                    const float* wp = cw + j * 3072 + col;
                    const f32x4 w0 = *(const f32x4*)wp, w1 = *(const f32x4*)(wp + 4), w2 = *(const f32x4*)(wp + 8), w3 = *(const f32x4*)(wp + 12);
                    v[0] += w0[0] * bflo(x0.x); v[1] += w0[1] * bfhi(x0.x); v[2] += w0[2] * bflo(x0.y); v[3] += w0[3] * bfhi(x0.y);
                    v[4] += w1[0] * bflo(x0.z); v[5] += w1[1] * bfhi(x0.z); v[6] += w1[2] * bflo(x0.w); v[7] += w1[3] * bfhi(x0.w);
                    v[8] += w2[0] * bflo(x1.x); v[9] += w2[1] * bfhi(x1.x); v[10] += w2[2] * bflo(x1.y); v[11] += w2[3] * bfhi(x1.y);
                    v[12] += w3[0] * bflo(x1.z); v[13] += w3[1] * bfhi(x1.z); v[14] += w3[2] * bflo(x1.w); v[15] += w3[3] * bfhi(x1.w);
                }
                float ss = 0.f;
#pragma unroll
                for (int c = 0; c < 16; ++c) { v[c] = silu(v[c]); ss += v[c] * v[c]; }
                if (part < 2) {
                    ss += __shfl_xor(ss, 1); ss += __shfl_xor(ss, 2); ss += __shfl_xor(ss, 4);
                    const float sc = rsqrtf(ss + EPS) * (part == 0 ? 0.08838834764831845f : 1.f);
#pragma unroll
                    for (int c = 0; c < 16; ++c) v[c] *= sc;
                    LAS u16* dstl = (part == 0 ? qn : kn) + tok * 136 + cgp * 16;
                    *(LAS u32x4*)dstl = (u32x4){pack2(v[0], v[1]), pack2(v[2], v[3]), pack2(v[4], v[5]), pack2(v[6], v[7])};
                    *(LAS u32x4*)(dstl + 8) = (u32x4){pack2(v[8], v[9]), pack2(v[10], v[11]), pack2(v[12], v[13]), pack2(v[14], v[15])};
                }
                if (part == 0) {
                    oq0 = (u32x4){pack2(v[0] * ed, v[1] * ed), pack2(v[2] * ed, v[3] * ed), pack2(v[4] * ed, v[5] * ed), pack2(v[6] * ed, v[7] * ed)};
                    oq1 = (u32x4){pack2(v[8] * ed, v[9] * ed), pack2(v[10] * ed, v[11] * ed), pack2(v[12] * ed, v[13] * ed), pack2(v[14] * ed, v[15] * ed)};
                } else if (part == 1) {
                    ok0 = (u32x4){pack2(v[0] * edl, v[1] * edl), pack2(v[2] * edl, v[3] * edl), pack2(v[4] * edl, v[5] * edl), pack2(v[6] * edl, v[7] * edl)};
                    ok1 = (u32x4){pack2(v[8] * edl, v[9] * edl), pack2(v[10] * edl, v[11] * edl), pack2(v[12] * edl, v[13] * edl), pack2(v[14] * edl, v[15] * edl)};
                    const float kb = be * ed;
                    okb0 = (u32x4){pack2(v[0] * kb, v[1] * kb), pack2(v[2] * kb, v[3] * kb), pack2(v[4] * kb, v[5] * kb), pack2(v[6] * kb, v[7] * kb)};
                    okb1 = (u32x4){pack2(v[8] * kb, v[9] * kb), pack2(v[10] * kb, v[11] * kb), pack2(v[12] * kb, v[13] * kb), pack2(v[14] * kb, v[15] * kb)};
                } else {
                    ov0 = (u32x4){pack2(v[0] * be, v[1] * be), pack2(v[2] * be, v[3] * be), pack2(v[4] * be, v[5] * be), pack2(v[6] * be, v[7] * be)};
                    ov1 = (u32x4){pack2(v[8] * be, v[9] * be), pack2(v[10] * be, v[11] * be), pack2(v[12] * be, v[13] * be), pack2(v[14] * be, v[15] * be)};
                }
            }
        };
        stage1(0, qn, kn);
#pragma unroll 1
        for (int h = 0; h < 8; ++h) {
            __syncthreads();
            {
                const int tok = tid >> 3, cgp = tid & 7;
                LAS u16* const qnh = (h & 1) ? qn1 : qn; LAS u16* const knh = (h & 1) ? kn1 : kn;
                { LAS u16* qn = qnh; LAS u16* kn = knh; (void)qn; (void)kn;
            {
                u16* zr = z + (size_t)(R0 + tok) * ZLD + h * 128 + cgp * 16;
                *(u32x4*)(zr + ZQ) = oq0; *(u32x4*)(zr + ZQ + 8) = oq1;
                *(u32x4*)(zr + ZK) = ok0; *(u32x4*)(zr + ZK + 8) = ok1;
                *(u32x4*)(zr + ZV) = ov0; *(u32x4*)(zr + ZV + 8) = ov1;
                u16* wr_ = wbuf + ((size_t)(item * 8 + h) * 64 + tok) * 128 + cgp * 16;
                *(u32x4*)wr_ = okb0; *(u32x4*)(wr_ + 8) = okb1;
            }
            {
                const int which = wid >> 2, mi = wid & 3;
                LAS u16* As = which ? qn : kn;
                f32x4 acc[4];
#pragma unroll
                for (int ni = 0; ni < 4; ++ni) acc[ni] = zero4();
#pragma unroll
                for (int ks = 0; ks < 4; ++ks) {
                    const bf16x8 af = *(LAS bf16x8*)(As + (16 * mi + r16) * 136 + ks * 32 + g * 8);
#pragma unroll
                    for (int ni = 0; ni < 4; ++ni) acc[ni] = MFMA16(af, *(LAS bf16x8*)(kn + (16 * ni + r16) * 136 + ks * 32 + g * 8), acc[ni]);
                }
#pragma unroll
                for (int ni = 0; ni < 4; ++ni)
#pragma unroll
                    for (int i = 0; i < 4; ++i) {
                        const int ti = 16 * mi + 4 * g + i, tj = 16 * ni + r16;
                        const float e = (ti >= tj) ? __expf(dec[h * 64 + ti] - dec[h * 64 + tj]) : 0.f;
                        if (which == 0) Mbuf[((size_t)(item * 8 + h) * 64 + ti) * 64 + tj] = (ti > tj) ? bet[h * 64 + ti] * acc[ni][i] * e : 0.f;
                        else abuf[((size_t)(item * 8 + h) * 64 + ti) * 64 + tj] = f2bf(acc[ni][i] * e);
                    }
            }
                }
            }
            if (h + 1 < 8) stage1(h + 1, (h & 1) ? qn : qn1, (h & 1) ? kn : kn1);
        }
        __syncthreads();
        {
            const int h = wid;
            LAS float* Ml = (LAS float*)(lds + 4096 + wid * 17408);
            const float* Mg = Mbuf + (size_t)(item * 8 + h) * 4096;
#pragma unroll
            for (int it = 0; it < 16; ++it) { const int idx = it * 64 + lane; *(LAS f32x4*)(Ml + (idx >> 4) * 68 + (idx & 15) * 4) = *(const f32x4*)(Mg + idx * 4); }
            {
                float t[64];
                t[0] = (lane == 0) ? 1.f : 0.f;
#pragma unroll
                for (int i = 1; i < 64; ++i) {
                    float s = (lane == i) ? 1.f : 0.f;
#pragma unroll
                    for (int j4 = 0; j4 < i; j4 += 4) {
                        const f32x4 m = *(LAS f32x4*)(Ml + i * 68 + j4);
                        s -= m[0] * t[j4];
                        if (j4 + 1 < i) s -= m[1] * t[j4 + 1];
                        if (j4 + 2 < i) s -= m[2] * t[j4 + 2];
                        if (j4 + 3 < i) s -= m[3] * t[j4 + 3];
                    }
                    t[i] = s;
                }
#pragma unroll
                for (int i = 0; i < 64; ++i) Ml[i * 68 + lane] = t[i];
            }
            bf16x8 at[4][2];
#pragma unroll
            for (int mt = 0; mt < 4; ++mt)
#pragma unroll
                for (int ks = 0; ks < 2; ++ks) {
                    const f32x4 t0 = *(LAS f32x4*)(Ml + (16 * mt + r16) * 68 + ks * 32 + g * 8), t1 = *(LAS f32x4*)(Ml + (16 * mt + r16) * 68 + ks * 32 + g * 8 + 4);
                    const u32x4 pk = pack8(t0, t1);
                    at[mt][ks] = __builtin_bit_cast(bf16x8, pk);
                }
            LAS u16* Xl = (LAS u16*)Ml;
#pragma unroll 1
            for (int pass = 0; pass < 2; ++pass) {
                u16* base = pass == 0 ? z + (size_t)R0 * ZLD + ZV + h * 128 : wbuf + (size_t)(item * 8 + h) * 64 * 128;
                const unsigned ld = pass == 0 ? ZLD : 128;
#pragma unroll
                for (int i = 0; i < 16; ++i) { const int p = lane + 64 * i, row = p >> 4, c8 = (p & 15) * 8; *(LAS u32x4*)(Xl + row * 136 + c8) = *(const u32x4*)(base + (size_t)row * ld + c8); }
#pragma unroll 1
                for (int nt = 0; nt < 8; ++nt) {
                    LAS u16* xp = Xl + nt * 16 + r16;
                    bf16x8 b0, b1;
#pragma unroll
                    for (int j = 0; j < 8; ++j) { b0[j] = (short)xp[(g * 8 + j) * 136]; b1[j] = (short)xp[(32 + g * 8 + j) * 136]; }
                    f32x4 c[4];
#pragma unroll
                    for (int mt = 0; mt < 4; ++mt) { c[mt] = MFMA16(at[mt][0], b0, zero4()); c[mt] = MFMA16(at[mt][1], b1, c[mt]); }
#pragma unroll
                    for (int mt = 0; mt < 4; ++mt)
#pragma unroll
                        for (int i = 0; i < 4; ++i) xp[(16 * mt + 4 * g + i) * 136] = f2bf(c[mt][i]);
                }
#pragma unroll
                for (int i = 0; i < 16; ++i) { const int p = lane + 64 * i, row = p >> 4, c8 = (p & 15) * 8; *(u32x4*)(base + (size_t)row * ld + c8) = *(LAS u32x4*)(Xl + row * 136 + c8); }
            }
        }
        __syncthreads();
    }
}

DI bf16x8 frag_perm(LAS u16* p) {
    const u32x2 lo = *(LAS u32x2*)p, hi = *(LAS u32x2*)(p + 16);
    const u32x4 v = (u32x4){lo.x, lo.y, hi.x, hi.y};
    return __builtin_bit_cast(bf16x8, v);
}
DI bf16x8 pack_pair(const f32x4 a, const f32x4 b) { const u32x4 v = (u32x4){pack2(a[0], a[1]), pack2(a[2], a[3]), pack2(b[0], b[1]), pack2(b[2], b[3])}; return __builtin_bit_cast(bf16x8, v); }
DI void phase_scan(const Args& a, LAS unsigned char* lds, int s) {
    const int tid = otid(), lane = tid & 63, wid = tid >> 6, r16 = lane & 15, g = lane >> 4;
    const int b = s >> 3, h = s & 7;
    u16* z = (u16*)(a.ws + WS_Z);
    const u16* wbuf = (const u16*)(a.ws + WS_H);
    const u16* abuf = (const u16*)(a.ws + WS_RA);
    const float* lastbuf = (const float*)(a.ws + WS_LAST);
    LAS u16* Wl = (LAS u16*)lds;
    LAS u16* Ql = Wl + 64 * 136;
    LAS u16* Al = Ql + 64 * 136;
    LAS u16* KT = Al + 64 * 72;
    LAS u16* Ul = KT + 128 * 72;
    LAS u16* Ol = Ul + 64 * 136;
    if (wid >= 4) {
        const int lt = tid - 256;
        const int t0 = lt >> 4, c80 = (lt & 15) * 8;
        const int pc = (c80 & ~31) + 8 * ((c80 >> 2) & 3) + 4 * ((c80 >> 4) & 1);
        const int ta = lt >> 3, ca = (lt & 7) * 8;
        const int pca = (ca & ~31) + 8 * ((ca >> 2) & 3) + 4 * ((ca >> 4) & 1);
        const int tk = lt & 63, dg = lt >> 6;
        const int ptk = (tk & ~31) + 8 * ((tk >> 2) & 3) + 4 * ((tk >> 4) & 1) + (tk & 3);
        const f32x4 ow0 = *(const f32x4*)(a.in[17] + c80), ow1 = *(const f32x4*)(a.in[17] + c80 + 4);
        u32x4 pw[4], pq[4], pu[4], pg[4], pk[4], pa[2], gc[4];
#define SCAN_LOAD(n_) do { const int R0_ = b * 2048 + (n_) * 64; const size_t ci_ = (size_t)((b * 32 + (n_)) * 8 + h); \
            _Pragma("unroll") for (int i_ = 0; i_ < 4; ++i_) { const int tr_ = t0 + 16 * i_; \
                pw[i_] = *(const u32x4*)(wbuf + ci_ * 8192 + tr_ * 128 + c80); \
                const u16* zz_ = z + (size_t)(R0_ + tr_) * ZLD + h * 128 + c80; \
                pq[i_] = *(const u32x4*)(zz_ + ZQ); pu[i_] = *(const u32x4*)(zz_ + ZV); pg[i_] = *(const u32x4*)(zz_ + ZG); \
                pk[i_] = *(const u32x4*)(z + (size_t)(R0_ + tk) * ZLD + ZK + h * 128 + (dg + 4 * i_) * 8); } \
            _Pragma("unroll") for (int i_ = 0; i_ < 2; ++i_) pa[i_] = *(const u32x4*)(abuf + ci_ * 4096 + (ta + 32 * i_) * 64 + ca); } while (0)
        SCAN_LOAD(0);
#pragma unroll 1
        for (int n = 0; n < 32; ++n) {
            const int R0 = b * 2048 + n * 64;
#pragma unroll
            for (int i = 0; i < 4; ++i) {
                const int tr = t0 + 16 * i;
                *(LAS u32x2*)(Wl + tr * 136 + pc) = (u32x2){pw[i].x, pw[i].y}; *(LAS u32x2*)(Wl + tr * 136 + pc + 8) = (u32x2){pw[i].z, pw[i].w};
                *(LAS u32x2*)(Ql + tr * 136 + pc) = (u32x2){pq[i].x, pq[i].y}; *(LAS u32x2*)(Ql + tr * 136 + pc + 8) = (u32x2){pq[i].z, pq[i].w};
                *(LAS u32x4*)(Ul + tr * 136 + c80) = pu[i];
                gc[i] = pg[i];
                const unsigned e[4] = {pk[i].x, pk[i].y, pk[i].z, pk[i].w};
                const int d0 = (dg + 4 * i) * 8;
#pragma unroll
                for (int j = 0; j < 4; ++j) { KT[(d0 + 2 * j) * 72 + ptk] = (u16)(e[j] & 0xFFFFu); KT[(d0 + 2 * j + 1) * 72 + ptk] = (u16)(e[j] >> 16); }
            }
#pragma unroll
            for (int i = 0; i < 2; ++i) { *(LAS u32x2*)(Al + (ta + 32 * i) * 72 + pca) = (u32x2){pa[i].x, pa[i].y}; *(LAS u32x2*)(Al + (ta + 32 * i) * 72 + pca + 8) = (u32x2){pa[i].z, pa[i].w}; }
            __syncthreads();
            if (n + 1 < 32) SCAN_LOAD(n + 1);
            asm volatile("s_waitcnt lgkmcnt(0)\n\ts_barrier" ::: "memory");
#pragma unroll
            for (int i = 0; i < 4; ++i) {
                const int tok = t0 + 16 * i;
                const u32x4 ov = *(LAS u32x4*)(Ol + tok * 136 + c80);
                const float q2 = bflo(ov.x) * bflo(ov.x) + bfhi(ov.x) * bfhi(ov.x) + bflo(ov.y) * bflo(ov.y) + bfhi(ov.y) * bfhi(ov.y) + bflo(ov.z) * bflo(ov.z) + bfhi(ov.z) * bfhi(ov.z) + bflo(ov.w) * bflo(ov.w) + bfhi(ov.w) * bfhi(ov.w);
                const float rstd = rsqrtf(row_sum16(q2) * (1.f / 128.f) + EPS);
                const u32x4 gv = gc[i];
                u32x4 r;
                r.x = pack2(bflo(ov.x) * rstd * ow0[0] * bflo(gv.x), bfhi(ov.x) * rstd * ow0[1] * bfhi(gv.x));
                r.y = pack2(bflo(ov.y) * rstd * ow0[2] * bflo(gv.y), bfhi(ov.y) * rstd * ow0[3] * bfhi(gv.y));
                r.z = pack2(bflo(ov.z) * rstd * ow1[0] * bflo(gv.z), bfhi(ov.z) * rstd * ow1[1] * bfhi(gv.z));
                r.w = pack2(bflo(ov.w) * rstd * ow1[2] * bflo(gv.w), bfhi(ov.w) * rstd * ow1[3] * bfhi(gv.w));
                *(u32x4*)(z + (size_t)(R0 + tok) * ZLD + ZG + h * 128 + c80) = r;
            }
        }
#undef SCAN_LOAD
    } else {
        f32x4 st[2][8];
#pragma unroll
        for (int t = 0; t < 2; ++t)
#pragma unroll
            for (int nt = 0; nt < 8; ++nt) st[t][nt] = zero4();
        const int dv0 = 32 * wid + r16;
#define SB_ __builtin_amdgcn_sched_barrier(0)
#define LD_ROWS2(dst, base, m0) _Pragma("unroll") for (int q_ = 0; q_ < 2; ++q_) _Pragma("unroll") for (int ks_ = 0; ks_ < 4; ++ks_) dst[q_ * 4 + ks_] = *(LAS bf16x8*)(base + (16 * ((m0) + q_) + r16) * 136 + ks_ * 32 + 8 * g)
#define LD_ROWS4(dst, base, m0) _Pragma("unroll") for (int q_ = 0; q_ < 4; ++q_) _Pragma("unroll") for (int ks_ = 0; ks_ < 2; ++ks_) dst[q_ * 2 + ks_] = *(LAS bf16x8*)(base + (16 * ((m0) + q_) + r16) * 72 + ks_ * 32 + 8 * g)
#pragma unroll 1
        for (int n = 0; n < 32; ++n) {
            const float last = lastbuf[(b * 32 + n) * 8 + h];
            bf16x8 sb[2][4];
#pragma unroll
            for (int t = 0; t < 2; ++t)
#pragma unroll
                for (int ks = 0; ks < 4; ++ks) sb[t][ks] = pack_pair(st[t][2 * ks], st[t][2 * ks + 1]);
            __syncthreads();
            bf16x8 fa[8], fb[8];
            f32x4 vn[2][4];
            LD_ROWS2(fa, Wl, 0); LD_ROWS2(fb, Wl, 2);
            SB_;
#pragma unroll
            for (int half = 0; half < 2; ++half) {
#pragma unroll
                for (int q = 0; q < 2; ++q) {
                    const int mt = 2 * half + q;
#pragma unroll
                    for (int t = 0; t < 2; ++t) {
                        f32x4 c = zero4();
#pragma unroll
                        for (int ks = 0; ks < 4; ++ks) c = MFMA16(half ? fb[q * 4 + ks] : fa[q * 4 + ks], sb[t][ks], c);
                        LAS u16* up = Ul + (16 * mt + 4 * g) * 136 + dv0 + 16 * t;
                        vn[t][mt] = (f32x4){bf2f(up[0]) - c[0], bf2f(up[136]) - c[1], bf2f(up[272]) - c[2], bf2f(up[408]) - c[3]};
                    }
                }
                if (half == 0) { SB_; LD_ROWS4(fa, KT, 0); SB_; }
            }
            bf16x8 vb[2][2];
#pragma unroll
            for (int t = 0; t < 2; ++t)
#pragma unroll
                for (int ks = 0; ks < 2; ++ks) vb[t][ks] = pack_pair(vn[t][2 * ks], vn[t][2 * ks + 1]);
            SB_;
            LD_ROWS4(fb, KT, 4);
            SB_;
#pragma unroll
            for (int half = 0; half < 2; ++half) {
#pragma unroll
                for (int q = 0; q < 4; ++q)
#pragma unroll
                    for (int t = 0; t < 2; ++t) {
                        f32x4 c = st[t][4 * half + q] * last;
#pragma unroll
                        for (int ks = 0; ks < 2; ++ks) c = MFMA16(half ? fb[q * 2 + ks] : fa[q * 2 + ks], vb[t][ks], c);
                        st[t][4 * half + q] = c;
                    }
                if (half == 0) { SB_; LD_ROWS2(fa, Ql, 0); SB_; } else { SB_; LD_ROWS2(fb, Ql, 2); SB_; }
            }
            f32x4 oa[2][4];
#pragma unroll
            for (int half = 0; half < 2; ++half) {
#pragma unroll
                for (int q = 0; q < 2; ++q)
#pragma unroll
                    for (int t = 0; t < 2; ++t) {
                        f32x4 c = zero4();
#pragma unroll
                        for (int ks = 0; ks < 4; ++ks) c = MFMA16(half ? fb[q * 4 + ks] : fa[q * 4 + ks], sb[t][ks], c);
                        oa[t][2 * half + q] = c;
                    }
                if (half == 0) { SB_; LD_ROWS4(fa, Al, 0); SB_; }
            }
            SB_;
#pragma unroll
            for (int mt = 0; mt < 4; ++mt)
#pragma unroll
                for (int t = 0; t < 2; ++t) {
                    f32x4 c = oa[t][mt];
#pragma unroll
                    for (int ks = 0; ks < 2; ++ks) c = MFMA16(fa[mt * 2 + ks], vb[t][ks], c);
                    const unsigned w0 = pack2(c[0], c[1]), w1 = pack2(c[2], c[3]);
                    LAS u16* op = Ol + (16 * mt + 4 * g) * 136 + dv0 + 16 * t;
                    op[0] = (u16)(w0 & 0xFFFFu); op[136] = (u16)(w0 >> 16); op[272] = (u16)(w1 & 0xFFFFu); op[408] = (u16)(w1 >> 16);
                }
            __syncthreads();
        }
#undef SB_
#undef LD_ROWS2
#undef LD_ROWS4
        float* So = a.out + OFF_GSP + (size_t)(b * 8 + h) * 16384;
#pragma unroll
        for (int t = 0; t < 2; ++t)
#pragma unroll
            for (int nt = 0; nt < 8; ++nt)
#pragma unroll
                for (int i = 0; i < 4; ++i) So[(size_t)(16 * nt + 4 * g + i) * 128 + dv0 + 16 * t] = st[t][nt][i];
    }
}

DI void swa_prompt_item(const Args& a, LAS unsigned char* lds, int it) {
    const int tid = otid(), lane = tid & 63, wid = tid >> 6, r16 = lane & 15, g = lane >> 4;
    const int b = it >> 6, kvh = (it >> 4) & 3, n = it & 15;
    u16* z = (u16*)(a.ws + WS_Z);
    LAS u16* Kl = (LAS u16*)lds;
    LAS u16* VTl = Kl + 256 * 72;
    LAS u16* Pl = VTl + 64 * 280 + wid * (16 * 168);
    const int gq = wid >> 1, th = wid & 1, qh = kvh * 4 + gq;
    bf16x8 qfa[4][2];
#pragma unroll
    for (int mtl = 0; mtl < 4; ++mtl)
#pragma unroll
        for (int ks = 0; ks < 2; ++ks) qfa[mtl][ks] = *(const bf16x8*)(z + ((size_t)(b * 2048 + n * 128 + 16 * (th * 4 + mtl)) + r16) * ZLD + ZSQ + qh * 64 + ks * 32 + g * 8);
#pragma unroll
    for (int i = 0; i < 4; ++i) {
        const int p = tid + 512 * i, key = p & 255, d8 = (p >> 8) * 8, srow = (n - 1) * 128 + key;
        u32x4 kv = (u32x4){0u, 0u, 0u, 0u}, vv = kv;
        if (srow >= 0) { const u16* base = z + (size_t)(b * 2048 + srow) * ZLD + kvh * 64 + d8; kv = *(const u32x4*)(base + ZSK); vv = *(const u32x4*)(base + ZSV); }
        *(LAS u32x4*)(Kl + key * 72 + d8) = kv;
        const unsigned e[4] = {vv.x, vv.y, vv.z, vv.w};
#pragma unroll
        for (int j = 0; j < 4; ++j) { VTl[(d8 + 2 * j) * 280 + key] = (u16)(e[j] & 0xFFFFu); VTl[(d8 + 2 * j + 1) * 280 + key] = (u16)(e[j] >> 16); }
    }
    for (int idx = tid; idx < 1536; idx += 512) { const int d = idx / 24; VTl[d * 280 + 256 + (idx - d * 24)] = 0; }
    __syncthreads();
    const float sink = a.in[19][qh];
#pragma unroll
    for (int mtl = 0; mtl < 4; ++mtl) {
        const int mt = th * 4 + mtl, tq0 = 16 * mt;
        const size_t rowA = (size_t)(b * 2048 + n * 128 + tq0);
        const bf16x8 qf[2] = {qfa[mtl][0], qfa[mtl][1]};
        f32x4 sc[9];
#pragma unroll
        for (int j = 0; j < 9; ++j) {
            f32x4 c = zero4();
#pragma unroll
            for (int ks = 0; ks < 2; ++ks) c = MFMA16(qf[ks], *(LAS bf16x8*)(Kl + (16 * (mt + j) + r16) * 72 + ks * 32 + g * 8), c);
            sc[j] = c;
        }
        float mx[4], sm[4];
#pragma unroll
        for (int i = 0; i < 4; ++i) mx[i] = sink;
#pragma unroll
        for (int j = 0; j < 9; ++j)
#pragma unroll
            for (int i = 0; i < 4; ++i) {
                const int tq = tq0 + 4 * g + i, kk = 16 * (mt + j) + r16;
                const bool valid = (kk > tq) && (kk <= tq + 128) && (n > 0 || kk >= 128);
                const float sv = valid ? sc[j][i] * 0.125f : -1e30f;
                sc[j][i] = sv; mx[i] = fmaxf(mx[i], sv);
            }
#pragma unroll
        for (int i = 0; i < 4; ++i) {
            float m = mx[i];
            mx[i] = row_max16(m); sm[i] = 0.f;
        }
#pragma unroll
        for (int j = 0; j < 9; ++j)
#pragma unroll
            for (int i = 0; i < 4; ++i) {
                const float p = (sc[j][i] > -1e29f) ? __expf(sc[j][i] - mx[i]) : 0.f;
                sm[i] += p;
                Pl[(4 * g + i) * 168 + 16 * j + r16] = f2bf(p);
            }
#pragma unroll
        for (int i = 0; i < 4; ++i) {
            Pl[(4 * g + i) * 168 + 144 + r16] = 0;
            const float s = row_sum16(sm[i]);
            sm[i] = 1.f / (s + __expf(sink - mx[i]));
        }
        f32x4 o[4];
#pragma unroll
        for (int nd = 0; nd < 4; ++nd) o[nd] = zero4();
#pragma unroll
        for (int ks = 0; ks < 5; ++ks) {
            const bf16x8 pa = *(LAS bf16x8*)(Pl + r16 * 168 + ks * 32 + g * 8);
#pragma unroll
            for (int nd = 0; nd < 4; ++nd) o[nd] = MFMA16(pa, *(LAS bf16x8*)(VTl + (16 * nd + r16) * 280 + 16 * mt + ks * 32 + g * 8), o[nd]);
        }
#pragma unroll
        for (int nd = 0; nd < 4; ++nd)
#pragma unroll
            for (int i = 0; i < 4; ++i) z[(rowA + 4 * g + i) * ZLD + ZSQ + qh * 64 + 16 * nd + r16] = f2bf(o[nd][i] * sm[i]);
    }
    __syncthreads();
}

DI void swa_sample_item(const Args& a, LAS unsigned char* lds, int it) {
    const int tid = otid(), lane = tid & 63, wid = tid >> 6;
    const int b = it >> 2, kvh = it & 3;
    u16* zr = (u16*)(a.ws + WS_Z) + (size_t)(NP + b) * ZLD;
    LAS float* ql = (LAS float*)lds;
    LAS float* ps = ql + 256;
    LAS float* pl = ps + 2048;
    LAS float* red = pl + 512;
    LAS float* po = red + 16;
    const int key = tid & 127, qt = tid >> 7;
    f32x4 kv[4];
    if (key < 127) { const float* kp = a.in[6] + ((size_t)(b * 128 + key + 1) * 4 + kvh) * 64 + qt * 16;
#pragma unroll
        for (int i = 0; i < 4; ++i) kv[i] = *(const f32x4*)(kp + 4 * i);
    } else { const u16* kp = zr + ZSK + kvh * 64 + qt * 16;
#pragma unroll
        for (int i = 0; i < 4; ++i) kv[i] = (f32x4){bf2f(kp[4 * i]), bf2f(kp[4 * i + 1]), bf2f(kp[4 * i + 2]), bf2f(kp[4 * i + 3])};
    }
    const int d4 = (tid & 15) * 4, kg = tid >> 4;
    f32x4 vv[4];
#pragma unroll
    for (int i = 0; i < 4; ++i) {
        const int kx = 4 * kg + i;
        if (kx < 127) vv[i] = *(const f32x4*)(a.in[7] + ((size_t)(b * 128 + kx + 1) * 4 + kvh) * 64 + d4);
        else { const u16* vp = zr + ZSV + kvh * 64 + d4; vv[i] = (f32x4){bf2f(vp[0]), bf2f(vp[1]), bf2f(vp[2]), bf2f(vp[3])}; }
    }
    if (tid < 256) ql[tid] = bf2f(zr[ZSQ + kvh * 256 + tid]);
    __syncthreads();
#pragma unroll
    for (int gq = 0; gq < 4; ++gq) {
        float s = 0.f;
#pragma unroll
        for (int i = 0; i < 4; ++i) { const f32x4 q4 = *(LAS f32x4*)(ql + gq * 64 + qt * 16 + 4 * i); s += q4[0] * kv[i][0] + q4[1] * kv[i][1] + q4[2] * kv[i][2] + q4[3] * kv[i][3]; }
        ps[(qt * 4 + gq) * 128 + key] = s;
    }
    __syncthreads();
    const int gq = tid >> 7;
    const float s = 0.125f * (ps[(0 * 4 + gq) * 128 + key] + ps[(1 * 4 + gq) * 128 + key] + ps[(2 * 4 + gq) * 128 + key] + ps[(3 * 4 + gq) * 128 + key]);
    const float sink = a.in[19][kvh * 4 + gq];
    float m = row_max16(s); m = fmaxf(m, __shfl_xor(m, 16)); m = fmaxf(m, __shfl_xor(m, 32));
    if (lane == 0) red[wid] = m;
    __syncthreads();
    m = fmaxf(fmaxf(red[2 * gq], red[2 * gq + 1]), sink);
    const float p = __expf(s - m);
    float psum = row_sum16(p); psum += __shfl_xor(psum, 16); psum += __shfl_xor(psum, 32);
    if (lane == 0) red[8 + wid] = psum;
    __syncthreads();
    pl[gq * 128 + key] = p * __builtin_amdgcn_rcpf(red[8 + 2 * gq] + red[8 + 2 * gq + 1] + __expf(sink - m));
    __syncthreads();
#pragma unroll
    for (int g2 = 0; g2 < 4; ++g2) {
        const f32x4 pw = *(LAS f32x4*)(pl + g2 * 128 + 4 * kg);
        *(LAS f32x4*)(po + (kg * 4 + g2) * 64 + d4) = vv[0] * pw[0] + vv[1] * pw[1] + vv[2] * pw[2] + vv[3] * pw[3];
    }
    __syncthreads();
    if (tid < 256) {
        float o = 0.f;
#pragma unroll
        for (int k2 = 0; k2 < 32; ++k2) o += po[k2 * 256 + tid];
        zr[ZSQ + kvh * 256 + tid] = f2bf(o);
    }
    __syncthreads();
}

DI void gdn_sample_item(const Args& a, LAS unsigned char* lds, int it) {
    const int tid = otid(), lane = tid & 63, wid = tid >> 6;
    const int b = it >> 3, h = it & 7, row = NP + b;
    u16* zr = (u16*)(a.ws + WS_Z) + (size_t)row * ZLD;
    const float* zb = (const float*)(a.ws + WS_ZB) + (size_t)row * 16;
    const float* cw = a.in[14];
    LAS float* act = (LAS float*)lds;
    LAS float* nrm = act + 384;
    LAS float* pkl = act + 512;
    LAS float* pql = pkl + 2048;
    const int dv4 = (tid & 31) * 4, dk0 = tid >> 5;
    const float* S0 = a.in[4] + (size_t)(b * 8 + h) * 16384;
    f32x4 sd[8];
#pragma unroll
    for (int i = 0; i < 8; ++i) sd[i] = __builtin_nontemporal_load((const f32x4*)(S0 + (size_t)(dk0 + 16 * i) * 128 + dv4));
    if (tid < 384) {
        const int col = (tid >> 7) * 1024 + h * 128 + (tid & 127);
        float x = cw[3 * 3072 + col] * bf2f(zr[col]);
#pragma unroll
        for (int j = 0; j < 3; ++j) x += cw[j * 3072 + col] * a.in[5][((size_t)b * 3 + j) * 3072 + col];
        act[tid] = silu(x);
    }
    __syncthreads();
    if (wid < 3) {
        const int o0 = wid == 2 ? 0 : wid * 128, o1 = wid == 2 ? 128 : wid * 128;
        float ss = act[o0 + lane] * act[o1 + lane] + act[o0 + 64 + lane] * act[o1 + 64 + lane];
#pragma unroll
        for (int o = 1; o < 64; o <<= 1) ss += __shfl_xor(ss, o);
        if (lane == 0) nrm[wid] = ss;
    }
    __syncthreads();
    const float qs = rsqrtf(nrm[0] + EPS) * 0.08838834764831845f, ksc = rsqrtf(nrm[1] + EPS), qk = nrm[2] * qs * ksc;
    const float beta = sigm(zb[h]);
    const float eg = __expf(-__expf(a.in[15][h]) * softplus(zb[8 + h] + a.in[16][h]));
    float* S1 = a.out + OFF_GSS + (size_t)(b * 8 + h) * 16384;
    f32x4 pk = zero4(), pq = zero4();
#pragma unroll
    for (int i = 0; i < 8; ++i) {
        const int dk = dk0 + 16 * i;
        sd[i] = sd[i] * eg;
        pk += sd[i] * (act[128 + dk] * ksc); pq += sd[i] * (act[dk] * qs);
    }
    *(LAS f32x4*)(pkl + dk0 * 128 + dv4) = pk; *(LAS f32x4*)(pql + dk0 * 128 + dv4) = pq;
    __syncthreads();
    f32x4 ksum = zero4(), qsum = zero4();
#pragma unroll
    for (int r = 0; r < 16; ++r) { ksum += *(LAS f32x4*)(pkl + r * 128 + dv4); qsum += *(LAS f32x4*)(pql + r * 128 + dv4); }
    f32x4 delta;
#pragma unroll
    for (int c = 0; c < 4; ++c) delta[c] = (act[256 + dv4 + c] - ksum[c]) * beta;
#pragma unroll
    for (int i = 0; i < 8; ++i) { const int dk = dk0 + 16 * i; __builtin_nontemporal_store(sd[i] + delta * (act[128 + dk] * ksc), (f32x4*)(S1 + (size_t)dk * 128 + dv4)); }
    if (tid < 32) {
        const f32x4 o = qsum + delta * qk;
        float ss = o[0] * o[0] + o[1] * o[1] + o[2] * o[2] + o[3] * o[3];
#pragma unroll
        for (int m = 1; m < 32; m <<= 1) ss += __shfl_xor(ss, m);
        const float rstd = rsqrtf(ss * (1.f / 128.f) + EPS);
        u16* gp = zr + ZG + h * 128 + dv4;
        const u32x2 gv = *(const u32x2*)gp;
        const float g0 = bflo(gv.x), g1 = bfhi(gv.x), g2 = bflo(gv.y), g3 = bfhi(gv.y);
        const f32x4 w = *(const f32x4*)(a.in[17] + dv4);
        *(u32x2*)gp = (u32x2){pack2(o[0] * rstd * w[0] * g0, o[1] * rstd * w[1] * g1), pack2(o[2] * rstd * w[2] * g2, o[3] * rstd * w[3] * g3)};
    }
    __syncthreads();
}

DI void state_copies(const Args& a, int vt, int nvt) {
    const u16* z = (const u16*)(a.ws + WS_Z);
    const u16* halo = (const u16*)(a.ws + WS_HALO);
    float* out = a.out;
    for (int i = vt; i < 8 * 3 * 3072; i += nvt) { const int b = i / 9216, r = i - b * 9216; out[OFF_GCP + i] = bf2f(halo[(size_t)((b * 32 + 31) * 3) * 3072 + r]); }
    for (int i = vt; i < 128 * 3 * 3072; i += nvt) {
        const int b = i / 9216, r = i - b * 9216, j = r / 3072, c = r - j * 3072;
        out[OFF_GCS + i] = (j < 2) ? a.in[5][((size_t)b * 3 + j + 1) * 3072 + c] : bf2f(z[(size_t)(NP + b) * ZLD + c]);
    }
    for (int i = vt; i < 8 * 128 * 256; i += nvt) {
        const int b = i >> 15, w = (i >> 8) & 127, c = i & 255;
        const u16* zr = z + (size_t)(b * 2048 + 1920 + w) * ZLD;
        out[OFF_KP + i] = bf2f(zr[ZSK + c]); out[OFF_VP + i] = bf2f(zr[ZSV + c]);
    }
    for (int i = vt; i < 128 * 128 * 64; i += nvt) {
        const int b = i >> 13, w = (i >> 6) & 127, c = (i & 63) * 4;
        f32x4 kv, vv;
        if (w < 127) { const size_t o = ((size_t)b * 128 + w + 1) * 256 + c; kv = *(const f32x4*)(a.in[6] + o); vv = *(const f32x4*)(a.in[7] + o); }
        else { const u16* zr = z + (size_t)(NP + b) * ZLD;
            kv = (f32x4){bf2f(zr[ZSK + c]), bf2f(zr[ZSK + c + 1]), bf2f(zr[ZSK + c + 2]), bf2f(zr[ZSK + c + 3])};
            vv = (f32x4){bf2f(zr[ZSV + c]), bf2f(zr[ZSV + c + 1]), bf2f(zr[ZSV + c + 2]), bf2f(zr[ZSV + c + 3])}; }
        __builtin_nontemporal_store(kv, (f32x4*)(out + OFF_KS + (size_t)i * 4)); __builtin_nontemporal_store(vv, (f32x4*)(out + OFF_VS + (size_t)i * 4));
    }
}

__global__ void __launch_bounds__(512, 2) fwd_megakernel(Args a) {
    extern __shared__ __attribute__((aligned(16))) unsigned char smem[];
    LAS unsigned char* lds = (LAS unsigned char*)smem;
    cg::grid_group grid = cg::this_grid();
    if (a.ws == nullptr) grid.sync();
    { volatile LAS unsigned* st_ = (volatile LAS unsigned*)(lds + LDS_XB); if (threadIdx.x < 4) st_[threadIdx.x] = 0u; }
    __syncthreads();
    const XcdBarrier xbar = xcd_barrier_post((unsigned*)(a.ws + WS_BAR), (volatile LAS unsigned*)(lds + LDS_XB));
    u16* H = (u16*)(a.ws + WS_H);
    u16* Z = (u16*)(a.ws + WS_Z);
    phase0(a, lds);
    xcd_barrier(xbar);
    phase_norm<0>(a);
    xcd_barrier(xbar);
    { EpiZ e; e.z = Z; e.gab = (u16*)a.out; e.zb = (float*)(a.ws + WS_ZB); e.halo = (u16*)(a.ws + WS_HALO);
      run_gemm(lds, H, 1024, (const u16*)(a.ws + WS_RA), 1024, MP, N1, 1024, e); }
    xcd_barrier(xbar);
    phase_prep(a, lds);
    xcd_barrier(xbar);
    if (blockIdx.x < 64) {
        phase_scan(a, lds, blockIdx.x);
        __syncthreads();
    } else {
        const int v = blockIdx.x - 64, nv = gridDim.x - 64, v2 = (v + 64) % nv;
        if (gridDim.x == 256) {
            const int xcd = blockIdx.x & 7, j = v >> 3;
            for (int m = j; m < 64; m += 24) swa_prompt_item(a, lds, (xcd + 8 * (m >> 4)) * 16 + (m & 15));
        } else {
            for (int it = v; it < 512; it += nv) swa_prompt_item(a, lds, it);
        }
        for (int it = v2; it < 1024; it += nv) gdn_sample_item(a, lds, it);
        for (int it = v2; it < 512; it += nv) swa_sample_item(a, lds, it);
        state_copies(a, v * 512 + otid(), nv * 512);
    }
    xcd_barrier(xbar);
    skinny_phase<0>(a, lds);
    { EpiMixBoth e; e.e0.mix = H; e.e0.gab = (const u16*)a.out; e.e1.mix = H; e.e1.gab = (const u16*)a.out;
      pg8::Gemm g; g.A = Z + ZG; g.Bt = (const u16*)(a.ws + WS_WA); g.A2 = Z + ZSQ; g.Bt2 = (const u16*)(a.ws + WS_WB); g.M = NP; g.N = 1024; g.K = 1024; g.lda = ZLD; g.ldb = 1024;
      MixOrder S; S.base.init(NP, 1024, (int)gridDim.x, (int)blockIdx.x);
      pg8::gemm_phase<EpiMixBoth, MixOrder, false>((PG8_LAS unsigned char*)lds, g, S, e, nullptr); }
    xcd_barrier(xbar);
    { EpiRes<0> e; e.out = a.out; e.xp = a.in[0]; e.xs = a.in[1]; e.mod = (const float*)(a.ws + WS_MOD); skinny_phase<1>(a, lds);
      run_gemm(lds, H, 1024, (const u16*)(a.ws + WS_WO), 1024, NP, 1024, 1024, e); }
    xcd_barrier(xbar);
    phase_norm<1>(a);
    xcd_barrier(xbar);
    { EpiPlain e; e.o = Z; e.ld = FF; run_gemm(lds, H, 1024, (const u16*)(a.ws + WS_WG), 1024, MP, FF, 1024, e); }
    xcd_barrier(xbar);
    { EpiAct e; e.act = Z + (size_t)MP * FF; e.gate = Z; e.cw = a.in[24]; e.cb = a.in[25]; e.sf = a.in[8]; e.out = a.out;
      run_gemm(lds, H, 1024, (const u16*)(a.ws + WS_WU), 1024, MP, FF, 1024, e); }
    xcd_barrier(xbar);
    { EpiRes<1> e; e.out = a.out; e.xp = a.in[0]; e.xs = a.in[1]; e.mod = (const float*)(a.ws + WS_MOD); skinny_phase<2>(a, lds);
      run_gemm(lds, Z + (size_t)MP * FF, FF, (const u16*)(a.ws + WS_WD), FF, NP, 1024, FF, e); }
    xcd_barrier(xbar);
    phase_final(a);
}

extern "C" void kernel_launch(void* const* d_in, const int* in_sizes, int n_in, void* d_out, int out_size, void* d_ws, size_t ws_size, hipStream_t stream) {
    static int grid = 0;
    if (grid == 0) {
        if (n_in != 28 || ws_size < WS_END) { fprintf(stderr, "kernel_launch: expected 28 inputs and >= %zu bytes of workspace (got %d, %zu)\n", (size_t)WS_END, n_in, ws_size); grid = -1; return; }
        int dev = 0, cus = 0, per_cu = 0;
        hipGetDevice(&dev);
        hipDeviceGetAttribute(&cus, hipDeviceAttributeMultiprocessorCount, dev);
        if (hipFuncSetAttribute((const void*)fwd_megakernel, hipFuncAttributeMaxDynamicSharedMemorySize, LDS_BYTES) != hipSuccess) { fprintf(stderr, "kernel_launch: hipFuncSetAttribute failed\n"); grid = -1; return; }
        hipOccupancyMaxActiveBlocksPerMultiprocessor(&per_cu, (const void*)fwd_megakernel, 512, LDS_BYTES);
        if (per_cu < 1) fprintf(stderr, "kernel_launch: occupancy query says %d blocks per CU\n", per_cu);
        (void)hipGetLastError();
        grid = cus;
    }
    if (grid < 0) return;
    if (hipMemsetAsync((char*)d_ws + WS_BAR, 0, 16384, stream) != hipSuccess) { fprintf(stderr, "kernel_launch: memset of the barrier words failed\n"); return; }
    Args a{};
    for (int i = 0; i < 28; ++i) a.in[i] = (const float*)d_in[i];
    a.out = (float*)d_out; a.ws = (unsigned char*)d_ws;
    void* args[] = {&a};
    hipError_t e = hipLaunchCooperativeKernel((const void*)fwd_megakernel, dim3(grid), dim3(512), args, LDS_BYTES, stream);
    if (e != hipSuccess) fprintf(stderr, "cooperative launch failed: %s (grid %d)\n", hipGetErrorString(e), grid);
}
```

```cpp
#include <hip/hip_runtime.h>
#include <hip/hip_cooperative_groups.h>
#include <cstdio>
namespace cg = cooperative_groups;
__device__ __forceinline__ int otid() { int t = threadIdx.x; asm volatile("" : "+v"(t)); return t; }
namespace pg8 {
#define PG8_LAS __attribute__((address_space(3)))
typedef unsigned short bf16_t;
typedef short bf16x8 __attribute__((ext_vector_type(8)));
typedef float f32x4 __attribute__((ext_vector_type(4)));
typedef unsigned u32x4 __attribute__((ext_vector_type(4)));
constexpr int BM = 256, BK = 64, HALF = 128, HTB = HALF * BK * 2  , STAGE_BYTES = 8 * HTB, NXCD = 8, WGM = 8;

__host__ __device__ __forceinline__ int lds_byte(int r, int c) { const int st = (r >> 4) * 2 + (c >> 5), rr = r & 15, cc = c & 31, ob = rr * 64 + cc * 2; return st * 1024 + (ob ^ (((ob >> 9) & 1) << 5)); }
__host__ __device__ __forceinline__ void stage_rc(int b, int& R, int& C) { const int st = b / 1024, sb = b % 1024, swz = sb ^ (((sb >> 9) & 1) << 5); R = (st >> 1) * 16 + swz / 64; C = (st & 1) * 32 + (swz % 64) / 2; }
__host__ __device__ __forceinline__ int perm32(int rho) { const int n = rho >> 4, i = rho & 15; return 8 * (i >> 2) + 4 * n + (i & 3); }

struct Unit { int pm, pn, sel = 0; };
struct Gemm { const bf16_t* A; const bf16_t* Bt; int M, N, K, lda, ldb; const bf16_t* A2 = nullptr; const bf16_t* Bt2 = nullptr; };

struct StaticOrder {
    int nM, nN, nwg, G, c;
    __host__ __device__ void init(int M, int N, int G_, int c_) { nM = M / BM; nN = N / BM; nwg = nM * nN; G = G_; c = c_; }
    __host__ __device__ bool next(int i, Unit& u) const {
        const long L = (long)i * G + c; if (L >= nwg) return false;
        int wgid = (int)L; { const int q = nwg / NXCD, r = nwg % NXCD, xcd = wgid % NXCD, off = wgid / NXCD; wgid = (xcd < r ? xcd * (q + 1) : r * (q + 1) + (xcd - r) * q) + off; }
        const int nig = WGM * nN, gid = wgid / nig, fm = gid * WGM, gsz = (nM - fm) < WGM ? (nM - fm) : WGM;
        u.pm = fm + ((wgid % nig) % gsz); u.pn = (wgid % nig) / gsz; return true;
    }
    __device__ __forceinline__ void a_ready(const Unit&) const {}
    __device__ __forceinline__ void done(const Unit&) const {}
};

template <class Epi, class Sched, bool STAMP = false>
__device__ __forceinline__ void gemm_phase(PG8_LAS unsigned char* lds, const Gemm g, const Sched& S, const Epi& E, unsigned long long* stamps) {
    const int tid = otid(), wid = __builtin_amdgcn_readfirstlane(tid >> 6), lane = tid & 63, wr = wid >> 2, wc = wid & 3, fr = lane & 15, fq = lane >> 4;
    const int K = g.K, nt = K / BK;
    int ts_lo = 0, ts_hi = 0, nts = 0; const unsigned long long rt_entry = STAMP ? (unsigned long long)wall_clock64() : 0ull;
#define PG8_STAMP() do { if (STAMP && wid == 0 && nts < 64) { const unsigned long long _c = (unsigned long long)clock64(); \
        ts_lo = (lane == nts) ? (int)(unsigned)_c : ts_lo; ts_hi = (lane == nts) ? (int)(unsigned)(_c >> 32) : ts_hi; ++nts; } } while (0)
    PG8_STAMP();
    unsigned voffA[2], voffB[2];
#pragma unroll
    for (int i = 0; i < 2; ++i) { int R, C; stage_rc(tid * 16 + i * 8192, R, C); const int Rb = Epi::PERM ? ((R & ~31) + perm32(R & 31)) : R;
        voffA[i] = (unsigned)(R * g.lda + C) * 2u; voffB[i] = (unsigned)(Rb * g.ldb + C) * 2u; }
    const size_t kstep = (size_t)(BK * 2);
    const size_t hstepA = (size_t)HALF * g.lda * 2, hstepB = (size_t)HALF * g.ldb * 2;
    const size_t tstepA = 2 * hstepA, tstepB = 2 * hstepB;
    const unsigned ldsw = (unsigned)wid * 1024u;
    const int aoff = lds_byte(wr * 64 + fr, fq * 8), boff = lds_byte(wc * 32 + fr, fq * 8);
#define PG8_SA(b, h) (((b) * 2 + (h)) * HTB)
#define PG8_SB(b, h) ((4 + (b) * 2 + (h)) * HTB)
#define PG8_STAGE(bufoff, gbase, voff) do { _Pragma("unroll") for (int _i = 0; _i < 2; ++_i) \
        __builtin_amdgcn_global_load_lds((const unsigned*)((const char*)(gbase) + (voff)[_i]), (PG8_LAS unsigned*)(lds + (bufoff) + ldsw + _i * 8192), 16, 0, 0); } while (0)
#define PG8_LDA(dst, b, h) do { _Pragma("unroll") for (int m = 0; m < 4; ++m) _Pragma("unroll") for (int k = 0; k < 2; ++k) dst[m][k] = *(const PG8_LAS bf16x8*)(lds + PG8_SA(b, h) + aoff + m * 2048 + k * 1024); } while (0)
#define PG8_LDB(dst, b, h) do { _Pragma("unroll") for (int n = 0; n < 2; ++n) _Pragma("unroll") for (int k = 0; k < 2; ++k) dst[n][k] = *(const PG8_LAS bf16x8*)(lds + PG8_SB(b, h) + boff + n * 2048 + k * 1024); } while (0)
#define PG8_MMA(ai, bj, At, Bt) do { __builtin_amdgcn_s_setprio(1); _Pragma("unroll") for (int m = 0; m < 4; ++m) _Pragma("unroll") for (int n = 0; n < 2; ++n) _Pragma("unroll") for (int k = 0; k < 2; ++k) \
        acc[ai][bj][m][n] = __builtin_amdgcn_mfma_f32_16x16x32_bf16(Bt[n][k], At[m][k], acc[ai][bj][m][n], 0, 0, 0); __builtin_amdgcn_s_setprio(0); } while (0)
#define PG8_WAIT_V(n) asm volatile("s_waitcnt vmcnt(" #n ")" ::: "memory")
#define PG8_WAIT_L(n) asm volatile("s_waitcnt lgkmcnt(" #n ")" ::: "memory")
#define PG8_BAR __builtin_amdgcn_s_barrier()
#define PG8_SCHED __builtin_amdgcn_sched_barrier(0)
    Unit cur, nxt; int ui = 0;
    if (!S.next(0, cur)) return;
    f32x4 acc[2][2][4][2];
#pragma unroll
    for (int a = 0; a < 2; ++a)
#pragma unroll
        for (int b = 0; b < 2; ++b)
#pragma unroll
            for (int m = 0; m < 4; ++m)
#pragma unroll
                for (int n = 0; n < 2; ++n) acc[a][b][m][n] = (f32x4){0.f, 0.f, 0.f, 0.f};
    bf16x8 At[4][2], B0[2][2], B1[2][2];
    const char* cA = (const char*)(cur.sel ? g.A2 : g.A) + (size_t)cur.pm * tstepA; const char* cB = (const char*)(cur.sel ? g.Bt2 : g.Bt) + (size_t)cur.pn * tstepB;
    S.a_ready(cur);
    PG8_STAGE(PG8_SB(0, 0), cB, voffB); PG8_STAGE(PG8_SA(0, 0), cA, voffA); PG8_STAGE(PG8_SB(0, 1), cB + hstepB, voffB); PG8_STAGE(PG8_SA(0, 1), cA + hstepA, voffA);
    if (wr == 1) PG8_BAR;
    PG8_WAIT_V(4); PG8_BAR;
    PG8_STAGE(PG8_SB(1, 0), cB + kstep, voffB); PG8_STAGE(PG8_SA(1, 0), cA + kstep, voffA); PG8_STAGE(PG8_SB(1, 1), cB + hstepB + kstep, voffB);
    PG8_WAIT_V(6); PG8_BAR;
    PG8_STAMP();
    for (;;) {
        const bool has_next = S.next(ui + 1, nxt);
        const char* nA = has_next ? (const char*)(nxt.sel ? g.A2 : g.A) + (size_t)nxt.pm * tstepA : cA; const char* nB = has_next ? (const char*)(nxt.sel ? g.Bt2 : g.Bt) + (size_t)nxt.pn * tstepB : cB;
        for (int t = 0; t < nt; t += 2) {
            const bool last = (t == nt - 2);
            const char* a1 = cA + (size_t)(t + 1) * kstep;
            const char* a2 = last ? nA : cA + (size_t)(t + 2) * kstep; const char* b2 = last ? nB : cB + (size_t)(t + 2) * kstep;
            const char* a3 = a2 + kstep; const char* b3 = b2 + kstep;
            if (last && has_next) S.a_ready(nxt);
            PG8_LDB(B0, 0, 0); PG8_SCHED; PG8_LDA(At, 0, 0); PG8_STAGE(PG8_SA(1, 1), a1 + hstepA, voffA);
            PG8_WAIT_L(8); PG8_BAR; PG8_WAIT_L(0); PG8_MMA(0, 0, At, B0); PG8_BAR; PG8_SCHED;
            PG8_LDB(B1, 0, 1); PG8_STAGE(PG8_SB(0, 0), b2, voffB);
            PG8_BAR; PG8_WAIT_L(0); PG8_MMA(0, 1, At, B1); PG8_BAR;
            PG8_LDA(At, 0, 1); PG8_STAGE(PG8_SA(0, 0), a2, voffA);
            PG8_BAR; PG8_WAIT_L(0); PG8_MMA(1, 0, At, B0); PG8_BAR; PG8_SCHED;
            PG8_STAGE(PG8_SB(0, 1), b2 + hstepB, voffB);
            PG8_WAIT_V(6); PG8_BAR; PG8_MMA(1, 1, At, B1); PG8_BAR;
            PG8_LDB(B0, 1, 0); PG8_SCHED; PG8_LDA(At, 1, 0); PG8_STAGE(PG8_SA(0, 1), a2 + hstepA, voffA);
            PG8_WAIT_L(8); PG8_BAR; PG8_WAIT_L(0); PG8_MMA(0, 0, At, B0); PG8_BAR; PG8_SCHED;
            PG8_LDB(B1, 1, 1); PG8_STAGE(PG8_SB(1, 0), b3, voffB);
            PG8_BAR; PG8_WAIT_L(0); PG8_MMA(0, 1, At, B1); PG8_BAR;
            PG8_LDA(At, 1, 1); PG8_STAGE(PG8_SA(1, 0), a3, voffA);
            PG8_BAR; PG8_WAIT_L(0); PG8_MMA(1, 0, At, B0); PG8_BAR; PG8_SCHED;
            PG8_STAGE(PG8_SB(1, 1), b3 + hstepB, voffB);
            PG8_WAIT_V(6); PG8_BAR; PG8_MMA(1, 1, At, B1); PG8_BAR;
        }
        PG8_STAMP();
        if constexpr (!Epi::AFTER_DRAIN) { E(acc, cur, wr, wc, fr, fq); S.done(cur); }
        PG8_STAMP();
        if (!has_next) break;
#pragma unroll
        for (int a = 0; a < 2; ++a)
#pragma unroll
            for (int b = 0; b < 2; ++b)
#pragma unroll
                for (int m = 0; m < 4; ++m)
#pragma unroll
                    for (int n = 0; n < 2; ++n) acc[a][b][m][n] = (f32x4){0.f, 0.f, 0.f, 0.f};
        cur = nxt; cA = nA; cB = nB; ++ui;
    }
    PG8_WAIT_V(0);
    if (wr == 0) PG8_BAR;
    PG8_BAR;
    if constexpr (Epi::AFTER_DRAIN) { E.fused(acc, cur, wr, wc, fr, fq, lds, wid, lane); S.done(cur); }
    PG8_STAMP();
    if (STAMP && wid == 0) { stamps[lane] = lane < nts ? (((unsigned long long)(unsigned)ts_hi << 32) | (unsigned)ts_lo) : 0ull;
        if (lane == 62) stamps[62] = rt_entry; if (lane == 63) stamps[63] = (unsigned long long)wall_clock64(); }
#undef PG8_STAMP
#undef PG8_SA
#undef PG8_SB
#undef PG8_STAGE
#undef PG8_LDA
#undef PG8_LDB
#undef PG8_MMA
#undef PG8_WAIT_V
#undef PG8_WAIT_L
#undef PG8_BAR
#undef PG8_SCHED
}
}


typedef unsigned short u16;
typedef short bf16x8 __attribute__((ext_vector_type(8)));
typedef float f32x4 __attribute__((ext_vector_type(4)));
typedef unsigned u32x4 __attribute__((ext_vector_type(4)));
typedef unsigned u32x2 __attribute__((ext_vector_type(2)));
#define LAS __attribute__((address_space(3)))
#define DI __device__ __forceinline__
#define MFMA16(a, b, c) __builtin_amdgcn_mfma_f32_16x16x32_bf16((a), (b), (c), 0, 0, 0)

#define XB_TMO      128
#define XB_XCNT(j)  (256  + 64 * (j))
#define XB_XSUB(j)  (1280 + 64 * (j))
#define XB_XGEN(j)  (2304 + 64 * (j))
#define XB_TOP      3328
#define XB_TOPGEN   3392
#define XCD_BAR_WORDS 3456
#define XB_SPIN_CAP (1u << 18)

__device__ __forceinline__ unsigned xb_ld(unsigned* p)              { return __hip_atomic_load(p, __ATOMIC_RELAXED, __HIP_MEMORY_SCOPE_AGENT); }
__device__ __forceinline__ unsigned xb_add(unsigned* p, unsigned v) { return __hip_atomic_fetch_add(p, v, __ATOMIC_RELAXED, __HIP_MEMORY_SCOPE_AGENT); }
__device__ __forceinline__ unsigned xb_xcc_id() { return (unsigned)__builtin_amdgcn_s_getreg((3 << 11) | 20) & 0xFu; }
#define XB_SPIN(cond, bar) do { unsigned _sp = 0; while (cond) { __builtin_amdgcn_s_sleep(1); \
    if ((++_sp & 255u) == 0u) { if (xb_ld(&(bar)[XB_TMO])) break; if (_sp > XB_SPIN_CAP) { atomicAdd(&(bar)[XB_TMO], 1u); break; } } } } while (0)

struct XcdBarrier {
    unsigned* bar; unsigned x;
    volatile LAS unsigned* st;
};

__device__ __forceinline__ XcdBarrier xcd_barrier_post(unsigned* bar, volatile LAS unsigned* st) {
    XcdBarrier b; b.bar = bar; b.x = xb_xcc_id(); b.st = st;
    if (threadIdx.x == 0) (void)xb_add(&bar[XB_XCNT(b.x)], 1u);
    return b;
}
__device__ __forceinline__ void xcd_barrier_complete(unsigned* bar, unsigned x, unsigned& nloc, unsigned& nx) {
    const unsigned G = gridDim.x * gridDim.y * gridDim.z;
    unsigned sum, cnt, mine, sp = 0u;
    for (;;) {
        sum = 0u; cnt = 0u; mine = 0u;
#pragma unroll
        for (unsigned j = 0; j < 16; ++j) { const unsigned c = xb_ld(&bar[XB_XCNT(j)]); sum += c; cnt += (c > 0u) ? 1u : 0u; mine = (j == x) ? c : mine; }
        if (sum == G) break;
        __builtin_amdgcn_s_sleep(1);
        if ((++sp & 255u) == 0u) { if (xb_ld(&bar[XB_TMO])) break; if (sp > XB_SPIN_CAP) { atomicAdd(&bar[XB_TMO], 1u); break; } }
    }
    nloc = mine > 0u ? mine : 1u; nx = cnt > 0u ? cnt : 1u;
}

__device__ __forceinline__ void xcd_barrier(const XcdBarrier& b) {
    asm volatile("s_waitcnt vmcnt(0)" ::: "memory");
    __syncthreads();
    if (threadIdx.x == 0) {
        unsigned* bar = b.bar;
        __builtin_amdgcn_s_waitcnt(0);
        unsigned nloc = b.st[0], nx = b.st[1];
        if (nloc == 0u) { xcd_barrier_complete(bar, b.x, nloc, nx); b.st[0] = nloc; b.st[1] = nx; }
        const unsigned old = xb_add(&bar[XB_XSUB(b.x)], 1u);
        const unsigned gen = old / nloc;
        if (old + 1u == (gen + 1u) * nloc) {
            __builtin_amdgcn_fence(__ATOMIC_RELEASE, "agent");
            asm volatile("s_waitcnt vmcnt(0)" ::: "memory");
            const unsigned og = xb_add(&bar[XB_TOP], 1u);
            const unsigned tg = og / nx;
            if (og + 1u == (tg + 1u) * nx) xb_add(&bar[XB_TOPGEN], 1u);
            else XB_SPIN(xb_ld(&bar[XB_TOPGEN]) == tg, bar);
            __builtin_amdgcn_fence(__ATOMIC_ACQUIRE, "agent");
            xb_add(&bar[XB_XGEN(b.x)], 1u);
            asm volatile("s_waitcnt vmcnt(0)" ::: "memory");
        } else {
            XB_SPIN(xb_ld(&bar[XB_XGEN(b.x)]) == gen, bar);
            __builtin_amdgcn_fence(__ATOMIC_ACQUIRE, "agent");
            asm volatile("s_waitcnt vmcnt(0)" ::: "memory");
        }
    }
    __syncthreads();
}


constexpr int NP = 16384, NS = 128, NR = 16512, MP = 16640;
constexpr int ZLD = 5632, FF = 2816, N1 = 7936;
constexpr int ZQ = 0, ZK = 1024, ZV = 2048, ZG = 3072, ZSQ = 4096, ZSK = 5120, ZSV = 5376;
constexpr float EPS = 1e-6f;
constexpr size_t WS_RA = 0;
constexpr size_t WS_WA = WS_RA + 16777216;
constexpr size_t WS_WB = WS_WA + 2097152;
constexpr size_t WS_WO = WS_WB + 2097152;
constexpr size_t WS_WG = WS_WO + 2097152;
constexpr size_t WS_WU = WS_WG + 5767168;
constexpr size_t WS_WD = WS_WU + 5767168;
constexpr size_t WS_MOD = WS_WD + 5767168;
constexpr size_t WS_ZB = WS_MOD + 3342336;
constexpr size_t WS_HALO = WS_ZB + 1064960;
constexpr size_t WS_LAST = WS_HALO + 4718592;
constexpr size_t WS_H = WS_LAST + 8192;
constexpr size_t WS_Z = WS_H + 34078720;
constexpr size_t WS_BAR = WS_Z + 187432960;
constexpr size_t WS_END = WS_BAR + 16384;
constexpr size_t OFF_YS = 16777216, OFF_GSP = 16908288, OFF_GSS = 17956864, OFF_GCP = 34734080, OFF_GCS = 34807808, OFF_KP = 35987456,
                 OFF_KS = 36249600, OFF_VP = 40443904, OFF_VS = 40706048, OFF_FP = 44900352, OFF_FS = 44945408;
constexpr int LDS_BYTES = 155648, LDS_XB = 155632;

struct Args { const float* in[28]; float* out; unsigned char* ws; };

typedef __bf16 bf16x2_t __attribute__((ext_vector_type(2)));
typedef float f32x2_t __attribute__((ext_vector_type(2)));
DI unsigned pack2(float a, float b) { f32x2_t v = {a, b}; bf16x2_t r = __builtin_convertvector(v, bf16x2_t); return __builtin_bit_cast(unsigned, r); }
DI u16 f2bf(float f) { return (u16)(pack2(f, 0.f) & 0xFFFFu); }
DI float bf2f(u16 b) { return __uint_as_float(((unsigned)b) << 16); }
DI float bflo(unsigned w) { return __uint_as_float(w << 16); }
DI float bfhi(unsigned w) { return __uint_as_float(w & 0xFFFF0000u); }
DI float sigm(float x) { return __builtin_amdgcn_rcpf(1.f + __expf(-x)); }
DI float silu(float x) { return x * __builtin_amdgcn_rcpf(1.f + __expf(-x)); }
#define DPP_F(v, ctrl) __builtin_bit_cast(float, __builtin_amdgcn_update_dpp(0, __builtin_bit_cast(int, (v)), (ctrl), 0xF, 0xF, false))
DI float row_sum16(float v) { v += DPP_F(v, 0x128); v += DPP_F(v, 0x124); v += DPP_F(v, 0x122); v += DPP_F(v, 0x121); return v; }
DI float row_max16(float v) { v = fmaxf(v, DPP_F(v, 0x128)); v = fmaxf(v, DPP_F(v, 0x124)); v = fmaxf(v, DPP_F(v, 0x122)); v = fmaxf(v, DPP_F(v, 0x121)); return v; }
DI float softplus(float x) { return x > 20.f ? x : log1pf(__expf(x)); }
DI f32x4 zero4() { return (f32x4){0.f, 0.f, 0.f, 0.f}; }
DI u32x4 pack8(f32x4 a, f32x4 b) { u32x4 w; w.x = pack2(a[0], a[1]); w.y = pack2(a[2], a[3]); w.z = pack2(b[0], b[1]); w.w = pack2(b[2], b[3]); return w; }
DI int row_bidx(int row) { return row < NP ? (row >> 11) : 8 + row - NP; }

struct EpiZ {
    static constexpr bool PERM = true, AFTER_DRAIN = false;
    u16* z; u16* gab; float* zb; u16* halo;
    DI void operator()(const f32x4 (&acc)[2][2][4][2], const pg8::Unit& u, int wr, int wc, int fr, int fq) const {
        const int row0 = u.pm * 256 + wr * 64 + fr;
        if (u.pn < 22) {
            const int col0 = u.pn * 256 + wc * 32 + 8 * fq;
            const bool gatecols = (u.pn >= 12) && (u.pn < 16);
#pragma unroll
            for (int ai = 0; ai < 2; ++ai)
#pragma unroll
                for (int m = 0; m < 4; ++m) {
                    const int row = row0 + ai * 128 + m * 16;
                    u16* rowp = z + (size_t)row * ZLD + col0;
                    const bool hal = (u.pn < 12) && (row < NP) && ((row & 63) >= 61);
#pragma unroll
                    for (int bj = 0; bj < 2; ++bj) {
                        f32x4 v0 = acc[ai][bj][m][0], v1 = acc[ai][bj][m][1];
                        if (gatecols) {
#pragma unroll
                            for (int j = 0; j < 4; ++j) { v0[j] = silu(v0[j]); v1[j] = silu(v1[j]); }
                        }
                        const u32x4 w = pack8(v0, v1);
                        __builtin_nontemporal_store(w, (u32x4*)(rowp + bj * 128));
                        if (hal) *(u32x4*)(halo + ((size_t)(row >> 6) * 3 + ((row & 63) - 61)) * 3072 + col0 + bj * 128) = w;
                    }
                }
        } else if (u.pn < 30) {
            const int col0 = (u.pn - 22) * 256 + wc * 32 + 8 * fq;
#pragma unroll
            for (int ai = 0; ai < 2; ++ai)
#pragma unroll
                for (int m = 0; m < 4; ++m) {
                    const int row = row0 + ai * 128 + m * 16;
                    if (row < NR) {
                        u16* rowp = gab + (size_t)row * 2048 + col0;
#pragma unroll
                        for (int bj = 0; bj < 2; ++bj) *(u32x4*)(rowp + bj * 128) = pack8(acc[ai][bj][m][0], acc[ai][bj][m][1]);
                    }
                }
        } else if (wc == 0 && fq < 2) {
#pragma unroll
            for (int ai = 0; ai < 2; ++ai)
#pragma unroll
                for (int m = 0; m < 4; ++m) {
                    const int row = row0 + ai * 128 + m * 16;
#pragma unroll
                    for (int n = 0; n < 2; ++n) *(f32x4*)(zb + (size_t)row * 16 + 8 * fq + 4 * n) = acc[ai][0][m][n];
                }
        }
    }
};
template <int WHICH> struct EpiMix {
    static constexpr bool PERM = true, AFTER_DRAIN = false;
    u16* mix; const u16* gab;
    DI void operator()(const f32x4 (&acc)[2][2][4][2], const pg8::Unit& u, int wr, int wc, int fr, int fq) const {
        const int row0 = u.pm * 256 + wr * 64 + fr, col0 = u.pn * 256 + wc * 32 + 8 * fq;
#pragma unroll
        for (int ai = 0; ai < 2; ++ai)
#pragma unroll
            for (int mp = 0; mp < 4; mp += 2) {
                u32x4 gv[2][2], pv[2][2];
#pragma unroll
                for (int mm = 0; mm < 2; ++mm) {
                    const int row = row0 + ai * 128 + (mp + mm) * 16;
#pragma unroll
                    for (int bj = 0; bj < 2; ++bj) {
                        gv[mm][bj] = (u32x4){0u, 0u, 0u, 0u}; pv[mm][bj] = gv[mm][bj];
                        if (row < NR) gv[mm][bj] = *(const u32x4*)(gab + (size_t)row * 2048 + WHICH * 1024 + col0 + bj * 128);
                        if (WHICH == 1) pv[mm][bj] = *(const u32x4*)(mix + (size_t)row * 1024 + col0 + bj * 128);
                    }
                }
#pragma unroll
                for (int mm = 0; mm < 2; ++mm) {
                    const int row = row0 + ai * 128 + (mp + mm) * 16;
#pragma unroll
                    for (int bj = 0; bj < 2; ++bj) {
                        const u32x4 g_ = gv[mm][bj], p_ = pv[mm][bj];
                        f32x4 a0 = acc[ai][bj][mp + mm][0], a1 = acc[ai][bj][mp + mm][1];
                        a0[0] *= sigm(bflo(g_.x)); a0[1] *= sigm(bfhi(g_.x)); a0[2] *= sigm(bflo(g_.y)); a0[3] *= sigm(bfhi(g_.y));
                        a1[0] *= sigm(bflo(g_.z)); a1[1] *= sigm(bfhi(g_.z)); a1[2] *= sigm(bflo(g_.w)); a1[3] *= sigm(bfhi(g_.w));
                        if (WHICH == 1) {
                            a0[0] += bflo(p_.x); a0[1] += bfhi(p_.x); a0[2] += bflo(p_.y); a0[3] += bfhi(p_.y);
                            a1[0] += bflo(p_.z); a1[1] += bfhi(p_.z); a1[2] += bflo(p_.w); a1[3] += bfhi(p_.w);
                        }
                        *(u32x4*)(mix + (size_t)row * 1024 + col0 + bj * 128) = pack8(a0, a1);
                    }
                }
            }
    }
};
template <int WHICH> struct EpiRes {
    static constexpr bool PERM = false, AFTER_DRAIN = false;
    float* out; const float* xp; const float* xs; const float* mod; u16* xh;
    DI void operator()(const f32x4 (&acc)[2][2][4][2], const pg8::Unit& u, int wr, int wc, int fr, int fq) const {
        const int row0 = u.pm * 256 + wr * 64 + fr, col0 = u.pn * 256 + wc * 32 + 4 * fq;
        constexpr int GOFF = WHICH ? 5120 : 2048;
        if (u.pm < 64) {
            f32x4 gtv[2][2];
            const float* gt = mod + (size_t)(u.pm >> 3) * 6144 + GOFF + col0;
#pragma unroll
            for (int bj = 0; bj < 2; ++bj)
#pragma unroll
                for (int n = 0; n < 2; ++n) gtv[bj][n] = *(const f32x4*)(gt + bj * 128 + n * 16);
#pragma unroll
            for (int ai = 0; ai < 2; ++ai)
#pragma unroll
                for (int mp = 0; mp < 4; mp += 2) {
                    f32x4 xv[2][2][2];
#pragma unroll
                    for (int mm = 0; mm < 2; ++mm) {
                        const size_t ro = (size_t)(row0 + ai * 128 + (mp + mm) * 16) * 1024 + col0;
                        const float* xr = WHICH ? out + ro : xp + ro;
#pragma unroll
                        for (int bj = 0; bj < 2; ++bj)
#pragma unroll
                            for (int n = 0; n < 2; ++n) xv[mm][bj][n] = *(const f32x4*)(xr + bj * 128 + n * 16);
                    }
#pragma unroll
                    for (int mm = 0; mm < 2; ++mm) {
                        float* op = out + (size_t)(row0 + ai * 128 + (mp + mm) * 16) * 1024 + col0;
#pragma unroll
                        for (int bj = 0; bj < 2; ++bj)
#pragma unroll
                            for (int n = 0; n < 2; ++n) {
                                const f32x4 r_ = xv[mm][bj][n] + gtv[bj][n] * acc[ai][bj][mp + mm][n];
                                if (WHICH) *(u32x2*)(xh + (size_t)(row0 + ai * 128 + (mp + mm) * 16) * 1024 + col0 + bj * 128 + n * 16) = (u32x2){pack2(r_[0], r_[1]), pack2(r_[2], r_[3])};
                                else *(f32x4*)(op + bj * 128 + n * 16) = r_;
                            }
                    }
                }
        } else {
#pragma unroll
            for (int ai = 0; ai < 2; ++ai)
#pragma unroll
                for (int m = 0; m < 4; ++m) {
                    const int row = row0 + ai * 128 + m * 16;
                    if (row < NR) {
                        float* op = out + (size_t)row * 1024 + col0;
                        const float* xr = WHICH ? op : (xs + (size_t)(row - NP) * 1024 + col0);
                        const float* gt = mod + (size_t)row_bidx(row) * 6144 + GOFF + col0;
                        f32x4 xv[2][2], gv[2][2];
#pragma unroll
                        for (int bj = 0; bj < 2; ++bj)
#pragma unroll
                            for (int n = 0; n < 2; ++n) { xv[bj][n] = *(const f32x4*)(xr + bj * 128 + n * 16); gv[bj][n] = *(const f32x4*)(gt + bj * 128 + n * 16); }
#pragma unroll
                        for (int bj = 0; bj < 2; ++bj)
#pragma unroll
                            for (int n = 0; n < 2; ++n) {
                                const f32x4 r_ = xv[bj][n] + gv[bj][n] * acc[ai][bj][m][n];
                                if (WHICH) *(u32x2*)(xh + (size_t)row * 1024 + col0 + bj * 128 + n * 16) = (u32x2){pack2(r_[0], r_[1]), pack2(r_[2], r_[3])};
                                else *(f32x4*)(op + bj * 128 + n * 16) = r_;
                            }
                    }
                }
        }
    }
};
struct EpiPlain {
    static constexpr bool PERM = true, AFTER_DRAIN = false;
    u16* o; int ld;
    DI void operator()(const f32x4 (&acc)[2][2][4][2], const pg8::Unit& u, int wr, int wc, int fr, int fq) const {
        const int row0 = u.pm * 256 + wr * 64 + fr, col0 = u.pn * 256 + wc * 32 + 8 * fq;
#pragma unroll
        for (int ai = 0; ai < 2; ++ai)
#pragma unroll
            for (int m = 0; m < 4; ++m) {
                u16* rowp = o + (size_t)(row0 + ai * 128 + m * 16) * ld + col0;
#pragma unroll
                for (int bj = 0; bj < 2; ++bj) *(u32x4*)(rowp + bj * 128) = pack8(acc[ai][bj][m][0], acc[ai][bj][m][1]);
            }
    }
};
struct EpiAct {
    static constexpr bool PERM = true, AFTER_DRAIN = false;
    u16* act; const u16* gate; const float* cw; const float* cb; const float* sf; float* out;
    DI void finish(const float (&f0)[8], const float (&f1)[8], const float (&f2)[8], const f32x4 (&w)[8], const f32x4 a0, const f32x4 a1, u16* dst) const {
        float r[8];
#pragma unroll
        for (int j = 0; j < 8; ++j) {
            const float gc = w[(j >> 2)][j & 3] * f2[j] + w[2 + (j >> 2)][j & 3] * f1[j] + w[4 + (j >> 2)][j & 3] * f0[j] + w[6 + (j >> 2)][j & 3];
            r[j] = silu(gc) * (j < 4 ? a0[j & 3] : a1[j & 3]);
        }
        *(u32x4*)dst = (u32x4){pack2(r[0], r[1]), pack2(r[2], r[3]), pack2(r[4], r[5]), pack2(r[6], r[7])};
    }
    DI void operator()(const f32x4 (&acc)[2][2][4][2], const pg8::Unit& u, int wr, int wc, int fr, int fq) const {
        const int row0 = u.pm * 256 + wr * 64 + fr, col0 = u.pn * 256 + wc * 32 + 8 * fq;
#pragma unroll
        for (int bj = 0; bj < 2; ++bj) {
            const int c = col0 + bj * 128;
            f32x4 w[8];
#pragma unroll
            for (int q = 0; q < 3; ++q) { w[2 * q] = *(const f32x4*)(cw + q * FF + c); w[2 * q + 1] = *(const f32x4*)(cw + q * FF + c + 4); }
            w[6] = *(const f32x4*)(cb + c); w[7] = *(const f32x4*)(cb + c + 4);
            if (u.pm < 64) {
#pragma unroll
                for (int ai = 0; ai < 2; ++ai)
#pragma unroll
                    for (int mp = 0; mp < 4; mp += 2) {
                        u32x4 g0[2], g1[2], g2[2];
#pragma unroll
                        for (int mm = 0; mm < 2; ++mm) {
                            const int row = row0 + ai * 128 + (mp + mm) * 16, t = row & 2047;
                            const u16* gp = gate + (size_t)row * FF + c;
                            g0[mm] = *(const u32x4*)gp;
                            g1[mm] = (t >= 1) ? *(const u32x4*)(gp - FF) : (u32x4){0u, 0u, 0u, 0u};
                            g2[mm] = (t >= 2) ? *(const u32x4*)(gp - 2 * FF) : (u32x4){0u, 0u, 0u, 0u};
                        }
#pragma unroll
                        for (int mm = 0; mm < 2; ++mm) {
                            const int row = row0 + ai * 128 + (mp + mm) * 16, t = row & 2047;
                            float f0[8], f1[8], f2[8];
                            f0[0] = bflo(g0[mm].x); f0[1] = bfhi(g0[mm].x); f0[2] = bflo(g0[mm].y); f0[3] = bfhi(g0[mm].y); f0[4] = bflo(g0[mm].z); f0[5] = bfhi(g0[mm].z); f0[6] = bflo(g0[mm].w); f0[7] = bfhi(g0[mm].w);
                            f1[0] = bflo(g1[mm].x); f1[1] = bfhi(g1[mm].x); f1[2] = bflo(g1[mm].y); f1[3] = bfhi(g1[mm].y); f1[4] = bflo(g1[mm].z); f1[5] = bfhi(g1[mm].z); f1[6] = bflo(g1[mm].w); f1[7] = bfhi(g1[mm].w);
                            f2[0] = bflo(g2[mm].x); f2[1] = bfhi(g2[mm].x); f2[2] = bflo(g2[mm].y); f2[3] = bfhi(g2[mm].y); f2[4] = bflo(g2[mm].z); f2[5] = bfhi(g2[mm].z); f2[6] = bflo(g2[mm].w); f2[7] = bfhi(g2[mm].w);
                            if (t >= 2046) { float* fp = out + OFF_FP + ((size_t)(row >> 11) * 2 + (t - 2046)) * FF + c;
                                *(f32x4*)fp = (f32x4){f0[0], f0[1], f0[2], f0[3]}; *(f32x4*)(fp + 4) = (f32x4){f0[4], f0[5], f0[6], f0[7]}; }
                            finish(f0, f1, f2, w, acc[ai][bj][mp + mm][0], acc[ai][bj][mp + mm][1], act + (size_t)row * FF + c);
                        }
                    }
            } else {
#pragma unroll
                for (int ai = 0; ai < 2; ++ai)
#pragma unroll
                    for (int m = 0; m < 4; ++m) {
                        const int row = row0 + ai * 128 + m * 16;
                        if (row >= NR) continue;
                        float f0[8], f1[8], f2[8];
                        const u32x4 g0 = *(const u32x4*)(gate + (size_t)row * FF + c);
                        f0[0] = bflo(g0.x); f0[1] = bfhi(g0.x); f0[2] = bflo(g0.y); f0[3] = bfhi(g0.y); f0[4] = bflo(g0.z); f0[5] = bfhi(g0.z); f0[6] = bflo(g0.w); f0[7] = bfhi(g0.w);
                        const float* sp = sf + (size_t)(row - NP) * 2 * FF + c;
                        const f32x4 p0 = *(const f32x4*)sp, p1 = *(const f32x4*)(sp + 4), q0 = *(const f32x4*)(sp + FF), q1 = *(const f32x4*)(sp + FF + 4);
#pragma unroll
                        for (int j = 0; j < 4; ++j) { f2[j] = p0[j]; f2[4 + j] = p1[j]; f1[j] = q0[j]; f1[4 + j] = q1[j]; }
                        float* fp = out + OFF_FS + (size_t)(row - NP) * 2 * FF + c;
                        *(f32x4*)fp = q0; *(f32x4*)(fp + 4) = q1;
                        *(f32x4*)(fp + FF) = (f32x4){f0[0], f0[1], f0[2], f0[3]}; *(f32x4*)(fp + FF + 4) = (f32x4){f0[4], f0[5], f0[6], f0[7]};
                        finish(f0, f1, f2, w, acc[ai][bj][m][0], acc[ai][bj][m][1], act + (size_t)row * FF + c);
                    }
            }
        }
    }
};
struct MixOrder {
    pg8::StaticOrder base;
    DI bool next(int i, pg8::Unit& u) const { if (!base.next(i >> 1, u)) return false; u.sel = i & 1; return true; }
    DI void a_ready(const pg8::Unit&) const {}
    DI void done(const pg8::Unit&) const {}
};
struct EpiMixBoth {
    static constexpr bool PERM = true, AFTER_DRAIN = false;
    EpiMix<0> e0; EpiMix<1> e1;
    DI void operator()(const f32x4 (&acc)[2][2][4][2], const pg8::Unit& u, int wr, int wc, int fr, int fq) const { if (u.sel) e1(acc, u, wr, wc, fr, fq); else e0(acc, u, wr, wc, fr, fq); }
};
template <class Epi> DI void run_gemm(LAS unsigned char* lds, const u16* A, int lda, const u16* Bt, int ldb, int M, int N, int K, const Epi& E) {
    pg8::Gemm g; g.A = A; g.Bt = Bt; g.M = M; g.N = N; g.K = K; g.lda = lda; g.ldb = ldb;
    pg8::StaticOrder S; S.init(M, N, (int)gridDim.x, (int)blockIdx.x);
    pg8::gemm_phase<Epi, pg8::StaticOrder, false>((PG8_LAS unsigned char*)lds, g, S, E, nullptr);
}

DI f32x4 skinny_part(const u16* A, int lda, const u16* Bt, int ldb, int K, int mt, int nt) {
    const int lane = otid() & 63, wid = otid() >> 6, r16 = lane & 15, g = lane >> 4;
    const int ks = K >> 3;
    const u16* ap = A + (size_t)(16 * mt + r16) * lda + wid * ks + g * 8;
    const u16* bp = Bt + (size_t)(16 * nt + r16) * ldb + wid * ks + g * 8;
    f32x4 c = zero4();
#pragma unroll 11
    for (int k = 0; k < ks; k += 32) c = MFMA16(*(const bf16x8*)(ap + k), *(const bf16x8*)(bp + k), c);
    return c;
}
template <int WHICH> DI void skinny_phase(const Args& a, LAS unsigned char* lds) {
    const int tid = otid(), lane = tid & 63, wid = tid >> 6;
    LAS float* red = (LAS float*)lds;
    const u16* Z = (const u16*)(a.ws + WS_Z);
    for (int t = blockIdx.x; t < 512; t += gridDim.x) {
        const int mt = t & 7, nt = t >> 3;
        f32x4 c0, c1 = zero4();
        if (WHICH == 0) { c0 = skinny_part(Z + (size_t)NP * ZLD + ZG, ZLD, (const u16*)(a.ws + WS_WA), 1024, 1024, mt, nt); c1 = skinny_part(Z + (size_t)NP * ZLD + ZSQ, ZLD, (const u16*)(a.ws + WS_WB), 1024, 1024, mt, nt); }
        else if (WHICH == 1) c0 = skinny_part((const u16*)(a.ws + WS_H) + (size_t)NP * 1024, 1024, (const u16*)(a.ws + WS_WO), 1024, 1024, mt, nt);
        else c0 = skinny_part(Z + (size_t)MP * FF + (size_t)NP * FF, FF, (const u16*)(a.ws + WS_WD), FF, FF, mt, nt);
        *(LAS f32x4*)(red + (wid * 64 + lane) * 4) = c0;
        if (WHICH == 0) *(LAS f32x4*)(red + 2048 + (wid * 64 + lane) * 4) = c1;
        __syncthreads();
        if (tid < 256) {
            const int l = tid >> 2, i = tid & 3, row = 16 * mt + 4 * (l >> 4) + i, col = 16 * nt + (l & 15);
            float s0 = 0.f, s1 = 0.f;
#pragma unroll
            for (int w = 0; w < 8; ++w) { s0 += red[w * 256 + tid]; if (WHICH == 0) s1 += red[2048 + w * 256 + tid]; }
            if (WHICH == 0) {
                const u16* gab = (const u16*)a.out + (size_t)(NP + row) * 2048;
                ((u16*)(a.ws + WS_H))[(size_t)(NP + row) * 1024 + col] = f2bf(sigm(bf2f(gab[col])) * s0 + sigm(bf2f(gab[1024 + col])) * s1);
            } else {
                float* op = a.out + (size_t)(NP + row) * 1024 + col;
                const float base = (WHICH == 2) ? *op : a.in[1][(size_t)row * 1024 + col];
                const float r_ = base + ((const float*)(a.ws + WS_MOD))[(size_t)(8 + row) * 6144 + (WHICH == 2 ? 5120 : 2048) + col] * s0;
                if (WHICH == 2) ((u16*)(a.ws + WS_H))[(size_t)(NP + row) * 1024 + col] = f2bf(r_); else *op = r_;
            }
        }
        __syncthreads();
    }
}

DI void convert_weights(const Args& a, LAS unsigned char* lds, int tlo, int thi, int v, int nv);
DI void phase0(const Args& a, LAS unsigned char* lds) {
    const int tid = otid(), lane = tid & 63, wid = tid >> 6, r16 = lane & 15, g = lane >> 4;
    float* mod = (float*)(a.ws + WS_MOD);
    const float* wmod = a.in[9]; const float* bmod = a.in[10];
    LAS float* red = (LAS float*)lds;
    for (int task = blockIdx.x; task < 192; task += gridDim.x) {
        const int n0 = task * 32;
        f32x4 acc[2][9];
#pragma unroll
        for (int t = 0; t < 2; ++t)
#pragma unroll
            for (int mt = 0; mt < 9; ++mt) acc[t][mt] = zero4();
#pragma unroll 1
        for (int ks = 0; ks < 4; ++ks) {
            const int k0 = wid * 128 + ks * 32 + g * 8;
            bf16x8 bfr0, bfr1;
#pragma unroll
            for (int j = 0; j < 8; ++j) { const float* wp = wmod + (size_t)(k0 + j) * 6144 + n0 + r16; bfr0[j] = (short)f2bf(wp[0]); bfr1[j] = (short)f2bf(wp[16]); }
#pragma unroll
            for (int mt = 0; mt < 9; ++mt) {
                const int r = mt * 16 + r16;
                bf16x8 af = (bf16x8){0, 0, 0, 0, 0, 0, 0, 0};
                if (r < 136) {
                    const float* cp = (r < 8 ? a.in[2] + r * 1024 : a.in[3] + (r - 8) * 1024) + k0;
                    const f32x4 v0 = *(const f32x4*)cp, v1 = *(const f32x4*)(cp + 4);
#pragma unroll
                    for (int j = 0; j < 4; ++j) { af[j] = (short)f2bf(silu(v0[j])); af[4 + j] = (short)f2bf(silu(v1[j])); }
                }
                acc[0][mt] = MFMA16(af, bfr0, acc[0][mt]);
                acc[1][mt] = MFMA16(af, bfr1, acc[1][mt]);
            }
        }
#pragma unroll
        for (int t = 0; t < 2; ++t) {
#pragma unroll
            for (int mt = 0; mt < 9; ++mt) *(LAS f32x4*)(red + ((wid * 9 + mt) * 64 + lane) * 4) = acc[t][mt];
            __syncthreads();
            for (int idx = tid; idx < 2304; idx += 512) {
                const int mt = idx >> 8, rem = idx & 255, l = rem >> 2, i = rem & 3;
                float s = 0.f;
#pragma unroll
                for (int w = 0; w < 8; ++w) s += red[((w * 9 + mt) * 64 + l) * 4 + i];
                const int row = mt * 16 + 4 * (l >> 4) + i, col = n0 + 16 * t + (l & 15);
                if (row < 136) mod[(size_t)row * 6144 + col] = s + bmod[col];
            }
            __syncthreads();
        }
    }
    convert_weights(a, lds, 0, 4864, blockIdx.x, gridDim.x);
}
DI void convert_weights(const Args& a, LAS unsigned char* lds, int tlo, int thi, int v, int nv) {
    const int tid = otid();
    LAS u16* T = (LAS u16*)lds;
    for (int t0 = tlo + v * 4; t0 < thi; t0 += nv * 4) {
        f32x4 v0[4], v1[4]; u16* dstp[4];
#pragma unroll
        for (int q = 0; q < 4; ++q) {
            const int t = t0 + q;
            const float* src; u16* dst; int ldsrc, K, tl = t, mode = 0;
            if (tl < 1984) { src = a.in[13]; ldsrc = 7696; K = 1024; dst = (u16*)(a.ws + WS_RA); mode = 1; }
            else if ((tl -= 1984) < 256) { src = a.in[18]; ldsrc = 1024; K = 1024; dst = (u16*)(a.ws + WS_WA); }
            else if ((tl -= 256) < 256) { src = a.in[20]; ldsrc = 1024; K = 1024; dst = (u16*)(a.ws + WS_WB); }
            else if ((tl -= 256) < 256) { src = a.in[21]; ldsrc = 1024; K = 1024; dst = (u16*)(a.ws + WS_WO); }
            else if ((tl -= 256) < 704) { src = a.in[22]; ldsrc = 2816; K = 1024; dst = (u16*)(a.ws + WS_WG); }
            else if ((tl -= 704) < 704) { src = a.in[23]; ldsrc = 2816; K = 1024; dst = (u16*)(a.ws + WS_WU); }
            else { tl -= 704; src = a.in[26]; ldsrc = 1024; K = 2816; dst = (u16*)(a.ws + WS_WD); }
            const int ktiles = K >> 6, nt = tl / ktiles, kt = tl - nt * ktiles, n0 = nt * 64, k0 = kt * 64;
            const int k = tid & 63, n8 = (tid >> 6) * 8, n = n0 + n8;
            int sc = n; bool valid = true;
            if (mode == 1) { if (n < 4096) sc = n; else if (n < 7680) sc = n + 16; else if (n < 7696) sc = 4096 + (n - 7680); else valid = false; }
            v0[q] = zero4(); v1[q] = zero4();
            if (valid) { const float* p = src + (size_t)(k0 + k) * ldsrc + sc; v0[q] = *(const f32x4*)p; v1[q] = *(const f32x4*)(p + 4); }
            dstp[q] = dst + (size_t)(n0 + (tid >> 3)) * K + k0 + (tid & 7) * 8;
        }
#pragma unroll
        for (int q = 0; q < 4; ++q) {
            const int k = tid & 63, n8 = (tid >> 6) * 8;
            LAS u16* Tq = T + q * (64 * 72);
#pragma unroll
            for (int j = 0; j < 4; ++j) { Tq[(n8 + j) * 72 + k] = f2bf(v0[q][j]); Tq[(n8 + 4 + j) * 72 + k] = f2bf(v1[q][j]); }
        }
        __syncthreads();
#pragma unroll
        for (int q = 0; q < 4; ++q) *(u32x4*)dstp[q] = *(LAS u32x4*)(T + q * (64 * 72) + (tid >> 3) * 72 + (tid & 7) * 8);
        __syncthreads();
    }
}

template <int WHICH> DI void phase_norm(const Args& a) {
    const int tid = otid(), lane = tid & 63, gw = blockIdx.x * 8 + (tid >> 6), nw = gridDim.x * 8;
    u16* hb = (u16*)(a.ws + WS_H);
    const float* mod = (const float*)(a.ws + WS_MOD);
    const float* nwt = a.in[WHICH ? 12 : 11];
    f32x4 w[4];
#pragma unroll
    for (int i = 0; i < 4; ++i) w[i] = *(const f32x4*)(nwt + lane * 4 + 256 * i);
    for (int row0 = gw; row0 < MP; row0 += 2 * nw) {
        f32x4 v[2][4];
#pragma unroll
        for (int rr = 0; rr < 2; ++rr) {
            const int row = row0 + rr * nw;
            if (row < NR) {
                const float* xr = WHICH ? a.out + (size_t)row * 1024 : (row < NP ? a.in[0] + (size_t)row * 1024 : a.in[1] + (size_t)(row - NP) * 1024);
#pragma unroll
                for (int i = 0; i < 4; ++i) v[rr][i] = *(const f32x4*)(xr + lane * 4 + 256 * i);
            } else {
#pragma unroll
                for (int i = 0; i < 4; ++i) v[rr][i] = zero4();
            }
        }
#pragma unroll
        for (int rr = 0; rr < 2; ++rr) {
            const int row = row0 + rr * nw;
            if (row >= MP) continue;
            u16* hp = hb + (size_t)row * 1024;
            if (row >= NR) {
#pragma unroll
                for (int i = 0; i < 4; ++i) *(u32x2*)(hp + lane * 4 + 256 * i) = (u32x2){0u, 0u};
                continue;
            }
            const float* mr = mod + (size_t)row_bidx(row) * 6144 + (WHICH ? 3072 : 0);
            float ss = 0.f;
#pragma unroll
            for (int i = 0; i < 4; ++i) ss += v[rr][i][0] * v[rr][i][0] + v[rr][i][1] * v[rr][i][1] + v[rr][i][2] * v[rr][i][2] + v[rr][i][3] * v[rr][i][3];
            ss = row_sum16(ss); ss += __shfl_xor(ss, 16); ss += __shfl_xor(ss, 32);
            const float rstd = rsqrtf(ss * (1.f / 1024.f) + EPS);
#pragma unroll
            for (int i = 0; i < 4; ++i) {
                const int c = lane * 4 + 256 * i;
                const f32x4 sh = *(const f32x4*)(mr + c), sc = *(const f32x4*)(mr + 1024 + c);
                f32x4 y;
#pragma unroll
                for (int j = 0; j < 4; ++j) y[j] = v[rr][i][j] * rstd * w[i][j] * (1.f + sc[j]) + sh[j];
                *(u32x2*)(hp + c) = (u32x2){pack2(y[0], y[1]), pack2(y[2], y[3])};
            }
        }
    }
}
DI void phase_final(const Args& a) {
    const int tid = otid(), lane = tid & 63, gw = blockIdx.x * 8 + (tid >> 6), nw = gridDim.x * 8;
    const float* fw = a.in[27];
    f32x4 w[4];
#pragma unroll
    for (int i = 0; i < 4; ++i) w[i] = *(const f32x4*)(fw + lane * 4 + 256 * i);
    for (int row0 = gw; row0 < NR; row0 += 2 * nw) {
        f32x4 v[2][4];
#pragma unroll
        for (int rr = 0; rr < 2; ++rr) {
            const int row = row0 + rr * nw;
#pragma unroll
            for (int i = 0; i < 4; ++i) {
                v[rr][i] = zero4();
                if (row < NR) { const u32x2 q_ = *(const u32x2*)((const u16*)(a.ws + WS_H) + (size_t)row * 1024 + lane * 4 + 256 * i); v[rr][i] = (f32x4){bflo(q_.x), bfhi(q_.x), bflo(q_.y), bfhi(q_.y)}; }
            }
        }
#pragma unroll
        for (int rr = 0; rr < 2; ++rr) {
            const int row = row0 + rr * nw;
            if (row >= NR) continue;
            float ss = 0.f;
#pragma unroll
            for (int i = 0; i < 4; ++i) ss += v[rr][i][0] * v[rr][i][0] + v[rr][i][1] * v[rr][i][1] + v[rr][i][2] * v[rr][i][2] + v[rr][i][3] * v[rr][i][3];
            ss = row_sum16(ss); ss += __shfl_xor(ss, 16); ss += __shfl_xor(ss, 32);
            const float rstd = rsqrtf(ss * (1.f / 1024.f) + EPS);
#pragma unroll
            for (int i = 0; i < 4; ++i) *(f32x4*)(a.out + (size_t)row * 1024 + lane * 4 + 256 * i) = v[rr][i] * rstd * w[i];
        }
    }
}

DI void unpack8(const u32x4 q, float (&f)[8]) { f[0] = bflo(q.x); f[1] = bfhi(q.x); f[2] = bflo(q.y); f[3] = bfhi(q.y); f[4] = bflo(q.z); f[5] = bfhi(q.z); f[6] = bflo(q.w); f[7] = bfhi(q.w); }
DI void phase_act(const Args& a) {
    const u16* gate = (const u16*)(a.ws + WS_Z);
    u16* up = (u16*)(a.ws + WS_Z) + (size_t)MP * FF;
    const float* cw = a.in[24]; const float* cb = a.in[25]; const float* sf = a.in[8];
    const int nthr = gridDim.x * 512, t0 = blockIdx.x * 512 + otid();
    for (int idx0 = t0; idx0 < NP * 352; idx0 += 2 * nthr) {
        u32x4 gv[2], g1[2], g2[2], uv[2]; int row[2], c[2]; bool ok[2];
#pragma unroll
        for (int q = 0; q < 2; ++q) {
            const int idx = idx0 + q * nthr;
            ok[q] = idx < NP * 352;
            row[q] = ok[q] ? idx / 352 : 0; c[q] = ok[q] ? (idx - row[q] * 352) * 8 : 0;
            const int t = row[q] & 2047;
            const u16* gp = gate + (size_t)row[q] * FF + c[q];
            gv[q] = *(const u32x4*)gp;
            g1[q] = (t >= 1) ? *(const u32x4*)(gp - FF) : (u32x4){0u, 0u, 0u, 0u};
            g2[q] = (t >= 2) ? *(const u32x4*)(gp - 2 * FF) : (u32x4){0u, 0u, 0u, 0u};
            uv[q] = *(const u32x4*)(up + (size_t)row[q] * FF + c[q]);
        }
#pragma unroll
        for (int q = 0; q < 2; ++q) {
            if (!ok[q]) continue;
            float f0[8], f1[8], f2[8], fu[8], r[8];
            unpack8(gv[q], f0); unpack8(g1[q], f1); unpack8(g2[q], f2); unpack8(uv[q], fu);
            const int t = row[q] & 2047;
            if (t >= 2046) { float* fp = a.out + OFF_FP + ((size_t)(row[q] >> 11) * 2 + (t - 2046)) * FF + c[q];
                *(f32x4*)fp = (f32x4){f0[0], f0[1], f0[2], f0[3]}; *(f32x4*)(fp + 4) = (f32x4){f0[4], f0[5], f0[6], f0[7]}; }
            const float* w0 = cw + c[q];
#pragma unroll
            for (int j = 0; j < 8; ++j) r[j] = silu(w0[j] * f2[j] + w0[FF + j] * f1[j] + w0[2 * FF + j] * f0[j] + cb[c[q] + j]) * fu[j];
            *(u32x4*)(up + (size_t)row[q] * FF + c[q]) = (u32x4){pack2(r[0], r[1]), pack2(r[2], r[3]), pack2(r[4], r[5]), pack2(r[6], r[7])};
        }
    }
    for (int idx = t0; idx < NS * 352; idx += nthr) {
        const int b = idx / 352, c = (idx - b * 352) * 8, row = NP + b;
        float f0[8], fu[8], r[8];
        unpack8(*(const u32x4*)(gate + (size_t)row * FF + c), f0);
        u16* upp = up + (size_t)row * FF + c;
        unpack8(*(const u32x4*)upp, fu);
        const float* s0 = sf + ((size_t)b * 2) * FF + c;
        const f32x4 p0 = *(const f32x4*)s0, p1 = *(const f32x4*)(s0 + 4), q0 = *(const f32x4*)(s0 + FF), q1 = *(const f32x4*)(s0 + FF + 4);
        float* fp = a.out + OFF_FS + ((size_t)b * 2) * FF + c;
        *(f32x4*)fp = q0; *(f32x4*)(fp + 4) = q1;
        *(f32x4*)(fp + FF) = (f32x4){f0[0], f0[1], f0[2], f0[3]}; *(f32x4*)(fp + FF + 4) = (f32x4){f0[4], f0[5], f0[6], f0[7]};
        const float* w0 = cw + c;
#pragma unroll
        for (int j = 0; j < 8; ++j) r[j] = silu(w0[j] * (j < 4 ? p0[j & 3] : p1[j & 3]) + w0[FF + j] * (j < 4 ? q0[j & 3] : q1[j & 3]) + w0[2 * FF + j] * f0[j] + cb[c + j]) * fu[j];
        *(u32x4*)upp = (u32x4){pack2(r[0], r[1]), pack2(r[2], r[3]), pack2(r[4], r[5]), pack2(r[6], r[7])};
    }
}

DI void phase_prep(const Args& a, LAS unsigned char* lds) {
    const int tid = otid(), lane = tid & 63, wid = tid >> 6, r16 = lane & 15, g = lane >> 4;
    u16* z = (u16*)(a.ws + WS_Z);
    const float* zb = (const float*)(a.ws + WS_ZB);
    const u16* halo = (const u16*)(a.ws + WS_HALO);
    u16* wbuf = (u16*)(a.ws + WS_H);
    u16* abuf = (u16*)(a.ws + WS_RA);
    float* Mbuf = a.out + OFF_KS;
    float* lastbuf = (float*)(a.ws + WS_LAST);
    const float* cw = a.in[14];
    LAS float* dec = (LAS float*)lds;
    LAS float* bet = dec + 512;
    LAS u16* qn = (LAS u16*)(lds + 4096);
    LAS u16* kn = qn + 64 * 136;
    const int item = blockIdx.x;
    if (item < 256) {
        const int b = item >> 5, ck = item & 31, R0 = b * 2048 + ck * 64;
        {
            const int h = wid;
            const float* zr = zb + (size_t)(R0 + lane) * 16;
            const float be = sigm(zr[h]);
            float s = -__expf(a.in[15][h]) * softplus(zr[8 + h] + a.in[16][h]);
#pragma unroll
            for (int off = 1; off < 64; off <<= 1) { const float t = __shfl_up(s, off); if (lane >= off) s += t; }
            dec[h * 64 + lane] = s; bet[h * 64 + lane] = be;
            if (lane == 63) lastbuf[item * 8 + h] = __expf(s);
        }
        __syncthreads();
#pragma unroll 1
        for (int h = 0; h < 8; ++h) {
            int tok = tid >> 3, cgp = tid & 7; asm volatile("" : "+v"(tok), "+v"(cgp));
            const float dtok = dec[h * 64 + tok], ed = __expf(dtok), edl = __expf(dec[h * 64 + 63] - dtok), be = bet[h * 64 + tok];
            u32x4 oq0, oq1, ok0, ok1, okb0, okb1, ov0, ov1;
            u32x4 tp[2][4][2];
#define PREP_TAPS(set_, part_) _Pragma("unroll") for (int j_ = 0; j_ < 4; ++j_) { const int col_ = (part_) * 1024 + h * 128 + cgp * 16, srow_ = tok - 3 + j_, pos_ = ck * 64 + srow_; \
                tp[set_][j_][0] = (u32x4){0u, 0u, 0u, 0u}; tp[set_][j_][1] = tp[set_][j_][0]; \
                if (pos_ >= 0) { const u16* p_ = (srow_ < 0) ? halo + ((size_t)((b * 32 + ck - 1) * 3 + 3 + srow_)) * 3072 + col_ : z + (size_t)(R0 + srow_) * ZLD + col_; \
                    tp[set_][j_][0] = *(const u32x4*)p_; tp[set_][j_][1] = *(const u32x4*)(p_ + 8); } }
            PREP_TAPS(0, 0);
#pragma unroll
            for (int part = 0; part < 3; ++part) {
                const int col = part * 1024 + h * 128 + cgp * 16;
                if (part < 2) { PREP_TAPS((part + 1) & 1, part + 1); }
                float v[16];
#pragma unroll
                for (int c = 0; c < 16; ++c) v[c] = 0.f;
#pragma unroll
                for (int j = 0; j < 4; ++j) {
                    const u32x4 x0 = tp[part & 1][j][0], x1 = tp[part & 1][j][1];
                    const float* wp = cw + j * 3072 + col;
                    const f32x4 w0 = *(const f32x4*)wp, w1 = *(const f32x4*)(wp + 4), w2 = *(const f32x4*)(wp + 8), w3 = *(const f32x4*)(wp + 12);
                    v[0] += w0[0] * bflo(x0.x); v[1] += w0[1] * bfhi(x0.x); v[2] += w0[2] * bflo(x0.y); v[3] += w0[3] * bfhi(x0.y);
                    v[4] += w1[0] * bflo(x0.z); v[5] += w1[1] * bfhi(x0.z); v[6] += w1[2] * bflo(x0.w); v[7] += w1[3] * bfhi(x0.w);
                    v[8] += w2[0] * bflo(x1.x); v[9] += w2[1] * bfhi(x1.x); v[10] += w2[2] * bflo(x1.y); v[11] += w2[3] * bfhi(x1.y);
                    v[12] += w3[0] * bflo(x1.z); v[13] += w3[1] * bfhi(x1.z); v[14] += w3[2] * bflo(x1.w); v[15] += w3[3] * bfhi(x1.w);
                }
                float ss = 0.f;
#pragma unroll
                for (int c = 0; c < 16; ++c) { v[c] = silu(v[c]); ss += v[c] * v[c]; }
                if (part < 2) {
                    ss += __shfl_xor(ss, 1); ss += __shfl_xor(ss, 2); ss += __shfl_xor(ss, 4);
                    const float sc = rsqrtf(ss + EPS) * (part == 0 ? 0.08838834764831845f : 1.f);
#pragma unroll
                    for (int c = 0; c < 16; ++c) v[c] *= sc;
                    LAS u16* dstl = (part == 0 ? qn : kn) + tok * 136 + cgp * 16;
                    *(LAS u32x4*)dstl = (u32x4){pack2(v[0], v[1]), pack2(v[2], v[3]), pack2(v[4], v[5]), pack2(v[6], v[7])};
                    *(LAS u32x4*)(dstl + 8) = (u32x4){pack2(v[8], v[9]), pack2(v[10], v[11]), pack2(v[12], v[13]), pack2(v[14], v[15])};
                }
                if (part == 0) {
                    oq0 = (u32x4){pack2(v[0] * ed, v[1] * ed), pack2(v[2] * ed, v[3] * ed), pack2(v[4] * ed, v[5] * ed), pack2(v[6] * ed, v[7] * ed)};
                    oq1 = (u32x4){pack2(v[8] * ed, v[9] * ed), pack2(v[10] * ed, v[11] * ed), pack2(v[12] * ed, v[13] * ed), pack2(v[14] * ed, v[15] * ed)};
                } else if (part == 1) {
                    ok0 = (u32x4){pack2(v[0] * edl, v[1] * edl), pack2(v[2] * edl, v[3] * edl), pack2(v[4] * edl, v[5] * edl), pack2(v[6] * edl, v[7] * edl)};
                    ok1 = (u32x4){pack2(v[8] * edl, v[9] * edl), pack2(v[10] * edl, v[11] * edl), pack2(v[12] * edl, v[13] * edl), pack2(v[14] * edl, v[15] * edl)};
                    const float kb = be * ed;
                    okb0 = (u32x4){pack2(v[0] * kb, v[1] * kb), pack2(v[2] * kb, v[3] * kb), pack2(v[4] * kb, v[5] * kb), pack2(v[6] * kb, v[7] * kb)};
                    okb1 = (u32x4){pack2(v[8] * kb, v[9] * kb), pack2(v[10] * kb, v[11] * kb), pack2(v[12] * kb, v[13] * kb), pack2(v[14] * kb, v[15] * kb)};
                } else {
                    ov0 = (u32x4){pack2(v[0] * be, v[1] * be), pack2(v[2] * be, v[3] * be), pack2(v[4] * be, v[5] * be), pack2(v[6] * be, v[7] * be)};
                    ov1 = (u32x4){pack2(v[8] * be, v[9] * be), pack2(v[10] * be, v[11] * be), pack2(v[12] * be, v[13] * be), pack2(v[14] * be, v[15] * be)};
                }
            }
            __syncthreads();
            {
                u16* zr = z + (size_t)(R0 + tok) * ZLD + h * 128 + cgp * 16;
                *(u32x4*)(zr + ZQ) = oq0; *(u32x4*)(zr + ZQ + 8) = oq1;
                *(u32x4*)(zr + ZK) = ok0; *(u32x4*)(zr + ZK + 8) = ok1;
                *(u32x4*)(zr + ZV) = ov0; *(u32x4*)(zr + ZV + 8) = ov1;
                u16* wr_ = wbuf + ((size_t)(item * 8 + h) * 64 + tok) * 128 + cgp * 16;
                *(u32x4*)wr_ = okb0; *(u32x4*)(wr_ + 8) = okb1;
            }
            {
                const int which = wid >> 2, mi = wid & 3;
                LAS u16* As = which ? qn : kn;
                f32x4 acc[4];
#pragma unroll
                for (int ni = 0; ni < 4; ++ni) acc[ni] = zero4();
#pragma unroll
                for (int ks = 0; ks < 4; ++ks) {
                    const bf16x8 af = *(LAS bf16x8*)(As + (16 * mi + r16) * 136 + ks * 32 + g * 8);
#pragma unroll
                    for (int ni = 0; ni < 4; ++ni) acc[ni] = MFMA16(af, *(LAS bf16x8*)(kn + (16 * ni + r16) * 136 + ks * 32 + g * 8), acc[ni]);
                }
#pragma unroll
                for (int ni = 0; ni < 4; ++ni)
#pragma unroll
                    for (int i = 0; i < 4; ++i) {
                        const int ti = 16 * mi + 4 * g + i, tj = 16 * ni + r16;
                        const float e = (ti >= tj) ? __expf(dec[h * 64 + ti] - dec[h * 64 + tj]) : 0.f;
                        if (which == 0) Mbuf[((size_t)(item * 8 + h) * 64 + ti) * 64 + tj] = (ti > tj) ? bet[h * 64 + ti] * acc[ni][i] * e : 0.f;
                        else abuf[((size_t)(item * 8 + h) * 64 + ti) * 64 + tj] = f2bf(acc[ni][i] * e);
                    }
            }
            asm volatile("s_waitcnt lgkmcnt(0)\n\ts_barrier" ::: "memory");
        }
        __syncthreads();
        {
            const int h = wid;
            LAS float* Ml = (LAS float*)(lds + 4096 + wid * 17408);
            const float* Mg = Mbuf + (size_t)(item * 8 + h) * 4096;
#pragma unroll
            for (int it = 0; it < 16; ++it) { const int idx = it * 64 + lane; *(LAS f32x4*)(Ml + (idx >> 4) * 68 + (idx & 15) * 4) = *(const f32x4*)(Mg + idx * 4); }
            {
                float t[64];
                t[0] = (lane == 0) ? 1.f : 0.f;
#pragma unroll
                for (int i = 1; i < 64; ++i) {
                    float s = (lane == i) ? 1.f : 0.f;
#pragma unroll
                    for (int j4 = 0; j4 < i; j4 += 4) {
                        const f32x4 m = *(LAS f32x4*)(Ml + i * 68 + j4);
                        s -= m[0] * t[j4];
                        if (j4 + 1 < i) s -= m[1] * t[j4 + 1];
                        if (j4 + 2 < i) s -= m[2] * t[j4 + 2];
                        if (j4 + 3 < i) s -= m[3] * t[j4 + 3];
                    }
                    t[i] = s;
                }
#pragma unroll
                for (int i = 0; i < 64; ++i) Ml[i * 68 + lane] = t[i];
            }
            bf16x8 at[4][2];
#pragma unroll
            for (int mt = 0; mt < 4; ++mt)
#pragma unroll
                for (int ks = 0; ks < 2; ++ks) {
                    const f32x4 t0 = *(LAS f32x4*)(Ml + (16 * mt + r16) * 68 + ks * 32 + g * 8), t1 = *(LAS f32x4*)(Ml + (16 * mt + r16) * 68 + ks * 32 + g * 8 + 4);
                    const u32x4 pk = pack8(t0, t1);
                    at[mt][ks] = __builtin_bit_cast(bf16x8, pk);
                }
#pragma unroll 1
            for (int pass = 0; pass < 2; ++pass) {
                u16* base = pass == 0 ? z + (size_t)R0 * ZLD + ZV + h * 128 : wbuf + (size_t)(item * 8 + h) * 64 * 128;
                const unsigned ld = pass == 0 ? ZLD : 128;
                const unsigned o0 = (unsigned)(g * 8) * ld + r16, o1 = o0 + 32u * ld, os = (unsigned)(4 * g) * ld + r16;
#pragma unroll 1
                for (int nh = 0; nh < 8; nh += 2) {
                    bf16x8 bb[2][2];
#pragma unroll
                    for (int nt = 0; nt < 2; ++nt)
#pragma unroll
                        for (int j = 0; j < 8; ++j) { bb[nt][0][j] = (short)base[(nh + nt) * 16 + o0 + j * ld]; bb[nt][1][j] = (short)base[(nh + nt) * 16 + o1 + j * ld]; }
#pragma unroll
                    for (int nt = 0; nt < 2; ++nt) {
                        f32x4 c[4];
#pragma unroll
                        for (int mt = 0; mt < 4; ++mt) { c[mt] = MFMA16(at[mt][0], bb[nt][0], zero4()); c[mt] = MFMA16(at[mt][1], bb[nt][1], c[mt]); }
#pragma unroll
                        for (int mt = 0; mt < 4; ++mt)
#pragma unroll
                            for (int i = 0; i < 4; ++i) base[(nh + nt) * 16 + os + (16 * mt + i) * ld] = f2bf(c[mt][i]);
                    }
                }
            }
        }
        __syncthreads();
    }
}

DI bf16x8 frag_perm(LAS u16* p) {
    const u32x2 lo = *(LAS u32x2*)p, hi = *(LAS u32x2*)(p + 16);
    const u32x4 v = (u32x4){lo.x, lo.y, hi.x, hi.y};
    return __builtin_bit_cast(bf16x8, v);
}
DI bf16x8 pack_pair(const f32x4 a, const f32x4 b) { const u32x4 v = (u32x4){pack2(a[0], a[1]), pack2(a[2], a[3]), pack2(b[0], b[1]), pack2(b[2], b[3])}; return __builtin_bit_cast(bf16x8, v); }
DI void phase_scan(const Args& a, LAS unsigned char* lds, int s) {
    const int tid = otid(), lane = tid & 63, wid = tid >> 6, r16 = lane & 15, g = lane >> 4;
    const int b = s >> 3, h = s & 7;
    u16* z = (u16*)(a.ws + WS_Z);
    const u16* wbuf = (const u16*)(a.ws + WS_H);
    const u16* abuf = (const u16*)(a.ws + WS_RA);
    const float* lastbuf = (const float*)(a.ws + WS_LAST);
    LAS u16* Wl = (LAS u16*)lds;
    LAS u16* Ql = Wl + 64 * 136;
    LAS u16* Al = Ql + 64 * 136;
    LAS u16* KT = Al + 64 * 72;
    LAS u16* Ul = KT + 128 * 72;
    LAS u16* Ol = Ul + 64 * 136;
    if (wid >= 4) {
        const int lt = tid - 256;
        const int t0 = lt >> 4, c80 = (lt & 15) * 8;
        const int pc = (c80 & ~31) + 8 * ((c80 >> 2) & 3) + 4 * ((c80 >> 4) & 1);
        const int ta = lt >> 3, ca = (lt & 7) * 8;
        const int pca = (ca & ~31) + 8 * ((ca >> 2) & 3) + 4 * ((ca >> 4) & 1);
        const int tk = lt & 63, dg = lt >> 6;
        const int ptk = (tk & ~31) + 8 * ((tk >> 2) & 3) + 4 * ((tk >> 4) & 1) + (tk & 3);
        const f32x4 ow0 = *(const f32x4*)(a.in[17] + c80), ow1 = *(const f32x4*)(a.in[17] + c80 + 4);
        u32x4 pw[4], pq[4], pu[4], pg[4], pk[4], pa[2], gc[4];
#define SCAN_LOAD(n_) do { const int R0_ = b * 2048 + (n_) * 64; const size_t ci_ = (size_t)((b * 32 + (n_)) * 8 + h); \
            _Pragma("unroll") for (int i_ = 0; i_ < 4; ++i_) { const int tr_ = t0 + 16 * i_; \
                pw[i_] = *(const u32x4*)(wbuf + ci_ * 8192 + tr_ * 128 + c80); \
                const u16* zz_ = z + (size_t)(R0_ + tr_) * ZLD + h * 128 + c80; \
                pq[i_] = *(const u32x4*)(zz_ + ZQ); pu[i_] = *(const u32x4*)(zz_ + ZV); pg[i_] = *(const u32x4*)(zz_ + ZG); \
                pk[i_] = *(const u32x4*)(z + (size_t)(R0_ + tk) * ZLD + ZK + h * 128 + (dg + 4 * i_) * 8); } \
            _Pragma("unroll") for (int i_ = 0; i_ < 2; ++i_) pa[i_] = *(const u32x4*)(abuf + ci_ * 4096 + (ta + 32 * i_) * 64 + ca); } while (0)
        SCAN_LOAD(0);
#pragma unroll 1
        for (int n = 0; n < 32; ++n) {
            const int R0 = b * 2048 + n * 64;
#pragma unroll
            for (int i = 0; i < 4; ++i) {
                const int tr = t0 + 16 * i;
                *(LAS u32x2*)(Wl + tr * 136 + pc) = (u32x2){pw[i].x, pw[i].y}; *(LAS u32x2*)(Wl + tr * 136 + pc + 8) = (u32x2){pw[i].z, pw[i].w};
                *(LAS u32x2*)(Ql + tr * 136 + pc) = (u32x2){pq[i].x, pq[i].y}; *(LAS u32x2*)(Ql + tr * 136 + pc + 8) = (u32x2){pq[i].z, pq[i].w};
                *(LAS u32x4*)(Ul + tr * 136 + c80) = pu[i];
                gc[i] = pg[i];
                const unsigned e[4] = {pk[i].x, pk[i].y, pk[i].z, pk[i].w};
                const int d0 = (dg + 4 * i) * 8;
#pragma unroll
                for (int j = 0; j < 4; ++j) { KT[(d0 + 2 * j) * 72 + ptk] = (u16)(e[j] & 0xFFFFu); KT[(d0 + 2 * j + 1) * 72 + ptk] = (u16)(e[j] >> 16); }
            }
#pragma unroll
            for (int i = 0; i < 2; ++i) { *(LAS u32x2*)(Al + (ta + 32 * i) * 72 + pca) = (u32x2){pa[i].x, pa[i].y}; *(LAS u32x2*)(Al + (ta + 32 * i) * 72 + pca + 8) = (u32x2){pa[i].z, pa[i].w}; }
            __syncthreads();
            if (n + 1 < 32) SCAN_LOAD(n + 1);
            asm volatile("s_waitcnt lgkmcnt(0)\n\ts_barrier" ::: "memory");
#pragma unroll
            for (int i = 0; i < 4; ++i) {
                const int tok = t0 + 16 * i;
                const u32x4 ov = *(LAS u32x4*)(Ol + tok * 136 + c80);
                const float q2 = bflo(ov.x) * bflo(ov.x) + bfhi(ov.x) * bfhi(ov.x) + bflo(ov.y) * bflo(ov.y) + bfhi(ov.y) * bfhi(ov.y) + bflo(ov.z) * bflo(ov.z) + bfhi(ov.z) * bfhi(ov.z) + bflo(ov.w) * bflo(ov.w) + bfhi(ov.w) * bfhi(ov.w);
                const float rstd = rsqrtf(row_sum16(q2) * (1.f / 128.f) + EPS);
                const u32x4 gv = gc[i];
                u32x4 r;
                r.x = pack2(bflo(ov.x) * rstd * ow0[0] * bflo(gv.x), bfhi(ov.x) * rstd * ow0[1] * bfhi(gv.x));
                r.y = pack2(bflo(ov.y) * rstd * ow0[2] * bflo(gv.y), bfhi(ov.y) * rstd * ow0[3] * bfhi(gv.y));
                r.z = pack2(bflo(ov.z) * rstd * ow1[0] * bflo(gv.z), bfhi(ov.z) * rstd * ow1[1] * bfhi(gv.z));
                r.w = pack2(bflo(ov.w) * rstd * ow1[2] * bflo(gv.w), bfhi(ov.w) * rstd * ow1[3] * bfhi(gv.w));
                *(u32x4*)(z + (size_t)(R0 + tok) * ZLD + ZG + h * 128 + c80) = r;
            }
        }
#undef SCAN_LOAD
    } else {
        f32x4 st[2][8];
#pragma unroll
        for (int t = 0; t < 2; ++t)
#pragma unroll
            for (int nt = 0; nt < 8; ++nt) st[t][nt] = zero4();
        const int dv0 = 32 * wid + r16;
#define SB_ __builtin_amdgcn_sched_barrier(0)
#define LD_ROWS2(dst, base, m0) _Pragma("unroll") for (int q_ = 0; q_ < 2; ++q_) _Pragma("unroll") for (int ks_ = 0; ks_ < 4; ++ks_) dst[q_ * 4 + ks_] = *(LAS bf16x8*)(base + (16 * ((m0) + q_) + r16) * 136 + ks_ * 32 + 8 * g)
#define LD_ROWS4(dst, base, m0) _Pragma("unroll") for (int q_ = 0; q_ < 4; ++q_) _Pragma("unroll") for (int ks_ = 0; ks_ < 2; ++ks_) dst[q_ * 2 + ks_] = *(LAS bf16x8*)(base + (16 * ((m0) + q_) + r16) * 72 + ks_ * 32 + 8 * g)
#pragma unroll 1
        for (int n = 0; n < 32; ++n) {
            const float last = lastbuf[(b * 32 + n) * 8 + h];
            bf16x8 sb[2][4];
#pragma unroll
            for (int t = 0; t < 2; ++t)
#pragma unroll
                for (int ks = 0; ks < 4; ++ks) sb[t][ks] = pack_pair(st[t][2 * ks], st[t][2 * ks + 1]);
            __syncthreads();
            bf16x8 fa[8], fb[8];
            f32x4 vn[2][4];
            LD_ROWS2(fa, Wl, 0); LD_ROWS2(fb, Wl, 2);
            SB_;
#pragma unroll
            for (int half = 0; half < 2; ++half) {
#pragma unroll
                for (int q = 0; q < 2; ++q) {
                    const int mt = 2 * half + q;
#pragma unroll
                    for (int t = 0; t < 2; ++t) {
                        f32x4 c = zero4();
#pragma unroll
                        for (int ks = 0; ks < 4; ++ks) c = MFMA16(half ? fb[q * 4 + ks] : fa[q * 4 + ks], sb[t][ks], c);
                        LAS u16* up = Ul + (16 * mt + 4 * g) * 136 + dv0 + 16 * t;
                        vn[t][mt] = (f32x4){bf2f(up[0]) - c[0], bf2f(up[136]) - c[1], bf2f(up[272]) - c[2], bf2f(up[408]) - c[3]};
                    }
                }
                if (half == 0) { SB_; LD_ROWS4(fa, KT, 0); SB_; }
            }
            bf16x8 vb[2][2];
#pragma unroll
            for (int t = 0; t < 2; ++t)
#pragma unroll
                for (int ks = 0; ks < 2; ++ks) vb[t][ks] = pack_pair(vn[t][2 * ks], vn[t][2 * ks + 1]);
            SB_;
            LD_ROWS4(fb, KT, 4);
            SB_;
#pragma unroll
            for (int half = 0; half < 2; ++half) {
#pragma unroll
                for (int q = 0; q < 4; ++q)
#pragma unroll
                    for (int t = 0; t < 2; ++t) {
                        f32x4 c = st[t][4 * half + q] * last;
#pragma unroll
                        for (int ks = 0; ks < 2; ++ks) c = MFMA16(half ? fb[q * 2 + ks] : fa[q * 2 + ks], vb[t][ks], c);
                        st[t][4 * half + q] = c;
                    }
                if (half == 0) { SB_; LD_ROWS2(fa, Ql, 0); SB_; } else { SB_; LD_ROWS2(fb, Ql, 2); SB_; }
            }
            f32x4 oa[2][4];
#pragma unroll
            for (int half = 0; half < 2; ++half) {
#pragma unroll
                for (int q = 0; q < 2; ++q)
#pragma unroll
                    for (int t = 0; t < 2; ++t) {
                        f32x4 c = zero4();
#pragma unroll
                        for (int ks = 0; ks < 4; ++ks) c = MFMA16(half ? fb[q * 4 + ks] : fa[q * 4 + ks], sb[t][ks], c);
                        oa[t][2 * half + q] = c;
                    }
                if (half == 0) { SB_; LD_ROWS4(fa, Al, 0); SB_; }
            }
            SB_;
#pragma unroll
            for (int mt = 0; mt < 4; ++mt)
#pragma unroll
                for (int t = 0; t < 2; ++t) {
                    f32x4 c = oa[t][mt];
#pragma unroll
                    for (int ks = 0; ks < 2; ++ks) c = MFMA16(fa[mt * 2 + ks], vb[t][ks], c);
                    const unsigned w0 = pack2(c[0], c[1]), w1 = pack2(c[2], c[3]);
                    LAS u16* op = Ol + (16 * mt + 4 * g) * 136 + dv0 + 16 * t;
                    op[0] = (u16)(w0 & 0xFFFFu); op[136] = (u16)(w0 >> 16); op[272] = (u16)(w1 & 0xFFFFu); op[408] = (u16)(w1 >> 16);
                }
            __syncthreads();
        }
#undef SB_
#undef LD_ROWS2
#undef LD_ROWS4
        float* So = a.out + OFF_GSP + (size_t)(b * 8 + h) * 16384;
#pragma unroll
        for (int t = 0; t < 2; ++t)
#pragma unroll
            for (int nt = 0; nt < 8; ++nt)
#pragma unroll
                for (int i = 0; i < 4; ++i) So[(size_t)(16 * nt + 4 * g + i) * 128 + dv0 + 16 * t] = st[t][nt][i];
    }
}

DI void swa_prompt_item(const Args& a, LAS unsigned char* lds, int it) {
    const int tid = otid(), lane = tid & 63, wid = tid >> 6, r16 = lane & 15, g = lane >> 4;
    const int b = it >> 6, kvh = (it >> 4) & 3, n = it & 15;
    u16* z = (u16*)(a.ws + WS_Z);
    LAS u16* Kl = (LAS u16*)lds;
    LAS u16* VTl = Kl + 256 * 72;
    LAS u16* Pl = VTl + 64 * 280 + wid * (16 * 168);
    const int gq = wid >> 1, th = wid & 1, qh = kvh * 4 + gq;
    bf16x8 qfa[4][2];
#pragma unroll
    for (int mtl = 0; mtl < 4; ++mtl)
#pragma unroll
        for (int ks = 0; ks < 2; ++ks) qfa[mtl][ks] = *(const bf16x8*)(z + ((size_t)(b * 2048 + n * 128 + 16 * (th * 4 + mtl)) + r16) * ZLD + ZSQ + qh * 64 + ks * 32 + g * 8);
#pragma unroll
    for (int i = 0; i < 4; ++i) {
        const int p = tid + 512 * i, key = p & 255, d8 = (p >> 8) * 8, srow = (n - 1) * 128 + key;
        u32x4 kv = (u32x4){0u, 0u, 0u, 0u}, vv = kv;
        if (srow >= 0) { const u16* base = z + (size_t)(b * 2048 + srow) * ZLD + kvh * 64 + d8; kv = *(const u32x4*)(base + ZSK); vv = *(const u32x4*)(base + ZSV); }
        *(LAS u32x4*)(Kl + key * 72 + d8) = kv;
        const unsigned e[4] = {vv.x, vv.y, vv.z, vv.w};
#pragma unroll
        for (int j = 0; j < 4; ++j) { VTl[(d8 + 2 * j) * 280 + key] = (u16)(e[j] & 0xFFFFu); VTl[(d8 + 2 * j + 1) * 280 + key] = (u16)(e[j] >> 16); }
    }
    for (int idx = tid; idx < 1536; idx += 512) { const int d = idx / 24; VTl[d * 280 + 256 + (idx - d * 24)] = 0; }
    __syncthreads();
    const float sink = a.in[19][qh];
#pragma unroll
    for (int mtl = 0; mtl < 4; ++mtl) {
        const int mt = th * 4 + mtl, tq0 = 16 * mt;
        const size_t rowA = (size_t)(b * 2048 + n * 128 + tq0);
        const bf16x8 qf[2] = {qfa[mtl][0], qfa[mtl][1]};
        f32x4 sc[9];
#pragma unroll
        for (int j = 0; j < 9; ++j) {
            f32x4 c = zero4();
#pragma unroll
            for (int ks = 0; ks < 2; ++ks) c = MFMA16(qf[ks], *(LAS bf16x8*)(Kl + (16 * (mt + j) + r16) * 72 + ks * 32 + g * 8), c);
            sc[j] = c;
        }
        float mx[4], sm[4];
#pragma unroll
        for (int i = 0; i < 4; ++i) mx[i] = sink;
#pragma unroll
        for (int j = 0; j < 9; ++j)
#pragma unroll
            for (int i = 0; i < 4; ++i) {
                const int tq = tq0 + 4 * g + i, kk = 16 * (mt + j) + r16;
                const bool valid = (kk > tq) && (kk <= tq + 128) && (n > 0 || kk >= 128);
                const float sv = valid ? sc[j][i] * 0.125f : -1e30f;
                sc[j][i] = sv; mx[i] = fmaxf(mx[i], sv);
            }
#pragma unroll
        for (int i = 0; i < 4; ++i) {
            float m = mx[i];
            mx[i] = row_max16(m); sm[i] = 0.f;
        }
#pragma unroll
        for (int j = 0; j < 9; ++j)
#pragma unroll
            for (int i = 0; i < 4; ++i) {
                const float p = (sc[j][i] > -1e29f) ? __expf(sc[j][i] - mx[i]) : 0.f;
                sm[i] += p;
                Pl[(4 * g + i) * 168 + 16 * j + r16] = f2bf(p);
            }
#pragma unroll
        for (int i = 0; i < 4; ++i) {
            Pl[(4 * g + i) * 168 + 144 + r16] = 0;
            const float s = row_sum16(sm[i]);
            sm[i] = 1.f / (s + __expf(sink - mx[i]));
        }
        f32x4 o[4];
#pragma unroll
        for (int nd = 0; nd < 4; ++nd) o[nd] = zero4();
#pragma unroll
        for (int ks = 0; ks < 5; ++ks) {
            const bf16x8 pa = *(LAS bf16x8*)(Pl + r16 * 168 + ks * 32 + g * 8);
#pragma unroll
            for (int nd = 0; nd < 4; ++nd) o[nd] = MFMA16(pa, *(LAS bf16x8*)(VTl + (16 * nd + r16) * 280 + 16 * mt + ks * 32 + g * 8), o[nd]);
        }
#pragma unroll
        for (int nd = 0; nd < 4; ++nd)
#pragma unroll
            for (int i = 0; i < 4; ++i) z[(rowA + 4 * g + i) * ZLD + ZSQ + qh * 64 + 16 * nd + r16] = f2bf(o[nd][i] * sm[i]);
    }
    __syncthreads();
}

DI void swa_sample_item(const Args& a, LAS unsigned char* lds, int it) {
    const int tid = otid(), lane = tid & 63, wid = tid >> 6;
    const int b = it >> 2, kvh = it & 3;
    u16* zr = (u16*)(a.ws + WS_Z) + (size_t)(NP + b) * ZLD;
    LAS float* ql = (LAS float*)lds;
    LAS float* ps = ql + 256;
    LAS float* pl = ps + 2048;
    LAS float* red = pl + 512;
    LAS float* po = red + 16;
    const int key = tid & 127, qt = tid >> 7;
    f32x4 kv[4];
    if (key < 127) { const float* kp = a.in[6] + ((size_t)(b * 128 + key + 1) * 4 + kvh) * 64 + qt * 16;
#pragma unroll
        for (int i = 0; i < 4; ++i) kv[i] = *(const f32x4*)(kp + 4 * i);
    } else { const u16* kp = zr + ZSK + kvh * 64 + qt * 16;
#pragma unroll
        for (int i = 0; i < 4; ++i) kv[i] = (f32x4){bf2f(kp[4 * i]), bf2f(kp[4 * i + 1]), bf2f(kp[4 * i + 2]), bf2f(kp[4 * i + 3])};
    }
    const int d4 = (tid & 15) * 4, kg = tid >> 4;
    f32x4 vv[4];
#pragma unroll
    for (int i = 0; i < 4; ++i) {
        const int kx = 4 * kg + i;
        if (kx < 127) vv[i] = *(const f32x4*)(a.in[7] + ((size_t)(b * 128 + kx + 1) * 4 + kvh) * 64 + d4);
        else { const u16* vp = zr + ZSV + kvh * 64 + d4; vv[i] = (f32x4){bf2f(vp[0]), bf2f(vp[1]), bf2f(vp[2]), bf2f(vp[3])}; }
    }
    if (tid < 256) ql[tid] = bf2f(zr[ZSQ + kvh * 256 + tid]);
    __syncthreads();
#pragma unroll
    for (int gq = 0; gq < 4; ++gq) {
        float s = 0.f;
#pragma unroll
        for (int i = 0; i < 4; ++i) { const f32x4 q4 = *(LAS f32x4*)(ql + gq * 64 + qt * 16 + 4 * i); s += q4[0] * kv[i][0] + q4[1] * kv[i][1] + q4[2] * kv[i][2] + q4[3] * kv[i][3]; }
        ps[(qt * 4 + gq) * 128 + key] = s;
    }
    __syncthreads();
    const int gq = tid >> 7;
    const float s = 0.125f * (ps[(0 * 4 + gq) * 128 + key] + ps[(1 * 4 + gq) * 128 + key] + ps[(2 * 4 + gq) * 128 + key] + ps[(3 * 4 + gq) * 128 + key]);
    const float sink = a.in[19][kvh * 4 + gq];
    float m = row_max16(s); m = fmaxf(m, __shfl_xor(m, 16)); m = fmaxf(m, __shfl_xor(m, 32));
    if (lane == 0) red[wid] = m;
    __syncthreads();
    m = fmaxf(fmaxf(red[2 * gq], red[2 * gq + 1]), sink);
    const float p = __expf(s - m);
    float psum = row_sum16(p); psum += __shfl_xor(psum, 16); psum += __shfl_xor(psum, 32);
    if (lane == 0) red[8 + wid] = psum;
    __syncthreads();
    pl[gq * 128 + key] = p * __builtin_amdgcn_rcpf(red[8 + 2 * gq] + red[8 + 2 * gq + 1] + __expf(sink - m));
    __syncthreads();
#pragma unroll
    for (int g2 = 0; g2 < 4; ++g2) {
        const f32x4 pw = *(LAS f32x4*)(pl + g2 * 128 + 4 * kg);
        *(LAS f32x4*)(po + (kg * 4 + g2) * 64 + d4) = vv[0] * pw[0] + vv[1] * pw[1] + vv[2] * pw[2] + vv[3] * pw[3];
    }
    __syncthreads();
    if (tid < 256) {
        float o = 0.f;
#pragma unroll
        for (int k2 = 0; k2 < 32; ++k2) o += po[k2 * 256 + tid];
        zr[ZSQ + kvh * 256 + tid] = f2bf(o);
    }
    __syncthreads();
}

DI void gdn_sample_item(const Args& a, LAS unsigned char* lds, int it) {
    const int tid = otid(), lane = tid & 63, wid = tid >> 6;
    const int b = it >> 3, h = it & 7, row = NP + b;
    u16* zr = (u16*)(a.ws + WS_Z) + (size_t)row * ZLD;
    const float* zb = (const float*)(a.ws + WS_ZB) + (size_t)row * 16;
    const float* cw = a.in[14];
    LAS float* act = (LAS float*)lds;
    LAS float* nrm = act + 384;
    LAS float* pkl = act + 512;
    LAS float* pql = pkl + 2048;
    const int dv4 = (tid & 31) * 4, dk0 = tid >> 5;
    const float* S0 = a.in[4] + (size_t)(b * 8 + h) * 16384;
    f32x4 sd[8];
#pragma unroll
    for (int i = 0; i < 8; ++i) sd[i] = __builtin_nontemporal_load((const f32x4*)(S0 + (size_t)(dk0 + 16 * i) * 128 + dv4));
    if (tid < 384) {
        const int col = (tid >> 7) * 1024 + h * 128 + (tid & 127);
        float x = cw[3 * 3072 + col] * bf2f(zr[col]);
#pragma unroll
        for (int j = 0; j < 3; ++j) x += cw[j * 3072 + col] * a.in[5][((size_t)b * 3 + j) * 3072 + col];
        act[tid] = silu(x);
    }
    __syncthreads();
    if (wid < 3) {
        const int o0 = wid == 2 ? 0 : wid * 128, o1 = wid == 2 ? 128 : wid * 128;
        float ss = act[o0 + lane] * act[o1 + lane] + act[o0 + 64 + lane] * act[o1 + 64 + lane];
#pragma unroll
        for (int o = 1; o < 64; o <<= 1) ss += __shfl_xor(ss, o);
        if (lane == 0) nrm[wid] = ss;
    }
    __syncthreads();
    const float qs = rsqrtf(nrm[0] + EPS) * 0.08838834764831845f, ksc = rsqrtf(nrm[1] + EPS), qk = nrm[2] * qs * ksc;
    const float beta = sigm(zb[h]);
    const float eg = __expf(-__expf(a.in[15][h]) * softplus(zb[8 + h] + a.in[16][h]));
    float* S1 = a.out + OFF_GSS + (size_t)(b * 8 + h) * 16384;
    f32x4 pk = zero4(), pq = zero4();
#pragma unroll
    for (int i = 0; i < 8; ++i) {
        const int dk = dk0 + 16 * i;
        sd[i] = sd[i] * eg;
        pk += sd[i] * (act[128 + dk] * ksc); pq += sd[i] * (act[dk] * qs);
    }
    *(LAS f32x4*)(pkl + dk0 * 128 + dv4) = pk; *(LAS f32x4*)(pql + dk0 * 128 + dv4) = pq;
    __syncthreads();
    f32x4 ksum = zero4(), qsum = zero4();
#pragma unroll
    for (int r = 0; r < 16; ++r) { ksum += *(LAS f32x4*)(pkl + r * 128 + dv4); qsum += *(LAS f32x4*)(pql + r * 128 + dv4); }
    f32x4 delta;
#pragma unroll
    for (int c = 0; c < 4; ++c) delta[c] = (act[256 + dv4 + c] - ksum[c]) * beta;
#pragma unroll
    for (int i = 0; i < 8; ++i) { const int dk = dk0 + 16 * i; __builtin_nontemporal_store(sd[i] + delta * (act[128 + dk] * ksc), (f32x4*)(S1 + (size_t)dk * 128 + dv4)); }
    if (tid < 32) {
        const f32x4 o = qsum + delta * qk;
        float ss = o[0] * o[0] + o[1] * o[1] + o[2] * o[2] + o[3] * o[3];
#pragma unroll
        for (int m = 1; m < 32; m <<= 1) ss += __shfl_xor(ss, m);
        const float rstd = rsqrtf(ss * (1.f / 128.f) + EPS);
        u16* gp = zr + ZG + h * 128 + dv4;
        const u32x2 gv = *(const u32x2*)gp;
        const float g0 = bflo(gv.x), g1 = bfhi(gv.x), g2 = bflo(gv.y), g3 = bfhi(gv.y);
        const f32x4 w = *(const f32x4*)(a.in[17] + dv4);
        *(u32x2*)gp = (u32x2){pack2(o[0] * rstd * w[0] * g0, o[1] * rstd * w[1] * g1), pack2(o[2] * rstd * w[2] * g2, o[3] * rstd * w[3] * g3)};
    }
    __syncthreads();
}

DI void state_copies(const Args& a, int vt, int nvt) {
    const u16* z = (const u16*)(a.ws + WS_Z);
    const u16* halo = (const u16*)(a.ws + WS_HALO);
    float* out = a.out;
    for (int i = vt; i < 8 * 3 * 3072; i += nvt) { const int b = i / 9216, r = i - b * 9216; out[OFF_GCP + i] = bf2f(halo[(size_t)((b * 32 + 31) * 3) * 3072 + r]); }
    for (int i = vt; i < 128 * 3 * 3072; i += nvt) {
        const int b = i / 9216, r = i - b * 9216, j = r / 3072, c = r - j * 3072;
        out[OFF_GCS + i] = (j < 2) ? a.in[5][((size_t)b * 3 + j + 1) * 3072 + c] : bf2f(z[(size_t)(NP + b) * ZLD + c]);
    }
    for (int i = vt; i < 8 * 128 * 256; i += nvt) {
        const int b = i >> 15, w = (i >> 8) & 127, c = i & 255;
        const u16* zr = z + (size_t)(b * 2048 + 1920 + w) * ZLD;
        out[OFF_KP + i] = bf2f(zr[ZSK + c]); out[OFF_VP + i] = bf2f(zr[ZSV + c]);
    }
    for (int i = vt; i < 128 * 128 * 64; i += nvt) {
        const int b = i >> 13, w = (i >> 6) & 127, c = (i & 63) * 4;
        f32x4 kv, vv;
        if (w < 127) { const size_t o = ((size_t)b * 128 + w + 1) * 256 + c; kv = *(const f32x4*)(a.in[6] + o); vv = *(const f32x4*)(a.in[7] + o); }
        else { const u16* zr = z + (size_t)(NP + b) * ZLD;
            kv = (f32x4){bf2f(zr[ZSK + c]), bf2f(zr[ZSK + c + 1]), bf2f(zr[ZSK + c + 2]), bf2f(zr[ZSK + c + 3])};
            vv = (f32x4){bf2f(zr[ZSV + c]), bf2f(zr[ZSV + c + 1]), bf2f(zr[ZSV + c + 2]), bf2f(zr[ZSV + c + 3])}; }
        __builtin_nontemporal_store(kv, (f32x4*)(out + OFF_KS + (size_t)i * 4)); __builtin_nontemporal_store(vv, (f32x4*)(out + OFF_VS + (size_t)i * 4));
    }
}

__global__ void __launch_bounds__(512, 2) fwd_megakernel(Args a) {
    extern __shared__ __attribute__((aligned(16))) unsigned char smem[];
    LAS unsigned char* lds = (LAS unsigned char*)smem;
    cg::grid_group grid = cg::this_grid();
    if (a.ws == nullptr) grid.sync();
    { volatile LAS unsigned* st_ = (volatile LAS unsigned*)(lds + LDS_XB); if (threadIdx.x < 4) st_[threadIdx.x] = 0u; }
    __syncthreads();
    const XcdBarrier xbar = xcd_barrier_post((unsigned*)(a.ws + WS_BAR), (volatile LAS unsigned*)(lds + LDS_XB));
    u16* H = (u16*)(a.ws + WS_H);
    u16* Z = (u16*)(a.ws + WS_Z);
    phase0(a, lds);
    xcd_barrier(xbar);
    phase_norm<0>(a);
    xcd_barrier(xbar);
    { EpiZ e; e.z = Z; e.gab = (u16*)a.out; e.zb = (float*)(a.ws + WS_ZB); e.halo = (u16*)(a.ws + WS_HALO);
      run_gemm(lds, H, 1024, (const u16*)(a.ws + WS_RA), 1024, MP, N1, 1024, e); }
    xcd_barrier(xbar);
    phase_prep(a, lds);
    xcd_barrier(xbar);
    if (blockIdx.x < 64) {
        phase_scan(a, lds, blockIdx.x);
        __syncthreads();
    } else {
        const int v = blockIdx.x - 64, nv = gridDim.x - 64, v2 = (v + 64) % nv;
        if (gridDim.x == 256) {
            const int xcd = blockIdx.x & 7, j = v >> 3;
            for (int m = j; m < 64; m += 24) swa_prompt_item(a, lds, (xcd + 8 * (m >> 4)) * 16 + (m & 15));
        } else {
            for (int it = v; it < 512; it += nv) swa_prompt_item(a, lds, it);
        }
        for (int it = v2; it < 1024; it += nv) gdn_sample_item(a, lds, it);
        for (int it = v2; it < 512; it += nv) swa_sample_item(a, lds, it);
        state_copies(a, v * 512 + otid(), nv * 512);
    }
    xcd_barrier(xbar);
    skinny_phase<0>(a, lds);
    { EpiMixBoth e; e.e0.mix = H; e.e0.gab = (const u16*)a.out; e.e1.mix = H; e.e1.gab = (const u16*)a.out;
      pg8::Gemm g; g.A = Z + ZG; g.Bt = (const u16*)(a.ws + WS_WA); g.A2 = Z + ZSQ; g.Bt2 = (const u16*)(a.ws + WS_WB); g.M = NP; g.N = 1024; g.K = 1024; g.lda = ZLD; g.ldb = 1024;
      MixOrder S; S.base.init(NP, 1024, (int)gridDim.x, (int)blockIdx.x);
      pg8::gemm_phase<EpiMixBoth, MixOrder, false>((PG8_LAS unsigned char*)lds, g, S, e, nullptr); }
    xcd_barrier(xbar);
    { EpiRes<0> e; e.out = a.out; e.xp = a.in[0]; e.xs = a.in[1]; e.mod = (const float*)(a.ws + WS_MOD); e.xh = nullptr; skinny_phase<1>(a, lds);
      run_gemm(lds, H, 1024, (const u16*)(a.ws + WS_WO), 1024, NP, 1024, 1024, e); }
    xcd_barrier(xbar);
    phase_norm<1>(a);
    xcd_barrier(xbar);
    { EpiPlain e; e.o = Z; e.ld = FF; run_gemm(lds, H, 1024, (const u16*)(a.ws + WS_WG), 1024, MP, FF, 1024, e); }
    xcd_barrier(xbar);
    { EpiAct e; e.act = Z + (size_t)MP * FF; e.gate = Z; e.cw = a.in[24]; e.cb = a.in[25]; e.sf = a.in[8]; e.out = a.out;
      run_gemm(lds, H, 1024, (const u16*)(a.ws + WS_WU), 1024, MP, FF, 1024, e); }
    xcd_barrier(xbar);
    { EpiRes<1> e; e.out = a.out; e.xp = a.in[0]; e.xs = a.in[1]; e.mod = (const float*)(a.ws + WS_MOD); e.xh = H; skinny_phase<2>(a, lds);
      run_gemm(lds, Z + (size_t)MP * FF, FF, (const u16*)(a.ws + WS_WD), FF, NP, 1024, FF, e); }
    xcd_barrier(xbar);
    phase_final(a);
}

extern "C" void kernel_launch(void* const* d_in, const int* in_sizes, int n_in, void* d_out, int out_size, void* d_ws, size_t ws_size, hipStream_t stream) {
    static int grid = 0;
    if (grid == 0) {
        if (n_in != 28 || ws_size < WS_END) { fprintf(stderr, "kernel_launch: expected 28 inputs and >= %zu bytes of workspace (got %d, %zu)\n", (size_t)WS_END, n_in, ws_size); grid = -1; return; }
        int dev = 0, cus = 0, per_cu = 0;
        hipGetDevice(&dev);
        hipDeviceGetAttribute(&cus, hipDeviceAttributeMultiprocessorCount, dev);
        if (hipFuncSetAttribute((const void*)fwd_megakernel, hipFuncAttributeMaxDynamicSharedMemorySize, LDS_BYTES) != hipSuccess) { fprintf(stderr, "kernel_launch: hipFuncSetAttribute failed\n"); grid = -1; return; }
        hipOccupancyMaxActiveBlocksPerMultiprocessor(&per_cu, (const void*)fwd_megakernel, 512, LDS_BYTES);
        if (per_cu < 1) fprintf(stderr, "kernel_launch: occupancy query says %d blocks per CU\n", per_cu);
        (void)hipGetLastError();
        grid = cus;
    }
    if (grid < 0) return;
    if (hipMemsetAsync((char*)d_ws + WS_BAR, 0, 16384, stream) != hipSuccess) { fprintf(stderr, "kernel_launch: memset of the barrier words failed\n"); return; }
    Args a{};
    for (int i = 0; i < 28; ++i) a.in[i] = (const float*)d_in[i];
    a.out = (float*)d_out; a.ws = (unsigned char*)d_ws;
    void* args[] = {&a};
    hipError_t e = hipLaunchCooperativeKernel((const void*)fwd_megakernel, dim3(grid), dim3(512), args, LDS_BYTES, stream);
    if (e != hipSuccess) fprintf(stderr, "cooperative launch failed: %s (grid %d)\n", hipGetErrorString(e), grid);
}
```

```cpp
#include <hip/hip_runtime.h>
#include <hip/hip_cooperative_groups.h>
#include <cstdio>
namespace cg = cooperative_groups;
__device__ __forceinline__ int otid() { int t = threadIdx.x; asm volatile("" : "+v"(t)); return t; }
namespace pg8 {
#define PG8_LAS __attribute__((address_space(3)))
typedef unsigned short bf16_t;
typedef short bf16x8 __attribute__((ext_vector_type(8)));
typedef float f32x4 __attribute__((ext_vector_type(4)));
typedef unsigned u32x4 __attribute__((ext_vector_type(4)));
constexpr int BM = 256, BK = 64, HALF = 128, HTB = HALF * BK * 2  , STAGE_BYTES = 8 * HTB, NXCD = 8, WGM = 8;

__host__ __device__ __forceinline__ int lds_byte(int r, int c) { const int st = (r >> 4) * 2 + (c >> 5), rr = r & 15, cc = c & 31, ob = rr * 64 + cc * 2; return st * 1024 + (ob ^ (((ob >> 9) & 1) << 5)); }
__host__ __device__ __forceinline__ void stage_rc(int b, int& R, int& C) { const int st = b / 1024, sb = b % 1024, swz = sb ^ (((sb >> 9) & 1) << 5); R = (st >> 1) * 16 + swz / 64; C = (st & 1) * 32 + (swz % 64) / 2; }
__host__ __device__ __forceinline__ int perm32(int rho) { const int n = rho >> 4, i = rho & 15; return 8 * (i >> 2) + 4 * n + (i & 3); }

struct Unit { int pm, pn, sel = 0; };
struct Gemm { const bf16_t* A; const bf16_t* Bt; int M, N, K, lda, ldb; const bf16_t* A2 = nullptr; const bf16_t* Bt2 = nullptr; };

struct StaticOrder {
    int nM, nN, nwg, G, c;
    __host__ __device__ void init(int M, int N, int G_, int c_) { nM = M / BM; nN = N / BM; nwg = nM * nN; G = G_; c = c_; }
    __host__ __device__ bool next(int i, Unit& u) const {
        const long L = (long)i * G + c; if (L >= nwg) return false;
        int wgid = (int)L; { const int q = nwg / NXCD, r = nwg % NXCD, xcd = wgid % NXCD, off = wgid / NXCD; wgid = (xcd < r ? xcd * (q + 1) : r * (q + 1) + (xcd - r) * q) + off; }
        const int nig = WGM * nN, gid = wgid / nig, fm = gid * WGM, gsz = (nM - fm) < WGM ? (nM - fm) : WGM;
        u.pm = fm + ((wgid % nig) % gsz); u.pn = (wgid % nig) / gsz; return true;
    }
    __device__ __forceinline__ void a_ready(const Unit&) const {}
    __device__ __forceinline__ void done(const Unit&) const {}
};

template <class Epi, class Sched, bool STAMP = false>
__device__ __forceinline__ void gemm_phase(PG8_LAS unsigned char* lds, const Gemm g, const Sched& S, const Epi& E, unsigned long long* stamps) {
    const int tid = otid(), wid = __builtin_amdgcn_readfirstlane(tid >> 6), lane = tid & 63, wr = wid >> 2, wc = wid & 3, fr = lane & 15, fq = lane >> 4;
    const int K = g.K, nt = K / BK;
    int ts_lo = 0, ts_hi = 0, nts = 0; const unsigned long long rt_entry = STAMP ? (unsigned long long)wall_clock64() : 0ull;
#define PG8_STAMP() do { if (STAMP && wid == 0 && nts < 64) { const unsigned long long _c = (unsigned long long)clock64(); \
        ts_lo = (lane == nts) ? (int)(unsigned)_c : ts_lo; ts_hi = (lane == nts) ? (int)(unsigned)(_c >> 32) : ts_hi; ++nts; } } while (0)
    PG8_STAMP();
    unsigned voffA[2], voffB[2];
#pragma unroll
    for (int i = 0; i < 2; ++i) { int R, C; stage_rc(tid * 16 + i * 8192, R, C); const int Rb = Epi::PERM ? ((R & ~31) + perm32(R & 31)) : R;
        voffA[i] = (unsigned)(R * g.lda + C) * 2u; voffB[i] = (unsigned)(Rb * g.ldb + C) * 2u; }
    const size_t kstep = (size_t)(BK * 2);
    const size_t hstepA = (size_t)HALF * g.lda * 2, hstepB = (size_t)HALF * g.ldb * 2;
    const size_t tstepA = 2 * hstepA, tstepB = 2 * hstepB;
    const unsigned ldsw = (unsigned)wid * 1024u;
    const int aoff = lds_byte(wr * 64 + fr, fq * 8), boff = lds_byte(wc * 32 + fr, fq * 8);
#define PG8_SA(b, h) (((b) * 2 + (h)) * HTB)
#define PG8_SB(b, h) ((4 + (b) * 2 + (h)) * HTB)
#define PG8_STAGE(bufoff, gbase, voff) do { _Pragma("unroll") for (int _i = 0; _i < 2; ++_i) \
        __builtin_amdgcn_global_load_lds((const unsigned*)((const char*)(gbase) + (voff)[_i]), (PG8_LAS unsigned*)(lds + (bufoff) + ldsw + _i * 8192), 16, 0, 0); } while (0)
#define PG8_LDA(dst, b, h) do { _Pragma("unroll") for (int m = 0; m < 4; ++m) _Pragma("unroll") for (int k = 0; k < 2; ++k) dst[m][k] = *(const PG8_LAS bf16x8*)(lds + PG8_SA(b, h) + aoff + m * 2048 + k * 1024); } while (0)
#define PG8_LDB(dst, b, h) do { _Pragma("unroll") for (int n = 0; n < 2; ++n) _Pragma("unroll") for (int k = 0; k < 2; ++k) dst[n][k] = *(const PG8_LAS bf16x8*)(lds + PG8_SB(b, h) + boff + n * 2048 + k * 1024); } while (0)
#define PG8_MMA(ai, bj, At, Bt) do { __builtin_amdgcn_s_setprio(1); _Pragma("unroll") for (int m = 0; m < 4; ++m) _Pragma("unroll") for (int n = 0; n < 2; ++n) _Pragma("unroll") for (int k = 0; k < 2; ++k) \
        acc[ai][bj][m][n] = __builtin_amdgcn_mfma_f32_16x16x32_bf16(Bt[n][k], At[m][k], acc[ai][bj][m][n], 0, 0, 0); __builtin_amdgcn_s_setprio(0); } while (0)
#define PG8_WAIT_V(n) asm volatile("s_waitcnt vmcnt(" #n ")" ::: "memory")
#define PG8_WAIT_L(n) asm volatile("s_waitcnt lgkmcnt(" #n ")" ::: "memory")
#define PG8_BAR __builtin_amdgcn_s_barrier()
#define PG8_SCHED __builtin_amdgcn_sched_barrier(0)
    Unit cur, nxt; int ui = 0;
    if (!S.next(0, cur)) return;
    f32x4 acc[2][2][4][2];
#pragma unroll
    for (int a = 0; a < 2; ++a)
#pragma unroll
        for (int b = 0; b < 2; ++b)
#pragma unroll
            for (int m = 0; m < 4; ++m)
#pragma unroll
                for (int n = 0; n < 2; ++n) acc[a][b][m][n] = (f32x4){0.f, 0.f, 0.f, 0.f};
    bf16x8 At[4][2], B0[2][2], B1[2][2];
    const char* cA = (const char*)(cur.sel ? g.A2 : g.A) + (size_t)cur.pm * tstepA; const char* cB = (const char*)(cur.sel ? g.Bt2 : g.Bt) + (size_t)cur.pn * tstepB;
    S.a_ready(cur);
    PG8_STAGE(PG8_SB(0, 0), cB, voffB); PG8_STAGE(PG8_SA(0, 0), cA, voffA); PG8_STAGE(PG8_SB(0, 1), cB + hstepB, voffB); PG8_STAGE(PG8_SA(0, 1), cA + hstepA, voffA);
    if (wr == 1) PG8_BAR;
    PG8_WAIT_V(4); PG8_BAR;
    PG8_STAGE(PG8_SB(1, 0), cB + kstep, voffB); PG8_STAGE(PG8_SA(1, 0), cA + kstep, voffA); PG8_STAGE(PG8_SB(1, 1), cB + hstepB + kstep, voffB);
    PG8_WAIT_V(6); PG8_BAR;
    PG8_STAMP();
    for (;;) {
        const bool has_next = S.next(ui + 1, nxt);
        const char* nA = has_next ? (const char*)(nxt.sel ? g.A2 : g.A) + (size_t)nxt.pm * tstepA : cA; const char* nB = has_next ? (const char*)(nxt.sel ? g.Bt2 : g.Bt) + (size_t)nxt.pn * tstepB : cB;
        for (int t = 0; t < nt; t += 2) {
            const bool last = (t == nt - 2);
            const char* a1 = cA + (size_t)(t + 1) * kstep;
            const char* a2 = last ? nA : cA + (size_t)(t + 2) * kstep; const char* b2 = last ? nB : cB + (size_t)(t + 2) * kstep;
            const char* a3 = a2 + kstep; const char* b3 = b2 + kstep;
            if (last && has_next) S.a_ready(nxt);
            PG8_LDB(B0, 0, 0); PG8_SCHED; PG8_LDA(At, 0, 0); PG8_STAGE(PG8_SA(1, 1), a1 + hstepA, voffA);
            PG8_WAIT_L(8); PG8_BAR; PG8_WAIT_L(0); PG8_MMA(0, 0, At, B0); PG8_BAR; PG8_SCHED;
            PG8_LDB(B1, 0, 1); PG8_STAGE(PG8_SB(0, 0), b2, voffB);
            PG8_BAR; PG8_WAIT_L(0); PG8_MMA(0, 1, At, B1); PG8_BAR;
            PG8_LDA(At, 0, 1); PG8_STAGE(PG8_SA(0, 0), a2, voffA);
            PG8_BAR; PG8_WAIT_L(0); PG8_MMA(1, 0, At, B0); PG8_BAR; PG8_SCHED;
            PG8_STAGE(PG8_SB(0, 1), b2 + hstepB, voffB);
            PG8_WAIT_V(6); PG8_BAR; PG8_MMA(1, 1, At, B1); PG8_BAR;
            PG8_LDB(B0, 1, 0); PG8_SCHED; PG8_LDA(At, 1, 0); PG8_STAGE(PG8_SA(0, 1), a2 + hstepA, voffA);
            PG8_WAIT_L(8); PG8_BAR; PG8_WAIT_L(0); PG8_MMA(0, 0, At, B0); PG8_BAR; PG8_SCHED;
            PG8_LDB(B1, 1, 1); PG8_STAGE(PG8_SB(1, 0), b3, voffB);
            PG8_BAR; PG8_WAIT_L(0); PG8_MMA(0, 1, At, B1); PG8_BAR;
            PG8_LDA(At, 1, 1); PG8_STAGE(PG8_SA(1, 0), a3, voffA);
            PG8_BAR; PG8_WAIT_L(0); PG8_MMA(1, 0, At, B0); PG8_BAR; PG8_SCHED;
            PG8_STAGE(PG8_SB(1, 1), b3 + hstepB, voffB);
            PG8_WAIT_V(6); PG8_BAR; PG8_MMA(1, 1, At, B1); PG8_BAR;
        }
        PG8_STAMP();
        if constexpr (!Epi::AFTER_DRAIN) { E(acc, cur, wr, wc, fr, fq); S.done(cur); }
        PG8_STAMP();
        if (!has_next) break;
#pragma unroll
        for (int a = 0; a < 2; ++a)
#pragma unroll
            for (int b = 0; b < 2; ++b)
#pragma unroll
                for (int m = 0; m < 4; ++m)
#pragma unroll
                    for (int n = 0; n < 2; ++n) acc[a][b][m][n] = (f32x4){0.f, 0.f, 0.f, 0.f};
        cur = nxt; cA = nA; cB = nB; ++ui;
    }
    PG8_WAIT_V(0);
    if (wr == 0) PG8_BAR;
    PG8_BAR;
    if constexpr (Epi::AFTER_DRAIN) { E.fused(acc, cur, wr, wc, fr, fq, lds, wid, lane); S.done(cur); }
    PG8_STAMP();
    if (STAMP && wid == 0) { stamps[lane] = lane < nts ? (((unsigned long long)(unsigned)ts_hi << 32) | (unsigned)ts_lo) : 0ull;
        if (lane == 62) stamps[62] = rt_entry; if (lane == 63) stamps[63] = (unsigned long long)wall_clock64(); }
#undef PG8_STAMP
#undef PG8_SA
#undef PG8_SB
#undef PG8_STAGE
#undef PG8_LDA
#undef PG8_LDB
#undef PG8_MMA
#undef PG8_WAIT_V
#undef PG8_WAIT_L
#undef PG8_BAR
#undef PG8_SCHED
}
}


typedef unsigned short u16;
typedef short bf16x8 __attribute__((ext_vector_type(8)));
typedef float f32x4 __attribute__((ext_vector_type(4)));
typedef unsigned u32x4 __attribute__((ext_vector_type(4)));
typedef unsigned u32x2 __attribute__((ext_vector_type(2)));
#define LAS __attribute__((address_space(3)))
#define DI __device__ __forceinline__
#define MFMA16(a, b, c) __builtin_amdgcn_mfma_f32_16x16x32_bf16((a), (b), (c), 0, 0, 0)

#define XB_TMO      128
#define XB_XCNT(j)  (256  + 64 * (j))
#define XB_XSUB(j)  (1280 + 64 * (j))
#define XB_XGEN(j)  (2304 + 64 * (j))
#define XB_TOP      3328
#define XB_TOPGEN   3392
#define XCD_BAR_WORDS 3456
#define XB_SPIN_CAP (1u << 18)

__device__ __forceinline__ unsigned xb_ld(unsigned* p)              { return __hip_atomic_load(p, __ATOMIC_RELAXED, __HIP_MEMORY_SCOPE_AGENT); }
__device__ __forceinline__ unsigned xb_add(unsigned* p, unsigned v) { return __hip_atomic_fetch_add(p, v, __ATOMIC_RELAXED, __HIP_MEMORY_SCOPE_AGENT); }
__device__ __forceinline__ unsigned xb_xcc_id() { return (unsigned)__builtin_amdgcn_s_getreg((3 << 11) | 20) & 0xFu; }
#define XB_SPIN(cond, bar) do { unsigned _sp = 0; while (cond) { __builtin_amdgcn_s_sleep(1); \
    if ((++_sp & 255u) == 0u) { if (xb_ld(&(bar)[XB_TMO])) break; if (_sp > XB_SPIN_CAP) { atomicAdd(&(bar)[XB_TMO], 1u); break; } } } } while (0)

struct XcdBarrier {
    unsigned* bar; unsigned x;
    volatile LAS unsigned* st;
};

__device__ __forceinline__ XcdBarrier xcd_barrier_post(unsigned* bar, volatile LAS unsigned* st) {
    XcdBarrier b; b.bar = bar; b.x = xb_xcc_id(); b.st = st;
    if (threadIdx.x == 0) (void)xb_add(&bar[XB_XCNT(b.x)], 1u);
    return b;
}
__device__ __forceinline__ void xcd_barrier_complete(unsigned* bar, unsigned x, unsigned& nloc, unsigned& nx) {
    const unsigned G = gridDim.x * gridDim.y * gridDim.z;
    unsigned sum, cnt, mine, sp = 0u;
    for (;;) {
        sum = 0u; cnt = 0u; mine = 0u;
#pragma unroll
        for (unsigned j = 0; j < 16; ++j) { const unsigned c = xb_ld(&bar[XB_XCNT(j)]); sum += c; cnt += (c > 0u) ? 1u : 0u; mine = (j == x) ? c : mine; }
        if (sum == G) break;
        __builtin_amdgcn_s_sleep(1);
        if ((++sp & 255u) == 0u) { if (xb_ld(&bar[XB_TMO])) break; if (sp > XB_SPIN_CAP) { atomicAdd(&bar[XB_TMO], 1u); break; } }
    }
    nloc = mine > 0u ? mine : 1u; nx = cnt > 0u ? cnt : 1u;
}

__device__ __forceinline__ void xcd_barrier(const XcdBarrier& b) {
    asm volatile("s_waitcnt vmcnt(0)" ::: "memory");
    __syncthreads();
    if (threadIdx.x == 0) {
        unsigned* bar = b.bar;
        __builtin_amdgcn_s_waitcnt(0);
        unsigned nloc = b.st[0], nx = b.st[1];
        if (nloc == 0u) { xcd_barrier_complete(bar, b.x, nloc, nx); b.st[0] = nloc; b.st[1] = nx; }
        const unsigned old = xb_add(&bar[XB_XSUB(b.x)], 1u);
        const unsigned gen = old / nloc;
        if (old + 1u == (gen + 1u) * nloc) {
            __builtin_amdgcn_fence(__ATOMIC_RELEASE, "agent");
            asm volatile("s_waitcnt vmcnt(0)" ::: "memory");
            const unsigned og = xb_add(&bar[XB_TOP], 1u);
            const unsigned tg = og / nx;
            if (og + 1u == (tg + 1u) * nx) xb_add(&bar[XB_TOPGEN], 1u);
            else XB_SPIN(xb_ld(&bar[XB_TOPGEN]) == tg, bar);
            __builtin_amdgcn_fence(__ATOMIC_ACQUIRE, "agent");
            xb_add(&bar[XB_XGEN(b.x)], 1u);
            asm volatile("s_waitcnt vmcnt(0)" ::: "memory");
        } else {
            XB_SPIN(xb_ld(&bar[XB_XGEN(b.x)]) == gen, bar);
            __builtin_amdgcn_fence(__ATOMIC_ACQUIRE, "agent");
            asm volatile("s_waitcnt vmcnt(0)" ::: "memory");
        }
    }
    __syncthreads();
}


constexpr int NP = 16384, NS = 128, NR = 16512, MP = 16640;
constexpr int ZLD = 5632, FF = 2816, N1 = 7936;
constexpr int ZQ = 0, ZK = 1024, ZV = 2048, ZG = 3072, ZSQ = 4096, ZSK = 5120, ZSV = 5376;
constexpr float EPS = 1e-6f;
constexpr size_t WS_RA = 0;
constexpr size_t WS_WA = WS_RA + 16777216;
constexpr size_t WS_WB = WS_WA + 2097152;
constexpr size_t WS_WO = WS_WB + 2097152;
constexpr size_t WS_WG = WS_WO + 2097152;
constexpr size_t WS_WU = WS_WG + 5767168;
constexpr size_t WS_WD = WS_WU + 5767168;
constexpr size_t WS_MOD = WS_WD + 5767168;
constexpr size_t WS_ZB = WS_MOD + 3342336;
constexpr size_t WS_HALO = WS_ZB + 1064960;
constexpr size_t WS_LAST = WS_HALO + 4718592;
constexpr size_t WS_H = WS_LAST + 8192;
constexpr size_t WS_Z = WS_H + 34078720;
constexpr size_t WS_BAR = WS_Z + 187432960;
constexpr size_t WS_END = WS_BAR + 16384;
constexpr size_t OFF_YS = 16777216, OFF_GSP = 16908288, OFF_GSS = 17956864, OFF_GCP = 34734080, OFF_GCS = 34807808, OFF_KP = 35987456,
                 OFF_KS = 36249600, OFF_VP = 40443904, OFF_VS = 40706048, OFF_FP = 44900352, OFF_FS = 44945408;
constexpr int LDS_BYTES = 155648, LDS_XB = 155632;

struct Args { const float* in[28]; float* out; unsigned char* ws; };

typedef __bf16 bf16x2_t __attribute__((ext_vector_type(2)));
typedef float f32x2_t __attribute__((ext_vector_type(2)));
DI unsigned pack2(float a, float b) { f32x2_t v = {a, b}; bf16x2_t r = __builtin_convertvector(v, bf16x2_t); return __builtin_bit_cast(unsigned, r); }
DI u16 f2bf(float f) { return (u16)(pack2(f, 0.f) & 0xFFFFu); }
DI float bf2f(u16 b) { return __uint_as_float(((unsigned)b) << 16); }
DI float bflo(unsigned w) { return __uint_as_float(w << 16); }
DI float bfhi(unsigned w) { return __uint_as_float(w & 0xFFFF0000u); }
DI float sigm(float x) { return __builtin_amdgcn_rcpf(1.f + __expf(-x)); }
DI float silu(float x) { return x * __builtin_amdgcn_rcpf(1.f + __expf(-x)); }
#define DPP_F(v, ctrl) __builtin_bit_cast(float, __builtin_amdgcn_update_dpp(0, __builtin_bit_cast(int, (v)), (ctrl), 0xF, 0xF, false))
DI float row_sum16(float v) { v += DPP_F(v, 0x128); v += DPP_F(v, 0x124); v += DPP_F(v, 0x122); v += DPP_F(v, 0x121); return v; }
DI float row_max16(float v) { v = fmaxf(v, DPP_F(v, 0x128)); v = fmaxf(v, DPP_F(v, 0x124)); v = fmaxf(v, DPP_F(v, 0x122)); v = fmaxf(v, DPP_F(v, 0x121)); return v; }
DI float softplus(float x) { return x > 20.f ? x : log1pf(__expf(x)); }
DI f32x4 zero4() { return (f32x4){0.f, 0.f, 0.f, 0.f}; }
DI u32x4 pack8(f32x4 a, f32x4 b) { u32x4 w; w.x = pack2(a[0], a[1]); w.y = pack2(a[2], a[3]); w.z = pack2(b[0], b[1]); w.w = pack2(b[2], b[3]); return w; }
DI int row_bidx(int row) { return row < NP ? (row >> 11) : 8 + row - NP; }

struct EpiZ {
    static constexpr bool PERM = true, AFTER_DRAIN = false;
    u16* z; u16* gab; float* zb; u16* halo;
    DI void operator()(const f32x4 (&acc)[2][2][4][2], const pg8::Unit& u, int wr, int wc, int fr, int fq) const {
        const int row0 = u.pm * 256 + wr * 64 + fr;
        if (u.pn < 22) {
            const int col0 = u.pn * 256 + wc * 32 + 8 * fq;
            const bool gatecols = (u.pn >= 12) && (u.pn < 16);
#pragma unroll
            for (int ai = 0; ai < 2; ++ai)
#pragma unroll
                for (int m = 0; m < 4; ++m) {
                    const int row = row0 + ai * 128 + m * 16;
                    u16* rowp = z + (size_t)row * ZLD + col0;
                    const bool hal = (u.pn < 12) && (row < NP) && ((row & 63) >= 61);
#pragma unroll
                    for (int bj = 0; bj < 2; ++bj) {
                        f32x4 v0 = acc[ai][bj][m][0], v1 = acc[ai][bj][m][1];
                        if (gatecols) {
#pragma unroll
                            for (int j = 0; j < 4; ++j) { v0[j] = silu(v0[j]); v1[j] = silu(v1[j]); }
                        }
                        const u32x4 w = pack8(v0, v1);
                        __builtin_nontemporal_store(w, (u32x4*)(rowp + bj * 128));
                        if (hal) *(u32x4*)(halo + ((size_t)(row >> 6) * 3 + ((row & 63) - 61)) * 3072 + col0 + bj * 128) = w;
                    }
                }
        } else if (u.pn < 30) {
            const int col0 = (u.pn - 22) * 256 + wc * 32 + 8 * fq;
#pragma unroll
            for (int ai = 0; ai < 2; ++ai)
#pragma unroll
                for (int m = 0; m < 4; ++m) {
                    const int row = row0 + ai * 128 + m * 16;
                    if (row < NR) {
                        u16* rowp = gab + (size_t)row * 2048 + col0;
#pragma unroll
                        for (int bj = 0; bj < 2; ++bj) *(u32x4*)(rowp + bj * 128) = pack8(acc[ai][bj][m][0], acc[ai][bj][m][1]);
                    }
                }
        } else if (wc == 0 && fq < 2) {
#pragma unroll
            for (int ai = 0; ai < 2; ++ai)
#pragma unroll
                for (int m = 0; m < 4; ++m) {
                    const int row = row0 + ai * 128 + m * 16;
#pragma unroll
                    for (int n = 0; n < 2; ++n) *(f32x4*)(zb + (size_t)row * 16 + 8 * fq + 4 * n) = acc[ai][0][m][n];
                }
        }
    }
};
template <int WHICH> struct EpiMix {
    static constexpr bool PERM = true, AFTER_DRAIN = false;
    u16* mix; const u16* gab;
    DI void operator()(const f32x4 (&acc)[2][2][4][2], const pg8::Unit& u, int wr, int wc, int fr, int fq) const {
        const int row0 = u.pm * 256 + wr * 64 + fr, col0 = u.pn * 256 + wc * 32 + 8 * fq;
#pragma unroll
        for (int ai = 0; ai < 2; ++ai)
#pragma unroll
            for (int mp = 0; mp < 4; mp += 2) {
                u32x4 gv[2][2], pv[2][2];
#pragma unroll
                for (int mm = 0; mm < 2; ++mm) {
                    const int row = row0 + ai * 128 + (mp + mm) * 16;
#pragma unroll
                    for (int bj = 0; bj < 2; ++bj) {
                        gv[mm][bj] = (u32x4){0u, 0u, 0u, 0u}; pv[mm][bj] = gv[mm][bj];
                        if (row < NR) gv[mm][bj] = *(const u32x4*)(gab + (size_t)row * 2048 + WHICH * 1024 + col0 + bj * 128);
                        if (WHICH == 1) pv[mm][bj] = *(const u32x4*)(mix + (size_t)row * 1024 + col0 + bj * 128);
                    }
                }
#pragma unroll
                for (int mm = 0; mm < 2; ++mm) {
                    const int row = row0 + ai * 128 + (mp + mm) * 16;
#pragma unroll
                    for (int bj = 0; bj < 2; ++bj) {
                        const u32x4 g_ = gv[mm][bj], p_ = pv[mm][bj];
                        f32x4 a0 = acc[ai][bj][mp + mm][0], a1 = acc[ai][bj][mp + mm][1];
                        a0[0] *= sigm(bflo(g_.x)); a0[1] *= sigm(bfhi(g_.x)); a0[2] *= sigm(bflo(g_.y)); a0[3] *= sigm(bfhi(g_.y));
                        a1[0] *= sigm(bflo(g_.z)); a1[1] *= sigm(bfhi(g_.z)); a1[2] *= sigm(bflo(g_.w)); a1[3] *= sigm(bfhi(g_.w));
                        if (WHICH == 1) {
                            a0[0] += bflo(p_.x); a0[1] += bfhi(p_.x); a0[2] += bflo(p_.y); a0[3] += bfhi(p_.y);
                            a1[0] += bflo(p_.z); a1[1] += bfhi(p_.z); a1[2] += bflo(p_.w); a1[3] += bfhi(p_.w);
                        }
                        *(u32x4*)(mix + (size_t)row * 1024 + col0 + bj * 128) = pack8(a0, a1);
                    }
                }
            }
    }
};
template <int WHICH> struct EpiRes {
    static constexpr bool PERM = false, AFTER_DRAIN = false;
    float* out; const float* xp; const float* xs; const float* mod; u16* xh;
    DI void operator()(const f32x4 (&acc)[2][2][4][2], const pg8::Unit& u, int wr, int wc, int fr, int fq) const {
        const int row0 = u.pm * 256 + wr * 64 + fr, col0 = u.pn * 256 + wc * 32 + 4 * fq;
        constexpr int GOFF = WHICH ? 5120 : 2048;
        if (u.pm < 64) {
            f32x4 gtv[2][2];
            const float* gt = mod + (size_t)(u.pm >> 3) * 6144 + GOFF + col0;
#pragma unroll
            for (int bj = 0; bj < 2; ++bj)
#pragma unroll
                for (int n = 0; n < 2; ++n) gtv[bj][n] = *(const f32x4*)(gt + bj * 128 + n * 16);
#pragma unroll
            for (int ai = 0; ai < 2; ++ai)
#pragma unroll
                for (int mp = 0; mp < 4; mp += 2) {
                    f32x4 xv[2][2][2];
#pragma unroll
                    for (int mm = 0; mm < 2; ++mm) {
                        const size_t ro = (size_t)(row0 + ai * 128 + (mp + mm) * 16) * 1024 + col0;
                        const float* xr = xp + ro; const u16* xb = (const u16*)out + ro;
#pragma unroll
                        for (int bj = 0; bj < 2; ++bj)
#pragma unroll
                            for (int n = 0; n < 2; ++n) {
                                if (WHICH) { const u32x2 q_ = *(const u32x2*)(xb + bj * 128 + n * 16); xv[mm][bj][n] = (f32x4){bflo(q_.x), bfhi(q_.x), bflo(q_.y), bfhi(q_.y)}; }
                                else xv[mm][bj][n] = *(const f32x4*)(xr + bj * 128 + n * 16);
                            }
                    }
#pragma unroll
                    for (int mm = 0; mm < 2; ++mm) {
                        float* op = out + (size_t)(row0 + ai * 128 + (mp + mm) * 16) * 1024 + col0;
#pragma unroll
                        for (int bj = 0; bj < 2; ++bj)
#pragma unroll
                            for (int n = 0; n < 2; ++n) {
                                const f32x4 r_ = xv[mm][bj][n] + gtv[bj][n] * acc[ai][bj][mp + mm][n];
                                if (WHICH) *(u32x2*)(xh + (size_t)(row0 + ai * 128 + (mp + mm) * 16) * 1024 + col0 + bj * 128 + n * 16) = (u32x2){pack2(r_[0], r_[1]), pack2(r_[2], r_[3])};
                                else *(u32x2*)((u16*)out + (size_t)(row0 + ai * 128 + (mp + mm) * 16) * 1024 + col0 + bj * 128 + n * 16) = (u32x2){pack2(r_[0], r_[1]), pack2(r_[2], r_[3])};
                            }
                    }
                }
        } else {
#pragma unroll
            for (int ai = 0; ai < 2; ++ai)
#pragma unroll
                for (int m = 0; m < 4; ++m) {
                    const int row = row0 + ai * 128 + m * 16;
                    if (row < NR) {
                        float* op = out + (size_t)row * 1024 + col0;
                        const float* xr = WHICH ? op : (xs + (size_t)(row - NP) * 1024 + col0);
                        const float* gt = mod + (size_t)row_bidx(row) * 6144 + GOFF + col0;
                        f32x4 xv[2][2], gv[2][2];
#pragma unroll
                        for (int bj = 0; bj < 2; ++bj)
#pragma unroll
                            for (int n = 0; n < 2; ++n) { xv[bj][n] = *(const f32x4*)(xr + bj * 128 + n * 16); gv[bj][n] = *(const f32x4*)(gt + bj * 128 + n * 16); }
#pragma unroll
                        for (int bj = 0; bj < 2; ++bj)
#pragma unroll
                            for (int n = 0; n < 2; ++n) {
                                const f32x4 r_ = xv[bj][n] + gv[bj][n] * acc[ai][bj][m][n];
                                if (WHICH) *(u32x2*)(xh + (size_t)row * 1024 + col0 + bj * 128 + n * 16) = (u32x2){pack2(r_[0], r_[1]), pack2(r_[2], r_[3])};
                                else *(f32x4*)(op + bj * 128 + n * 16) = r_;
                            }
                    }
                }
        }
    }
};
struct EpiPlain {
    static constexpr bool PERM = true, AFTER_DRAIN = false;
    u16* o; int ld;
    DI void operator()(const f32x4 (&acc)[2][2][4][2], const pg8::Unit& u, int wr, int wc, int fr, int fq) const {
        const int row0 = u.pm * 256 + wr * 64 + fr, col0 = u.pn * 256 + wc * 32 + 8 * fq;
#pragma unroll
        for (int ai = 0; ai < 2; ++ai)
#pragma unroll
            for (int m = 0; m < 4; ++m) {
                u16* rowp = o + (size_t)(row0 + ai * 128 + m * 16) * ld + col0;
#pragma unroll
                for (int bj = 0; bj < 2; ++bj) *(u32x4*)(rowp + bj * 128) = pack8(acc[ai][bj][m][0], acc[ai][bj][m][1]);
            }
    }
};
struct EpiAct {
    static constexpr bool PERM = true, AFTER_DRAIN = false;
    u16* act; const u16* gate; const float* cw; const float* cb; const float* sf; float* out;
    DI void finish(const float (&f0)[8], const float (&f1)[8], const float (&f2)[8], const f32x4 (&w)[8], const f32x4 a0, const f32x4 a1, u16* dst) const {
        float r[8];
#pragma unroll
        for (int j = 0; j < 8; ++j) {
            const float gc = w[(j >> 2)][j & 3] * f2[j] + w[2 + (j >> 2)][j & 3] * f1[j] + w[4 + (j >> 2)][j & 3] * f0[j] + w[6 + (j >> 2)][j & 3];
            r[j] = silu(gc) * (j < 4 ? a0[j & 3] : a1[j & 3]);
        }
        *(u32x4*)dst = (u32x4){pack2(r[0], r[1]), pack2(r[2], r[3]), pack2(r[4], r[5]), pack2(r[6], r[7])};
    }
    DI void operator()(const f32x4 (&acc)[2][2][4][2], const pg8::Unit& u, int wr, int wc, int fr, int fq) const {
        const int row0 = u.pm * 256 + wr * 64 + fr, col0 = u.pn * 256 + wc * 32 + 8 * fq;
#pragma unroll
        for (int bj = 0; bj < 2; ++bj) {
            const int c = col0 + bj * 128;
            f32x4 w[8];
#pragma unroll
            for (int q = 0; q < 3; ++q) { w[2 * q] = *(const f32x4*)(cw + q * FF + c); w[2 * q + 1] = *(const f32x4*)(cw + q * FF + c + 4); }
            w[6] = *(const f32x4*)(cb + c); w[7] = *(const f32x4*)(cb + c + 4);
            if (u.pm < 64) {
#pragma unroll
                for (int ai = 0; ai < 2; ++ai)
#pragma unroll
                    for (int mp = 0; mp < 4; mp += 2) {
                        u32x4 g0[2], g1[2], g2[2];
#pragma unroll
                        for (int mm = 0; mm < 2; ++mm) {
                            const int row = row0 + ai * 128 + (mp + mm) * 16, t = row & 2047;
                            const u16* gp = gate + (size_t)row * FF + c;
                            g0[mm] = *(const u32x4*)gp;
                            g1[mm] = (t >= 1) ? *(const u32x4*)(gp - FF) : (u32x4){0u, 0u, 0u, 0u};
                            g2[mm] = (t >= 2) ? *(const u32x4*)(gp - 2 * FF) : (u32x4){0u, 0u, 0u, 0u};
                        }
#pragma unroll
                        for (int mm = 0; mm < 2; ++mm) {
                            const int row = row0 + ai * 128 + (mp + mm) * 16, t = row & 2047;
                            float f0[8], f1[8], f2[8];
                            f0[0] = bflo(g0[mm].x); f0[1] = bfhi(g0[mm].x); f0[2] = bflo(g0[mm].y); f0[3] = bfhi(g0[mm].y); f0[4] = bflo(g0[mm].z); f0[5] = bfhi(g0[mm].z); f0[6] = bflo(g0[mm].w); f0[7] = bfhi(g0[mm].w);
                            f1[0] = bflo(g1[mm].x); f1[1] = bfhi(g1[mm].x); f1[2] = bflo(g1[mm].y); f1[3] = bfhi(g1[mm].y); f1[4] = bflo(g1[mm].z); f1[5] = bfhi(g1[mm].z); f1[6] = bflo(g1[mm].w); f1[7] = bfhi(g1[mm].w);
                            f2[0] = bflo(g2[mm].x); f2[1] = bfhi(g2[mm].x); f2[2] = bflo(g2[mm].y); f2[3] = bfhi(g2[mm].y); f2[4] = bflo(g2[mm].z); f2[5] = bfhi(g2[mm].z); f2[6] = bflo(g2[mm].w); f2[7] = bfhi(g2[mm].w);
                            if (t >= 2046) { float* fp = out + OFF_FP + ((size_t)(row >> 11) * 2 + (t - 2046)) * FF + c;
                                *(f32x4*)fp = (f32x4){f0[0], f0[1], f0[2], f0[3]}; *(f32x4*)(fp + 4) = (f32x4){f0[4], f0[5], f0[6], f0[7]}; }
                            finish(f0, f1, f2, w, acc[ai][bj][mp + mm][0], acc[ai][bj][mp + mm][1], act + (size_t)row * FF + c);
                        }
                    }
            } else {
#pragma unroll
                for (int ai = 0; ai < 2; ++ai)
#pragma unroll
                    for (int m = 0; m < 4; ++m) {
                        const int row = row0 + ai * 128 + m * 16;
                        if (row >= NR) continue;
                        float f0[8], f1[8], f2[8];
                        const u32x4 g0 = *(const u32x4*)(gate + (size_t)row * FF + c);
                        f0[0] = bflo(g0.x); f0[1] = bfhi(g0.x); f0[2] = bflo(g0.y); f0[3] = bfhi(g0.y); f0[4] = bflo(g0.z); f0[5] = bfhi(g0.z); f0[6] = bflo(g0.w); f0[7] = bfhi(g0.w);
                        const float* sp = sf + (size_t)(row - NP) * 2 * FF + c;
                        const f32x4 p0 = *(const f32x4*)sp, p1 = *(const f32x4*)(sp + 4), q0 = *(const f32x4*)(sp + FF), q1 = *(const f32x4*)(sp + FF + 4);
#pragma unroll
                        for (int j = 0; j < 4; ++j) { f2[j] = p0[j]; f2[4 + j] = p1[j]; f1[j] = q0[j]; f1[4 + j] = q1[j]; }
                        float* fp = out + OFF_FS + (size_t)(row - NP) * 2 * FF + c;
                        *(f32x4*)fp = q0; *(f32x4*)(fp + 4) = q1;
                        *(f32x4*)(fp + FF) = (f32x4){f0[0], f0[1], f0[2], f0[3]}; *(f32x4*)(fp + FF + 4) = (f32x4){f0[4], f0[5], f0[6], f0[7]};
                        finish(f0, f1, f2, w, acc[ai][bj][m][0], acc[ai][bj][m][1], act + (size_t)row * FF + c);
                    }
            }
        }
    }
};
struct MixOrder {
    pg8::StaticOrder base;
    DI bool next(int i, pg8::Unit& u) const { if (!base.next(i >> 1, u)) return false; u.sel = i & 1; return true; }
    DI void a_ready(const pg8::Unit&) const {}
    DI void done(const pg8::Unit&) const {}
};
struct EpiMixBoth {
    static constexpr bool PERM = true, AFTER_DRAIN = false;
    EpiMix<0> e0; EpiMix<1> e1;
    DI void operator()(const f32x4 (&acc)[2][2][4][2], const pg8::Unit& u, int wr, int wc, int fr, int fq) const { if (u.sel) e1(acc, u, wr, wc, fr, fq); else e0(acc, u, wr, wc, fr, fq); }
};
template <class Epi> DI void run_gemm(LAS unsigned char* lds, const u16* A, int lda, const u16* Bt, int ldb, int M, int N, int K, const Epi& E) {
    pg8::Gemm g; g.A = A; g.Bt = Bt; g.M = M; g.N = N; g.K = K; g.lda = lda; g.ldb = ldb;
    pg8::StaticOrder S; S.init(M, N, (int)gridDim.x, (int)blockIdx.x);
    pg8::gemm_phase<Epi, pg8::StaticOrder, false>((PG8_LAS unsigned char*)lds, g, S, E, nullptr);
}

DI f32x4 skinny_part(const u16* A, int lda, const u16* Bt, int ldb, int K, int mt, int nt) {
    const int lane = otid() & 63, wid = otid() >> 6, r16 = lane & 15, g = lane >> 4;
    const int ks = K >> 3;
    const u16* ap = A + (size_t)(16 * mt + r16) * lda + wid * ks + g * 8;
    const u16* bp = Bt + (size_t)(16 * nt + r16) * ldb + wid * ks + g * 8;
    f32x4 c = zero4();
#pragma unroll 11
    for (int k = 0; k < ks; k += 32) c = MFMA16(*(const bf16x8*)(ap + k), *(const bf16x8*)(bp + k), c);
    return c;
}
template <int WHICH> DI void skinny_phase(const Args& a, LAS unsigned char* lds) {
    const int tid = otid(), lane = tid & 63, wid = tid >> 6;
    LAS float* red = (LAS float*)lds;
    const u16* Z = (const u16*)(a.ws + WS_Z);
    for (int t = blockIdx.x; t < 512; t += gridDim.x) {
        const int mt = t & 7, nt = t >> 3;
        f32x4 c0, c1 = zero4();
        if (WHICH == 0) { c0 = skinny_part(Z + (size_t)NP * ZLD + ZG, ZLD, (const u16*)(a.ws + WS_WA), 1024, 1024, mt, nt); c1 = skinny_part(Z + (size_t)NP * ZLD + ZSQ, ZLD, (const u16*)(a.ws + WS_WB), 1024, 1024, mt, nt); }
        else if (WHICH == 1) c0 = skinny_part((const u16*)(a.ws + WS_H) + (size_t)NP * 1024, 1024, (const u16*)(a.ws + WS_WO), 1024, 1024, mt, nt);
        else c0 = skinny_part(Z + (size_t)MP * FF + (size_t)NP * FF, FF, (const u16*)(a.ws + WS_WD), FF, FF, mt, nt);
        *(LAS f32x4*)(red + (wid * 64 + lane) * 4) = c0;
        if (WHICH == 0) *(LAS f32x4*)(red + 2048 + (wid * 64 + lane) * 4) = c1;
        __syncthreads();
        if (tid < 256) {
            const int l = tid >> 2, i = tid & 3, row = 16 * mt + 4 * (l >> 4) + i, col = 16 * nt + (l & 15);
            float s0 = 0.f, s1 = 0.f;
#pragma unroll
            for (int w = 0; w < 8; ++w) { s0 += red[w * 256 + tid]; if (WHICH == 0) s1 += red[2048 + w * 256 + tid]; }
            if (WHICH == 0) {
                const u16* gab = (const u16*)a.out + (size_t)(NP + row) * 2048;
                ((u16*)(a.ws + WS_H))[(size_t)(NP + row) * 1024 + col] = f2bf(sigm(bf2f(gab[col])) * s0 + sigm(bf2f(gab[1024 + col])) * s1);
            } else {
                float* op = a.out + (size_t)(NP + row) * 1024 + col;
                u16* x1p = (u16*)a.out + (size_t)(NP + row) * 1024 + col;
                const float base = (WHICH == 2) ? bf2f(*x1p) : a.in[1][(size_t)row * 1024 + col];
                const float r_ = base + ((const float*)(a.ws + WS_MOD))[(size_t)(8 + row) * 6144 + (WHICH == 2 ? 5120 : 2048) + col] * s0;
                if (WHICH == 2) ((u16*)(a.ws + WS_H))[(size_t)(NP + row) * 1024 + col] = f2bf(r_); else *x1p = f2bf(r_);
            }
        }
        __syncthreads();
    }
}

DI void convert_weights(const Args& a, LAS unsigned char* lds, int tlo, int thi, int v, int nv);
DI void phase0(const Args& a, LAS unsigned char* lds) {
    const int tid = otid(), lane = tid & 63, wid = tid >> 6, r16 = lane & 15, g = lane >> 4;
    float* mod = (float*)(a.ws + WS_MOD);
    const float* wmod = a.in[9]; const float* bmod = a.in[10];
    LAS float* red = (LAS float*)lds;
    for (int task = blockIdx.x; task < 192; task += gridDim.x) {
        const int n0 = task * 32;
        f32x4 acc[2][9];
#pragma unroll
        for (int t = 0; t < 2; ++t)
#pragma unroll
            for (int mt = 0; mt < 9; ++mt) acc[t][mt] = zero4();
#pragma unroll 1
        for (int ks = 0; ks < 4; ++ks) {
            const int k0 = wid * 128 + ks * 32 + g * 8;
            bf16x8 bfr0, bfr1;
#pragma unroll
            for (int j = 0; j < 8; ++j) { const float* wp = wmod + (size_t)(k0 + j) * 6144 + n0 + r16; bfr0[j] = (short)f2bf(wp[0]); bfr1[j] = (short)f2bf(wp[16]); }
#pragma unroll
            for (int mt = 0; mt < 9; ++mt) {
                const int r = mt * 16 + r16;
                bf16x8 af = (bf16x8){0, 0, 0, 0, 0, 0, 0, 0};
                if (r < 136) {
                    const float* cp = (r < 8 ? a.in[2] + r * 1024 : a.in[3] + (r - 8) * 1024) + k0;
                    const f32x4 v0 = *(const f32x4*)cp, v1 = *(const f32x4*)(cp + 4);
#pragma unroll
                    for (int j = 0; j < 4; ++j) { af[j] = (short)f2bf(silu(v0[j])); af[4 + j] = (short)f2bf(silu(v1[j])); }
                }
                acc[0][mt] = MFMA16(af, bfr0, acc[0][mt]);
                acc[1][mt] = MFMA16(af, bfr1, acc[1][mt]);
            }
        }
#pragma unroll
        for (int t = 0; t < 2; ++t) {
#pragma unroll
            for (int mt = 0; mt < 9; ++mt) *(LAS f32x4*)(red + ((wid * 9 + mt) * 64 + lane) * 4) = acc[t][mt];
            __syncthreads();
            for (int idx = tid; idx < 2304; idx += 512) {
                const int mt = idx >> 8, rem = idx & 255, l = rem >> 2, i = rem & 3;
                float s = 0.f;
#pragma unroll
                for (int w = 0; w < 8; ++w) s += red[((w * 9 + mt) * 64 + l) * 4 + i];
                const int row = mt * 16 + 4 * (l >> 4) + i, col = n0 + 16 * t + (l & 15);
                if (row < 136) mod[(size_t)row * 6144 + col] = s + bmod[col];
            }
            __syncthreads();
        }
    }
    convert_weights(a, lds, 0, 4864, blockIdx.x, gridDim.x);
}
DI void convert_weights(const Args& a, LAS unsigned char* lds, int tlo, int thi, int v, int nv) {
    const int tid = otid();
    LAS u16* T = (LAS u16*)lds;
    for (int t0 = tlo + v * 4; t0 < thi; t0 += nv * 4) {
        f32x4 v0[4], v1[4]; u16* dstp[4];
#pragma unroll
        for (int q = 0; q < 4; ++q) {
            const int t = t0 + q;
            const float* src; u16* dst; int ldsrc, K, tl = t, mode = 0;
            if (tl < 1984) { src = a.in[13]; ldsrc = 7696; K = 1024; dst = (u16*)(a.ws + WS_RA); mode = 1; }
            else if ((tl -= 1984) < 256) { src = a.in[18]; ldsrc = 1024; K = 1024; dst = (u16*)(a.ws + WS_WA); }
            else if ((tl -= 256) < 256) { src = a.in[20]; ldsrc = 1024; K = 1024; dst = (u16*)(a.ws + WS_WB); }
            else if ((tl -= 256) < 256) { src = a.in[21]; ldsrc = 1024; K = 1024; dst = (u16*)(a.ws + WS_WO); }
            else if ((tl -= 256) < 704) { src = a.in[22]; ldsrc = 2816; K = 1024; dst = (u16*)(a.ws + WS_WG); }
            else if ((tl -= 704) < 704) { src = a.in[23]; ldsrc = 2816; K = 1024; dst = (u16*)(a.ws + WS_WU); }
            else { tl -= 704; src = a.in[26]; ldsrc = 1024; K = 2816; dst = (u16*)(a.ws + WS_WD); }
            const int ktiles = K >> 6, nt = tl / ktiles, kt = tl - nt * ktiles, n0 = nt * 64, k0 = kt * 64;
            const int k = tid & 63, n8 = (tid >> 6) * 8, n = n0 + n8;
            int sc = n; bool valid = true;
            if (mode == 1) { if (n < 4096) sc = n; else if (n < 7680) sc = n + 16; else if (n < 7696) sc = 4096 + (n - 7680); else valid = false; }
            v0[q] = zero4(); v1[q] = zero4();
            if (valid) { const float* p = src + (size_t)(k0 + k) * ldsrc + sc; v0[q] = *(const f32x4*)p; v1[q] = *(const f32x4*)(p + 4); }
            dstp[q] = dst + (size_t)(n0 + (tid >> 3)) * K + k0 + (tid & 7) * 8;
        }
#pragma unroll
        for (int q = 0; q < 4; ++q) {
            const int k = tid & 63, n8 = (tid >> 6) * 8;
            LAS u16* Tq = T + q * (64 * 72);
#pragma unroll
            for (int j = 0; j < 4; ++j) { Tq[(n8 + j) * 72 + k] = f2bf(v0[q][j]); Tq[(n8 + 4 + j) * 72 + k] = f2bf(v1[q][j]); }
        }
        __syncthreads();
#pragma unroll
        for (int q = 0; q < 4; ++q) *(u32x4*)dstp[q] = *(LAS u32x4*)(T + q * (64 * 72) + (tid >> 3) * 72 + (tid & 7) * 8);
        __syncthreads();
    }
}

template <int WHICH> DI void phase_norm(const Args& a) {
    const int tid = otid(), lane = tid & 63, gw = blockIdx.x * 8 + (tid >> 6), nw = gridDim.x * 8;
    u16* hb = (u16*)(a.ws + WS_H);
    const float* mod = (const float*)(a.ws + WS_MOD);
    const float* nwt = a.in[WHICH ? 12 : 11];
    f32x4 w[4];
#pragma unroll
    for (int i = 0; i < 4; ++i) w[i] = *(const f32x4*)(nwt + lane * 4 + 256 * i);
    for (int row0 = gw; row0 < MP; row0 += 2 * nw) {
        f32x4 v[2][4];
#pragma unroll
        for (int rr = 0; rr < 2; ++rr) {
            const int row = row0 + rr * nw;
            if (row < NR) {
                const float* xr = (row < NP ? a.in[0] + (size_t)row * 1024 : a.in[1] + (size_t)(row - NP) * 1024);
#pragma unroll
                for (int i = 0; i < 4; ++i) {
                    if (WHICH) { const u32x2 q_ = *(const u32x2*)((const u16*)a.out + (size_t)row * 1024 + lane * 4 + 256 * i); v[rr][i] = (f32x4){bflo(q_.x), bfhi(q_.x), bflo(q_.y), bfhi(q_.y)}; }
                    else v[rr][i] = *(const f32x4*)(xr + lane * 4 + 256 * i);
                }
            } else {
#pragma unroll
                for (int i = 0; i < 4; ++i) v[rr][i] = zero4();
            }
        }
#pragma unroll
        for (int rr = 0; rr < 2; ++rr) {
            const int row = row0 + rr * nw;
            if (row >= MP) continue;
            u16* hp = hb + (size_t)row * 1024;
            if (row >= NR) {
#pragma unroll
                for (int i = 0; i < 4; ++i) *(u32x2*)(hp + lane * 4 + 256 * i) = (u32x2){0u, 0u};
                continue;
            }
            const float* mr = mod + (size_t)row_bidx(row) * 6144 + (WHICH ? 3072 : 0);
            float ss = 0.f;
#pragma unroll
            for (int i = 0; i < 4; ++i) ss += v[rr][i][0] * v[rr][i][0] + v[rr][i][1] * v[rr][i][1] + v[rr][i][2] * v[rr][i][2] + v[rr][i][3] * v[rr][i][3];
            ss = row_sum16(ss); ss += __shfl_xor(ss, 16); ss += __shfl_xor(ss, 32);
            const float rstd = rsqrtf(ss * (1.f / 1024.f) + EPS);
#pragma unroll
            for (int i = 0; i < 4; ++i) {
                const int c = lane * 4 + 256 * i;
                const f32x4 sh = *(const f32x4*)(mr + c), sc = *(const f32x4*)(mr + 1024 + c);
                f32x4 y;
#pragma unroll
                for (int j = 0; j < 4; ++j) y[j] = v[rr][i][j] * rstd * w[i][j] * (1.f + sc[j]) + sh[j];
                *(u32x2*)(hp + c) = (u32x2){pack2(y[0], y[1]), pack2(y[2], y[3])};
            }
        }
    }
}
DI void phase_final(const Args& a) {
    const int tid = otid(), lane = tid & 63, gw = blockIdx.x * 8 + (tid >> 6), nw = gridDim.x * 8;
    const float* fw = a.in[27];
    f32x4 w[4];
#pragma unroll
    for (int i = 0; i < 4; ++i) w[i] = *(const f32x4*)(fw + lane * 4 + 256 * i);
    for (int row0 = gw; row0 < NR; row0 += 2 * nw) {
        f32x4 v[2][4];
#pragma unroll
        for (int rr = 0; rr < 2; ++rr) {
            const int row = row0 + rr * nw;
#pragma unroll
            for (int i = 0; i < 4; ++i) {
                v[rr][i] = zero4();
                if (row < NR) { const u32x2 q_ = *(const u32x2*)((const u16*)(a.ws + WS_H) + (size_t)row * 1024 + lane * 4 + 256 * i); v[rr][i] = (f32x4){bflo(q_.x), bfhi(q_.x), bflo(q_.y), bfhi(q_.y)}; }
            }
        }
#pragma unroll
        for (int rr = 0; rr < 2; ++rr) {
            const int row = row0 + rr * nw;
            if (row >= NR) continue;
            float ss = 0.f;
#pragma unroll
            for (int i = 0; i < 4; ++i) ss += v[rr][i][0] * v[rr][i][0] + v[rr][i][1] * v[rr][i][1] + v[rr][i][2] * v[rr][i][2] + v[rr][i][3] * v[rr][i][3];
            ss = row_sum16(ss); ss += __shfl_xor(ss, 16); ss += __shfl_xor(ss, 32);
            const float rstd = rsqrtf(ss * (1.f / 1024.f) + EPS);
#pragma unroll
            for (int i = 0; i < 4; ++i) *(f32x4*)(a.out + (size_t)row * 1024 + lane * 4 + 256 * i) = v[rr][i] * rstd * w[i];
        }
    }
}

DI void unpack8(const u32x4 q, float (&f)[8]) { f[0] = bflo(q.x); f[1] = bfhi(q.x); f[2] = bflo(q.y); f[3] = bfhi(q.y); f[4] = bflo(q.z); f[5] = bfhi(q.z); f[6] = bflo(q.w); f[7] = bfhi(q.w); }
DI void phase_act(const Args& a) {
    const u16* gate = (const u16*)(a.ws + WS_Z);
    u16* up = (u16*)(a.ws + WS_Z) + (size_t)MP * FF;
    const float* cw = a.in[24]; const float* cb = a.in[25]; const float* sf = a.in[8];
    const int nthr = gridDim.x * 512, t0 = blockIdx.x * 512 + otid();
    for (int idx0 = t0; idx0 < NP * 352; idx0 += 2 * nthr) {
        u32x4 gv[2], g1[2], g2[2], uv[2]; int row[2], c[2]; bool ok[2];
#pragma unroll
        for (int q = 0; q < 2; ++q) {
            const int idx = idx0 + q * nthr;
            ok[q] = idx < NP * 352;
            row[q] = ok[q] ? idx / 352 : 0; c[q] = ok[q] ? (idx - row[q] * 352) * 8 : 0;
            const int t = row[q] & 2047;
            const u16* gp = gate + (size_t)row[q] * FF + c[q];
            gv[q] = *(const u32x4*)gp;
            g1[q] = (t >= 1) ? *(const u32x4*)(gp - FF) : (u32x4){0u, 0u, 0u, 0u};
            g2[q] = (t >= 2) ? *(const u32x4*)(gp - 2 * FF) : (u32x4){0u, 0u, 0u, 0u};
            uv[q] = *(const u32x4*)(up + (size_t)row[q] * FF + c[q]);
        }
#pragma unroll
        for (int q = 0; q < 2; ++q) {
            if (!ok[q]) continue;
            float f0[8], f1[8], f2[8], fu[8], r[8];
            unpack8(gv[q], f0); unpack8(g1[q], f1); unpack8(g2[q], f2); unpack8(uv[q], fu);
            const int t = row[q] & 2047;
            if (t >= 2046) { float* fp = a.out + OFF_FP + ((size_t)(row[q] >> 11) * 2 + (t - 2046)) * FF + c[q];
                *(f32x4*)fp = (f32x4){f0[0], f0[1], f0[2], f0[3]}; *(f32x4*)(fp + 4) = (f32x4){f0[4], f0[5], f0[6], f0[7]}; }
            const float* w0 = cw + c[q];
#pragma unroll
            for (int j = 0; j < 8; ++j) r[j] = silu(w0[j] * f2[j] + w0[FF + j] * f1[j] + w0[2 * FF + j] * f0[j] + cb[c[q] + j]) * fu[j];
            *(u32x4*)(up + (size_t)row[q] * FF + c[q]) = (u32x4){pack2(r[0], r[1]), pack2(r[2], r[3]), pack2(r[4], r[5]), pack2(r[6], r[7])};
        }
    }
    for (int idx = t0; idx < NS * 352; idx += nthr) {
        const int b = idx / 352, c = (idx - b * 352) * 8, row = NP + b;
        float f0[8], fu[8], r[8];
        unpack8(*(const u32x4*)(gate + (size_t)row * FF + c), f0);
        u16* upp = up + (size_t)row * FF + c;
        unpack8(*(const u32x4*)upp, fu);
        const float* s0 = sf + ((size_t)b * 2) * FF + c;
        const f32x4 p0 = *(const f32x4*)s0, p1 = *(const f32x4*)(s0 + 4), q0 = *(const f32x4*)(s0 + FF), q1 = *(const f32x4*)(s0 + FF + 4);
        float* fp = a.out + OFF_FS + ((size_t)b * 2) * FF + c;
        *(f32x4*)fp = q0; *(f32x4*)(fp + 4) = q1;
        *(f32x4*)(fp + FF) = (f32x4){f0[0], f0[1], f0[2], f0[3]}; *(f32x4*)(fp + FF + 4) = (f32x4){f0[4], f0[5], f0[6], f0[7]};
        const float* w0 = cw + c;
#pragma unroll
        for (int j = 0; j < 8; ++j) r[j] = silu(w0[j] * (j < 4 ? p0[j & 3] : p1[j & 3]) + w0[FF + j] * (j < 4 ? q0[j & 3] : q1[j & 3]) + w0[2 * FF + j] * f0[j] + cb[c + j]) * fu[j];
        *(u32x4*)upp = (u32x4){pack2(r[0], r[1]), pack2(r[2], r[3]), pack2(r[4], r[5]), pack2(r[6], r[7])};
    }
}

DI void phase_prep(const Args& a, LAS unsigned char* lds) {
    const int tid = otid(), lane = tid & 63, wid = tid >> 6, r16 = lane & 15, g = lane >> 4;
    u16* z = (u16*)(a.ws + WS_Z);
    const float* zb = (const float*)(a.ws + WS_ZB);
    const u16* halo = (const u16*)(a.ws + WS_HALO);
    u16* wbuf = (u16*)(a.ws + WS_H);
    u16* abuf = (u16*)(a.ws + WS_RA);
    float* Mbuf = a.out + OFF_KS;
    float* lastbuf = (float*)(a.ws + WS_LAST);
    const float* cw = a.in[14];
    LAS float* dec = (LAS float*)lds;
    LAS float* bet = dec + 512;
    LAS u16* qn = (LAS u16*)(lds + 4096);
    LAS u16* kn = qn + 64 * 136;
    const int item = blockIdx.x;
    if (item < 256) {
        const int b = item >> 5, ck = item & 31, R0 = b * 2048 + ck * 64;
        {
            const int h = wid;
            const float* zr = zb + (size_t)(R0 + lane) * 16;
            const float be = sigm(zr[h]);
            float s = -__expf(a.in[15][h]) * softplus(zr[8 + h] + a.in[16][h]);
#pragma unroll
            for (int off = 1; off < 64; off <<= 1) { const float t = __shfl_up(s, off); if (lane >= off) s += t; }
            dec[h * 64 + lane] = s; bet[h * 64 + lane] = be;
            if (lane == 63) lastbuf[item * 8 + h] = __expf(s);
        }
        __syncthreads();
#pragma unroll 1
        for (int h = 0; h < 8; ++h) {
            int tok = tid >> 3, cgp = tid & 7; asm volatile("" : "+v"(tok), "+v"(cgp));
            const float dtok = dec[h * 64 + tok], ed = __expf(dtok), edl = __expf(dec[h * 64 + 63] - dtok), be = bet[h * 64 + tok];
            u32x4 oq0, oq1, ok0, ok1, okb0, okb1, ov0, ov1;
            u32x4 tp[2][4][2];
#define PREP_TAPS(set_, part_) _Pragma("unroll") for (int j_ = 0; j_ < 4; ++j_) { const int col_ = (part_) * 1024 + h * 128 + cgp * 16, srow_ = tok - 3 + j_, pos_ = ck * 64 + srow_; \
                tp[set_][j_][0] = (u32x4){0u, 0u, 0u, 0u}; tp[set_][j_][1] = tp[set_][j_][0]; \
                if (pos_ >= 0) { const u16* p_ = (srow_ < 0) ? halo + ((size_t)((b * 32 + ck - 1) * 3 + 3 + srow_)) * 3072 + col_ : z + (size_t)(R0 + srow_) * ZLD + col_; \
                    tp[set_][j_][0] = *(const u32x4*)p_; tp[set_][j_][1] = *(const u32x4*)(p_ + 8); } }
            PREP_TAPS(0, 0);
#pragma unroll
            for (int part = 0; part < 3; ++part) {
                const int col = part * 1024 + h * 128 + cgp * 16;
                if (part < 2) { PREP_TAPS((part + 1) & 1, part + 1); }
                float v[16];
#pragma unroll
                for (int c = 0; c < 16; ++c) v[c] = 0.f;
#pragma unroll
                for (int j = 0; j < 4; ++j) {
                    const u32x4 x0 = tp[part & 1][j][0], x1 = tp[part & 1][j][1];
                    const float* wp = cw + j * 3072 + col;
                    const f32x4 w0 = *(const f32x4*)wp, w1 = *(const f32x4*)(wp + 4), w2 = *(const f32x4*)(wp + 8), w3 = *(const f32x4*)(wp + 12);
                    v[0] += w0[0] * bflo(x0.x); v[1] += w0[1] * bfhi(x0.x); v[2] += w0[2] * bflo(x0.y); v[3] += w0[3] * bfhi(x0.y);
                    v[4] += w1[0] * bflo(x0.z); v[5] += w1[1] * bfhi(x0.z); v[6] += w1[2] * bflo(x0.w); v[7] += w1[3] * bfhi(x0.w);
                    v[8] += w2[0] * bflo(x1.x); v[9] += w2[1] * bfhi(x1.x); v[10] += w2[2] * bflo(x1.y); v[11] += w2[3] * bfhi(x1.y);
                    v[12] += w3[0] * bflo(x1.z); v[13] += w3[1] * bfhi(x1.z); v[14] += w3[2] * bflo(x1.w); v[15] += w3[3] * bfhi(x1.w);
                }
                float ss = 0.f;
#pragma unroll
                for (int c = 0; c < 16; ++c) { v[c] = silu(v[c]); ss += v[c] * v[c]; }
                if (part < 2) {
                    ss += __shfl_xor(ss, 1); ss += __shfl_xor(ss, 2); ss += __shfl_xor(ss, 4);
                    const float sc = rsqrtf(ss + EPS) * (part == 0 ? 0.08838834764831845f : 1.f);
#pragma unroll
                    for (int c = 0; c < 16; ++c) v[c] *= sc;
                    LAS u16* dstl = (part == 0 ? qn : kn) + tok * 136 + cgp * 16;
                    *(LAS u32x4*)dstl = (u32x4){pack2(v[0], v[1]), pack2(v[2], v[3]), pack2(v[4], v[5]), pack2(v[6], v[7])};
                    *(LAS u32x4*)(dstl + 8) = (u32x4){pack2(v[8], v[9]), pack2(v[10], v[11]), pack2(v[12], v[13]), pack2(v[14], v[15])};
                }
                if (part == 0) {
                    oq0 = (u32x4){pack2(v[0] * ed, v[1] * ed), pack2(v[2] * ed, v[3] * ed), pack2(v[4] * ed, v[5] * ed), pack2(v[6] * ed, v[7] * ed)};
                    oq1 = (u32x4){pack2(v[8] * ed, v[9] * ed), pack2(v[10] * ed, v[11] * ed), pack2(v[12] * ed, v[13] * ed), pack2(v[14] * ed, v[15] * ed)};
                } else if (part == 1) {
                    ok0 = (u32x4){pack2(v[0] * edl, v[1] * edl), pack2(v[2] * edl, v[3] * edl), pack2(v[4] * edl, v[5] * edl), pack2(v[6] * edl, v[7] * edl)};
                    ok1 = (u32x4){pack2(v[8] * edl, v[9] * edl), pack2(v[10] * edl, v[11] * edl), pack2(v[12] * edl, v[13] * edl), pack2(v[14] * edl, v[15] * edl)};
                    const float kb = be * ed;
                    okb0 = (u32x4){pack2(v[0] * kb, v[1] * kb), pack2(v[2] * kb, v[3] * kb), pack2(v[4] * kb, v[5] * kb), pack2(v[6] * kb, v[7] * kb)};
                    okb1 = (u32x4){pack2(v[8] * kb, v[9] * kb), pack2(v[10] * kb, v[11] * kb), pack2(v[12] * kb, v[13] * kb), pack2(v[14] * kb, v[15] * kb)};
                } else {
                    ov0 = (u32x4){pack2(v[0] * be, v[1] * be), pack2(v[2] * be, v[3] * be), pack2(v[4] * be, v[5] * be), pack2(v[6] * be, v[7] * be)};
                    ov1 = (u32x4){pack2(v[8] * be, v[9] * be), pack2(v[10] * be, v[11] * be), pack2(v[12] * be, v[13] * be), pack2(v[14] * be, v[15] * be)};
                }
            }
            __syncthreads();
            {
                u16* zr = z + (size_t)(R0 + tok) * ZLD + h * 128 + cgp * 16;
                *(u32x4*)(zr + ZQ) = oq0; *(u32x4*)(zr + ZQ + 8) = oq1;
                *(u32x4*)(zr + ZK) = ok0; *(u32x4*)(zr + ZK + 8) = ok1;
                *(u32x4*)(zr + ZV) = ov0; *(u32x4*)(zr + ZV + 8) = ov1;
                u16* wr_ = wbuf + ((size_t)(item * 8 + h) * 64 + tok) * 128 + cgp * 16;
                *(u32x4*)wr_ = okb0; *(u32x4*)(wr_ + 8) = okb1;
            }
            {
                const int which = wid >> 2, mi = wid & 3;
                LAS u16* As = which ? qn : kn;
                f32x4 acc[4];
#pragma unroll
                for (int ni = 0; ni < 4; ++ni) acc[ni] = zero4();
#pragma unroll
                for (int ks = 0; ks < 4; ++ks) {
                    const bf16x8 af = *(LAS bf16x8*)(As + (16 * mi + r16) * 136 + ks * 32 + g * 8);
#pragma unroll
                    for (int ni = 0; ni < 4; ++ni) acc[ni] = MFMA16(af, *(LAS bf16x8*)(kn + (16 * ni + r16) * 136 + ks * 32 + g * 8), acc[ni]);
                }
#pragma unroll
                for (int ni = 0; ni < 4; ++ni)
#pragma unroll
                    for (int i = 0; i < 4; ++i) {
                        const int ti = 16 * mi + 4 * g + i, tj = 16 * ni + r16;
                        const float e = (ti >= tj) ? __expf(dec[h * 64 + ti] - dec[h * 64 + tj]) : 0.f;
                        if (which == 0) Mbuf[((size_t)(item * 8 + h) * 64 + ti) * 64 + tj] = (ti > tj) ? bet[h * 64 + ti] * acc[ni][i] * e : 0.f;
                        else abuf[((size_t)(item * 8 + h) * 64 + ti) * 64 + tj] = f2bf(acc[ni][i] * e);
                    }
            }
            asm volatile("s_waitcnt lgkmcnt(0)\n\ts_barrier" ::: "memory");
        }
        __syncthreads();
        {
            const int h = wid;
            LAS float* Ml = (LAS float*)(lds + 4096 + wid * 17408);
            const float* Mg = Mbuf + (size_t)(item * 8 + h) * 4096;
#pragma unroll
            for (int it = 0; it < 16; ++it) { const int idx = it * 64 + lane; *(LAS f32x4*)(Ml + (idx >> 4) * 68 + (idx & 15) * 4) = *(const f32x4*)(Mg + idx * 4); }
            {
                float t[64];
                t[0] = (lane == 0) ? 1.f : 0.f;
#pragma unroll
                for (int i = 1; i < 64; ++i) {
                    float s = (lane == i) ? 1.f : 0.f;
#pragma unroll
                    for (int j4 = 0; j4 < i; j4 += 4) {
                        const f32x4 m = *(LAS f32x4*)(Ml + i * 68 + j4);
                        s -= m[0] * t[j4];
                        if (j4 + 1 < i) s -= m[1] * t[j4 + 1];
                        if (j4 + 2 < i) s -= m[2] * t[j4 + 2];
                        if (j4 + 3 < i) s -= m[3] * t[j4 + 3];
                    }
                    t[i] = s;
                }
#pragma unroll
                for (int i = 0; i < 64; ++i) Ml[i * 68 + lane] = t[i];
            }
            bf16x8 at[4][2];
#pragma unroll
            for (int mt = 0; mt < 4; ++mt)
#pragma unroll
                for (int ks = 0; ks < 2; ++ks) {
                    const f32x4 t0 = *(LAS f32x4*)(Ml + (16 * mt + r16) * 68 + ks * 32 + g * 8), t1 = *(LAS f32x4*)(Ml + (16 * mt + r16) * 68 + ks * 32 + g * 8 + 4);
                    const u32x4 pk = pack8(t0, t1);
                    at[mt][ks] = __builtin_bit_cast(bf16x8, pk);
                }
#pragma unroll 1
            for (int pass = 0; pass < 2; ++pass) {
                u16* base = pass == 0 ? z + (size_t)R0 * ZLD + ZV + h * 128 : wbuf + (size_t)(item * 8 + h) * 64 * 128;
                const unsigned ld = pass == 0 ? ZLD : 128;
                const unsigned o0 = (unsigned)(g * 8) * ld + r16, o1 = o0 + 32u * ld, os = (unsigned)(4 * g) * ld + r16;
#pragma unroll 1
                for (int nh = 0; nh < 8; nh += 2) {
                    bf16x8 bb[2][2];
#pragma unroll
                    for (int nt = 0; nt < 2; ++nt)
#pragma unroll
                        for (int j = 0; j < 8; ++j) { bb[nt][0][j] = (short)base[(nh + nt) * 16 + o0 + j * ld]; bb[nt][1][j] = (short)base[(nh + nt) * 16 + o1 + j * ld]; }
#pragma unroll
                    for (int nt = 0; nt < 2; ++nt) {
                        f32x4 c[4];
#pragma unroll
                        for (int mt = 0; mt < 4; ++mt) { c[mt] = MFMA16(at[mt][0], bb[nt][0], zero4()); c[mt] = MFMA16(at[mt][1], bb[nt][1], c[mt]); }
#pragma unroll
                        for (int mt = 0; mt < 4; ++mt)
#pragma unroll
                            for (int i = 0; i < 4; ++i) base[(nh + nt) * 16 + os + (16 * mt + i) * ld] = f2bf(c[mt][i]);
                    }
                }
            }
        }
        __syncthreads();
    }
}

DI bf16x8 frag_perm(LAS u16* p) {
    const u32x2 lo = *(LAS u32x2*)p, hi = *(LAS u32x2*)(p + 16);
    const u32x4 v = (u32x4){lo.x, lo.y, hi.x, hi.y};
    return __builtin_bit_cast(bf16x8, v);
}
DI bf16x8 pack_pair(const f32x4 a, const f32x4 b) { const u32x4 v = (u32x4){pack2(a[0], a[1]), pack2(a[2], a[3]), pack2(b[0], b[1]), pack2(b[2], b[3])}; return __builtin_bit_cast(bf16x8, v); }
DI void phase_scan(const Args& a, LAS unsigned char* lds, int s) {
    const int tid = otid(), lane = tid & 63, wid = tid >> 6, r16 = lane & 15, g = lane >> 4;
    const int b = s >> 3, h = s & 7;
    u16* z = (u16*)(a.ws + WS_Z);
    const u16* wbuf = (const u16*)(a.ws + WS_H);
    const u16* abuf = (const u16*)(a.ws + WS_RA);
    const float* lastbuf = (const float*)(a.ws + WS_LAST);
    LAS u16* Wl = (LAS u16*)lds;
    LAS u16* Ql = Wl + 64 * 136;
    LAS u16* Al = Ql + 64 * 136;
    LAS u16* KT = Al + 64 * 72;
    LAS u16* Ul = KT + 128 * 72;
    LAS u16* Ol = Ul + 64 * 136;
    if (wid >= 4) {
        const int lt = tid - 256;
        const int t0 = lt >> 4, c80 = (lt & 15) * 8;
        const int pc = (c80 & ~31) + 8 * ((c80 >> 2) & 3) + 4 * ((c80 >> 4) & 1);
        const int ta = lt >> 3, ca = (lt & 7) * 8;
        const int pca = (ca & ~31) + 8 * ((ca >> 2) & 3) + 4 * ((ca >> 4) & 1);
        const int tk = lt & 63, dg = lt >> 6;
        const int ptk = (tk & ~31) + 8 * ((tk >> 2) & 3) + 4 * ((tk >> 4) & 1) + (tk & 3);
        const f32x4 ow0 = *(const f32x4*)(a.in[17] + c80), ow1 = *(const f32x4*)(a.in[17] + c80 + 4);
        u32x4 pw[4], pq[4], pu[4], pg[4], pk[4], pa[2], gc[4];
#define SCAN_LOAD(n_) do { const int R0_ = b * 2048 + (n_) * 64; const size_t ci_ = (size_t)((b * 32 + (n_)) * 8 + h); \
            _Pragma("unroll") for (int i_ = 0; i_ < 4; ++i_) { const int tr_ = t0 + 16 * i_; \
                pw[i_] = *(const u32x4*)(wbuf + ci_ * 8192 + tr_ * 128 + c80); \
                const u16* zz_ = z + (size_t)(R0_ + tr_) * ZLD + h * 128 + c80; \
                pq[i_] = *(const u32x4*)(zz_ + ZQ); pu[i_] = *(const u32x4*)(zz_ + ZV); pg[i_] = *(const u32x4*)(zz_ + ZG); \
                pk[i_] = *(const u32x4*)(z + (size_t)(R0_ + tk) * ZLD + ZK + h * 128 + (dg + 4 * i_) * 8); } \
            _Pragma("unroll") for (int i_ = 0; i_ < 2; ++i_) pa[i_] = *(const u32x4*)(abuf + ci_ * 4096 + (ta + 32 * i_) * 64 + ca); } while (0)
        SCAN_LOAD(0);
#pragma unroll 1
        for (int n = 0; n < 32; ++n) {
            const int R0 = b * 2048 + n * 64;
#pragma unroll
            for (int i = 0; i < 4; ++i) {
                const int tr = t0 + 16 * i;
                *(LAS u32x2*)(Wl + tr * 136 + pc) = (u32x2){pw[i].x, pw[i].y}; *(LAS u32x2*)(Wl + tr * 136 + pc + 8) = (u32x2){pw[i].z, pw[i].w};
                *(LAS u32x2*)(Ql + tr * 136 + pc) = (u32x2){pq[i].x, pq[i].y}; *(LAS u32x2*)(Ql + tr * 136 + pc + 8) = (u32x2){pq[i].z, pq[i].w};
                *(LAS u32x4*)(Ul + tr * 136 + c80) = pu[i];
                gc[i] = pg[i];
                const unsigned e[4] = {pk[i].x, pk[i].y, pk[i].z, pk[i].w};
                const int d0 = (dg + 4 * i) * 8;
#pragma unroll
                for (int j = 0; j < 4; ++j) { KT[(d0 + 2 * j) * 72 + ptk] = (u16)(e[j] & 0xFFFFu); KT[(d0 + 2 * j + 1) * 72 + ptk] = (u16)(e[j] >> 16); }
            }
#pragma unroll
            for (int i = 0; i < 2; ++i) { *(LAS u32x2*)(Al + (ta + 32 * i) * 72 + pca) = (u32x2){pa[i].x, pa[i].y}; *(LAS u32x2*)(Al + (ta + 32 * i) * 72 + pca + 8) = (u32x2){pa[i].z, pa[i].w}; }
            __syncthreads();
            if (n + 1 < 32) SCAN_LOAD(n + 1);
            asm volatile("s_waitcnt lgkmcnt(0)\n\ts_barrier" ::: "memory");
#pragma unroll
            for (int i = 0; i < 4; ++i) {
                const int tok = t0 + 16 * i;
                const u32x4 ov = *(LAS u32x4*)(Ol + tok * 136 + c80);
                const float q2 = bflo(ov.x) * bflo(ov.x) + bfhi(ov.x) * bfhi(ov.x) + bflo(ov.y) * bflo(ov.y) + bfhi(ov.y) * bfhi(ov.y) + bflo(ov.z) * bflo(ov.z) + bfhi(ov.z) * bfhi(ov.z) + bflo(ov.w) * bflo(ov.w) + bfhi(ov.w) * bfhi(ov.w);
                const float rstd = rsqrtf(row_sum16(q2) * (1.f / 128.f) + EPS);
                const u32x4 gv = gc[i];
                u32x4 r;
                r.x = pack2(bflo(ov.x) * rstd * ow0[0] * bflo(gv.x), bfhi(ov.x) * rstd * ow0[1] * bfhi(gv.x));
                r.y = pack2(bflo(ov.y) * rstd * ow0[2] * bflo(gv.y), bfhi(ov.y) * rstd * ow0[3] * bfhi(gv.y));
                r.z = pack2(bflo(ov.z) * rstd * ow1[0] * bflo(gv.z), bfhi(ov.z) * rstd * ow1[1] * bfhi(gv.z));
                r.w = pack2(bflo(ov.w) * rstd * ow1[2] * bflo(gv.w), bfhi(ov.w) * rstd * ow1[3] * bfhi(gv.w));
                *(u32x4*)(z + (size_t)(R0 + tok) * ZLD + ZG + h * 128 + c80) = r;
            }
        }
#undef SCAN_LOAD
    } else {
        f32x4 st[2][8];
#pragma unroll
        for (int t = 0; t < 2; ++t)
#pragma unroll
            for (int nt = 0; nt < 8; ++nt) st[t][nt] = zero4();
        const int dv0 = 32 * wid + r16;
#define SB_ __builtin_amdgcn_sched_barrier(0)
#define LD_ROWS2(dst, base, m0) _Pragma("unroll") for (int q_ = 0; q_ < 2; ++q_) _Pragma("unroll") for (int ks_ = 0; ks_ < 4; ++ks_) dst[q_ * 4 + ks_] = *(LAS bf16x8*)(base + (16 * ((m0) + q_) + r16) * 136 + ks_ * 32 + 8 * g)
#define LD_ROWS4(dst, base, m0) _Pragma("unroll") for (int q_ = 0; q_ < 4; ++q_) _Pragma("unroll") for (int ks_ = 0; ks_ < 2; ++ks_) dst[q_ * 2 + ks_] = *(LAS bf16x8*)(base + (16 * ((m0) + q_) + r16) * 72 + ks_ * 32 + 8 * g)
#pragma unroll 1
        for (int n = 0; n < 32; ++n) {
            const float last = lastbuf[(b * 32 + n) * 8 + h];
            bf16x8 sb[2][4];
#pragma unroll
            for (int t = 0; t < 2; ++t)
#pragma unroll
                for (int ks = 0; ks < 4; ++ks) sb[t][ks] = pack_pair(st[t][2 * ks], st[t][2 * ks + 1]);
            __syncthreads();
            bf16x8 fa[8], fb[8];
            f32x4 vn[2][4];
            LD_ROWS2(fa, Wl, 0); LD_ROWS2(fb, Wl, 2);
            SB_;
#pragma unroll
            for (int half = 0; half < 2; ++half) {
#pragma unroll
                for (int q = 0; q < 2; ++q) {
                    const int mt = 2 * half + q;
#pragma unroll
                    for (int t = 0; t < 2; ++t) {
                        f32x4 c = zero4();
#pragma unroll
                        for (int ks = 0; ks < 4; ++ks) c = MFMA16(half ? fb[q * 4 + ks] : fa[q * 4 + ks], sb[t][ks], c);
                        LAS u16* up = Ul + (16 * mt + 4 * g) * 136 + dv0 + 16 * t;
                        vn[t][mt] = (f32x4){bf2f(up[0]) - c[0], bf2f(up[136]) - c[1], bf2f(up[272]) - c[2], bf2f(up[408]) - c[3]};
                    }
                }
                if (half == 0) { SB_; LD_ROWS4(fa, KT, 0); SB_; }
            }
            bf16x8 vb[2][2];
#pragma unroll
            for (int t = 0; t < 2; ++t)
#pragma unroll
                for (int ks = 0; ks < 2; ++ks) vb[t][ks] = pack_pair(vn[t][2 * ks], vn[t][2 * ks + 1]);
            SB_;
            LD_ROWS4(fb, KT, 4);
            SB_;
#pragma unroll
            for (int half = 0; half < 2; ++half) {
#pragma unroll
                for (int q = 0; q < 4; ++q)
#pragma unroll
                    for (int t = 0; t < 2; ++t) {
                        f32x4 c = st[t][4 * half + q] * last;
#pragma unroll
                        for (int ks = 0; ks < 2; ++ks) c = MFMA16(half ? fb[q * 2 + ks] : fa[q * 2 + ks], vb[t][ks], c);
                        st[t][4 * half + q] = c;
                    }
                if (half == 0) { SB_; LD_ROWS2(fa, Ql, 0); SB_; } else { SB_; LD_ROWS2(fb, Ql, 2); SB_; }
            }
            f32x4 oa[2][4];
#pragma unroll
            for (int half = 0; half < 2; ++half) {
#pragma unroll
                for (int q = 0; q < 2; ++q)
#pragma unroll
                    for (int t = 0; t < 2; ++t) {
                        f32x4 c = zero4();
#pragma unroll
                        for (int ks = 0; ks < 4; ++ks) c = MFMA16(half ? fb[q * 4 + ks] : fa[q * 4 + ks], sb[t][ks], c);
                        oa[t][2 * half + q] = c;
                    }
                if (half == 0) { SB_; LD_ROWS4(fa, Al, 0); SB_; }
            }
            SB_;
#pragma unroll
            for (int mt = 0; mt < 4; ++mt)
#pragma unroll
                for (int t = 0; t < 2; ++t) {
                    f32x4 c = oa[t][mt];
#pragma unroll
                    for (int ks = 0; ks < 2; ++ks) c = MFMA16(fa[mt * 2 + ks], vb[t][ks], c);
                    const unsigned w0 = pack2(c[0], c[1]), w1 = pack2(c[2], c[3]);
                    LAS u16* op = Ol + (16 * mt + 4 * g) * 136 + dv0 + 16 * t;
                    op[0] = (u16)(w0 & 0xFFFFu); op[136] = (u16)(w0 >> 16); op[272] = (u16)(w1 & 0xFFFFu); op[408] = (u16)(w1 >> 16);
                }
            __syncthreads();
        }
#undef SB_
#undef LD_ROWS2
#undef LD_ROWS4
        float* So = a.out + OFF_GSP + (size_t)(b * 8 + h) * 16384;
#pragma unroll
        for (int t = 0; t < 2; ++t)
#pragma unroll
            for (int nt = 0; nt < 8; ++nt)
#pragma unroll
                for (int i = 0; i < 4; ++i) So[(size_t)(16 * nt + 4 * g + i) * 128 + dv0 + 16 * t] = st[t][nt][i];
    }
}

DI void swa_prompt_item(const Args& a, LAS unsigned char* lds, int it) {
    const int tid = otid(), lane = tid & 63, wid = tid >> 6, r16 = lane & 15, g = lane >> 4;
    const int b = it >> 6, kvh = (it >> 4) & 3, n = it & 15;
    u16* z = (u16*)(a.ws + WS_Z);
    LAS u16* Kl = (LAS u16*)lds;
    LAS u16* VTl = Kl + 256 * 72;
    LAS u16* Pl = VTl + 64 * 280 + wid * (16 * 168);
    const int gq = wid >> 1, th = wid & 1, qh = kvh * 4 + gq;
    bf16x8 qfa[4][2];
#pragma unroll
    for (int mtl = 0; mtl < 4; ++mtl)
#pragma unroll
        for (int ks = 0; ks < 2; ++ks) qfa[mtl][ks] = *(const bf16x8*)(z + ((size_t)(b * 2048 + n * 128 + 16 * (th * 4 + mtl)) + r16) * ZLD + ZSQ + qh * 64 + ks * 32 + g * 8);
#pragma unroll
    for (int i = 0; i < 4; ++i) {
        const int p = tid + 512 * i, key = p & 255, d8 = (p >> 8) * 8, srow = (n - 1) * 128 + key;
        u32x4 kv = (u32x4){0u, 0u, 0u, 0u}, vv = kv;
        if (srow >= 0) { const u16* base = z + (size_t)(b * 2048 + srow) * ZLD + kvh * 64 + d8; kv = *(const u32x4*)(base + ZSK); vv = *(const u32x4*)(base + ZSV); }
        *(LAS u32x4*)(Kl + key * 72 + d8) = kv;
        const unsigned e[4] = {vv.x, vv.y, vv.z, vv.w};
#pragma unroll
        for (int j = 0; j < 4; ++j) { VTl[(d8 + 2 * j) * 280 + key] = (u16)(e[j] & 0xFFFFu); VTl[(d8 + 2 * j + 1) * 280 + key] = (u16)(e[j] >> 16); }
    }
    for (int idx = tid; idx < 1536; idx += 512) { const int d = idx / 24; VTl[d * 280 + 256 + (idx - d * 24)] = 0; }
    __syncthreads();
    const float sink = a.in[19][qh];
#pragma unroll
    for (int mtl = 0; mtl < 4; ++mtl) {
        const int mt = th * 4 + mtl, tq0 = 16 * mt;
        const size_t rowA = (size_t)(b * 2048 + n * 128 + tq0);
        const bf16x8 qf[2] = {qfa[mtl][0], qfa[mtl][1]};
        f32x4 sc[9];
#pragma unroll
        for (int j = 0; j < 9; ++j) {
            f32x4 c = zero4();
#pragma unroll
            for (int ks = 0; ks < 2; ++ks) c = MFMA16(qf[ks], *(LAS bf16x8*)(Kl + (16 * (mt + j) + r16) * 72 + ks * 32 + g * 8), c);
            sc[j] = c;
        }
        float mx[4], sm[4];
#pragma unroll
        for (int i = 0; i < 4; ++i) mx[i] = sink;
#pragma unroll
        for (int j = 0; j < 9; ++j)
#pragma unroll
            for (int i = 0; i < 4; ++i) {
                const int tq = tq0 + 4 * g + i, kk = 16 * (mt + j) + r16;
                const bool valid = (kk > tq) && (kk <= tq + 128) && (n > 0 || kk >= 128);
                const float sv = valid ? sc[j][i] * 0.125f : -1e30f;
                sc[j][i] = sv; mx[i] = fmaxf(mx[i], sv);
            }
#pragma unroll
        for (int i = 0; i < 4; ++i) {
            float m = mx[i];
            mx[i] = row_max16(m); sm[i] = 0.f;
        }
#pragma unroll
        for (int j = 0; j < 9; ++j)
#pragma unroll
            for (int i = 0; i < 4; ++i) {
                const float p = (sc[j][i] > -1e29f) ? __expf(sc[j][i] - mx[i]) : 0.f;
                sm[i] += p;
                Pl[(4 * g + i) * 168 + 16 * j + r16] = f2bf(p);
            }
#pragma unroll
        for (int i = 0; i < 4; ++i) {
            Pl[(4 * g + i) * 168 + 144 + r16] = 0;
            const float s = row_sum16(sm[i]);
            sm[i] = 1.f / (s + __expf(sink - mx[i]));
        }
        f32x4 o[4];
#pragma unroll
        for (int nd = 0; nd < 4; ++nd) o[nd] = zero4();
#pragma unroll
        for (int ks = 0; ks < 5; ++ks) {
            const bf16x8 pa = *(LAS bf16x8*)(Pl + r16 * 168 + ks * 32 + g * 8);
#pragma unroll
            for (int nd = 0; nd < 4; ++nd) o[nd] = MFMA16(pa, *(LAS bf16x8*)(VTl + (16 * nd + r16) * 280 + 16 * mt + ks * 32 + g * 8), o[nd]);
        }
#pragma unroll
        for (int nd = 0; nd < 4; ++nd)
#pragma unroll
            for (int i = 0; i < 4; ++i) z[(rowA + 4 * g + i) * ZLD + ZSQ + qh * 64 + 16 * nd + r16] = f2bf(o[nd][i] * sm[i]);
    }
    __syncthreads();
}

DI void swa_sample_item(const Args& a, LAS unsigned char* lds, int it) {
    const int tid = otid(), lane = tid & 63, wid = tid >> 6;
    const int b = it >> 2, kvh = it & 3;
    u16* zr = (u16*)(a.ws + WS_Z) + (size_t)(NP + b) * ZLD;
    LAS float* ql = (LAS float*)lds;
    LAS float* ps = ql + 256;
    LAS float* pl = ps + 2048;
    LAS float* red = pl + 512;
    LAS float* po = red + 16;
    const int key = tid & 127, qt = tid >> 7;
    f32x4 kv[4];
    if (key < 127) { const float* kp = a.in[6] + ((size_t)(b * 128 + key + 1) * 4 + kvh) * 64 + qt * 16;
#pragma unroll
        for (int i = 0; i < 4; ++i) kv[i] = *(const f32x4*)(kp + 4 * i);
    } else { const u16* kp = zr + ZSK + kvh * 64 + qt * 16;
#pragma unroll
        for (int i = 0; i < 4; ++i) kv[i] = (f32x4){bf2f(kp[4 * i]), bf2f(kp[4 * i + 1]), bf2f(kp[4 * i + 2]), bf2f(kp[4 * i + 3])};
    }
    const int d4 = (tid & 15) * 4, kg = tid >> 4;
    f32x4 vv[4];
#pragma unroll
    for (int i = 0; i < 4; ++i) {
        const int kx = 4 * kg + i;
        if (kx < 127) vv[i] = *(const f32x4*)(a.in[7] + ((size_t)(b * 128 + kx + 1) * 4 + kvh) * 64 + d4);
        else { const u16* vp = zr + ZSV + kvh * 64 + d4; vv[i] = (f32x4){bf2f(vp[0]), bf2f(vp[1]), bf2f(vp[2]), bf2f(vp[3])}; }
    }
    if (tid < 256) ql[tid] = bf2f(zr[ZSQ + kvh * 256 + tid]);
    __syncthreads();
#pragma unroll
    for (int gq = 0; gq < 4; ++gq) {
        float s = 0.f;
#pragma unroll
        for (int i = 0; i < 4; ++i) { const f32x4 q4 = *(LAS f32x4*)(ql + gq * 64 + qt * 16 + 4 * i); s += q4[0] * kv[i][0] + q4[1] * kv[i][1] + q4[2] * kv[i][2] + q4[3] * kv[i][3]; }
        ps[(qt * 4 + gq) * 128 + key] = s;
    }
    __syncthreads();
    const int gq = tid >> 7;
    const float s = 0.125f * (ps[(0 * 4 + gq) * 128 + key] + ps[(1 * 4 + gq) * 128 + key] + ps[(2 * 4 + gq) * 128 + key] + ps[(3 * 4 + gq) * 128 + key]);
    const float sink = a.in[19][kvh * 4 + gq];
    float m = row_max16(s); m = fmaxf(m, __shfl_xor(m, 16)); m = fmaxf(m, __shfl_xor(m, 32));
    if (lane == 0) red[wid] = m;
    __syncthreads();
    m = fmaxf(fmaxf(red[2 * gq], red[2 * gq + 1]), sink);
    const float p = __expf(s - m);
    float psum = row_sum16(p); psum += __shfl_xor(psum, 16); psum += __shfl_xor(psum, 32);
    if (lane == 0) red[8 + wid] = psum;
    __syncthreads();
    pl[gq * 128 + key] = p * __builtin_amdgcn_rcpf(red[8 + 2 * gq] + red[8 + 2 * gq + 1] + __expf(sink - m));
    __syncthreads();
#pragma unroll
    for (int g2 = 0; g2 < 4; ++g2) {
        const f32x4 pw = *(LAS f32x4*)(pl + g2 * 128 + 4 * kg);
        *(LAS f32x4*)(po + (kg * 4 + g2) * 64 + d4) = vv[0] * pw[0] + vv[1] * pw[1] + vv[2] * pw[2] + vv[3] * pw[3];
    }
    __syncthreads();
    if (tid < 256) {
        float o = 0.f;
#pragma unroll
        for (int k2 = 0; k2 < 32; ++k2) o += po[k2 * 256 + tid];
        zr[ZSQ + kvh * 256 + tid] = f2bf(o);
    }
    __syncthreads();
}

DI void gdn_sample_item(const Args& a, LAS unsigned char* lds, int it) {
    const int tid = otid(), lane = tid & 63, wid = tid >> 6;
    const int b = it >> 3, h = it & 7, row = NP + b;
    u16* zr = (u16*)(a.ws + WS_Z) + (size_t)row * ZLD;
    const float* zb = (const float*)(a.ws + WS_ZB) + (size_t)row * 16;
    const float* cw = a.in[14];
    LAS float* act = (LAS float*)lds;
    LAS float* nrm = act + 384;
    LAS float* pkl = act + 512;
    LAS float* pql = pkl + 2048;
    const int dv4 = (tid & 31) * 4, dk0 = tid >> 5;
    const float* S0 = a.in[4] + (size_t)(b * 8 + h) * 16384;
    f32x4 sd[8];
#pragma unroll
    for (int i = 0; i < 8; ++i) sd[i] = __builtin_nontemporal_load((const f32x4*)(S0 + (size_t)(dk0 + 16 * i) * 128 + dv4));
    if (tid < 384) {
        const int col = (tid >> 7) * 1024 + h * 128 + (tid & 127);
        float x = cw[3 * 3072 + col] * bf2f(zr[col]);
#pragma unroll
        for (int j = 0; j < 3; ++j) x += cw[j * 3072 + col] * a.in[5][((size_t)b * 3 + j) * 3072 + col];
        act[tid] = silu(x);
    }
    __syncthreads();
    if (wid < 3) {
        const int o0 = wid == 2 ? 0 : wid * 128, o1 = wid == 2 ? 128 : wid * 128;
        float ss = act[o0 + lane] * act[o1 + lane] + act[o0 + 64 + lane] * act[o1 + 64 + lane];
#pragma unroll
        for (int o = 1; o < 64; o <<= 1) ss += __shfl_xor(ss, o);
        if (lane == 0) nrm[wid] = ss;
    }
    __syncthreads();
    const float qs = rsqrtf(nrm[0] + EPS) * 0.08838834764831845f, ksc = rsqrtf(nrm[1] + EPS), qk = nrm[2] * qs * ksc;
    const float beta = sigm(zb[h]);
    const float eg = __expf(-__expf(a.in[15][h]) * softplus(zb[8 + h] + a.in[16][h]));
    float* S1 = a.out + OFF_GSS + (size_t)(b * 8 + h) * 16384;
    f32x4 pk = zero4(), pq = zero4();
#pragma unroll
    for (int i = 0; i < 8; ++i) {
        const int dk = dk0 + 16 * i;
        sd[i] = sd[i] * eg;
        pk += sd[i] * (act[128 + dk] * ksc); pq += sd[i] * (act[dk] * qs);
    }
    *(LAS f32x4*)(pkl + dk0 * 128 + dv4) = pk; *(LAS f32x4*)(pql + dk0 * 128 + dv4) = pq;
    __syncthreads();
    f32x4 ksum = zero4(), qsum = zero4();
#pragma unroll
    for (int r = 0; r < 16; ++r) { ksum += *(LAS f32x4*)(pkl + r * 128 + dv4); qsum += *(LAS f32x4*)(pql + r * 128 + dv4); }
    f32x4 delta;
#pragma unroll
    for (int c = 0; c < 4; ++c) delta[c] = (act[256 + dv4 + c] - ksum[c]) * beta;
#pragma unroll
    for (int i = 0; i < 8; ++i) { const int dk = dk0 + 16 * i; __builtin_nontemporal_store(sd[i] + delta * (act[128 + dk] * ksc), (f32x4*)(S1 + (size_t)dk * 128 + dv4)); }
    if (tid < 32) {
        const f32x4 o = qsum + delta * qk;
        float ss = o[0] * o[0] + o[1] * o[1] + o[2] * o[2] + o[3] * o[3];
#pragma unroll
        for (int m = 1; m < 32; m <<= 1) ss += __shfl_xor(ss, m);
        const float rstd = rsqrtf(ss * (1.f / 128.f) + EPS);
        u16* gp = zr + ZG + h * 128 + dv4;
        const u32x2 gv = *(const u32x2*)gp;
        const float g0 = bflo(gv.x), g1 = bfhi(gv.x), g2 = bflo(gv.y), g3 = bfhi(gv.y);
        const f32x4 w = *(const f32x4*)(a.in[17] + dv4);
        *(u32x2*)gp = (u32x2){pack2(o[0] * rstd * w[0] * g0, o[1] * rstd * w[1] * g1), pack2(o[2] * rstd * w[2] * g2, o[3] * rstd * w[3] * g3)};
    }
    __syncthreads();
}

DI void state_copies(const Args& a, int vt, int nvt) {
    const u16* z = (const u16*)(a.ws + WS_Z);
    const u16* halo = (const u16*)(a.ws + WS_HALO);
    float* out = a.out;
    for (int i = vt; i < 8 * 3 * 3072; i += nvt) { const int b = i / 9216, r = i - b * 9216; out[OFF_GCP + i] = bf2f(halo[(size_t)((b * 32 + 31) * 3) * 3072 + r]); }
    for (int i = vt; i < 128 * 3 * 3072; i += nvt) {
        const int b = i / 9216, r = i - b * 9216, j = r / 3072, c = r - j * 3072;
        out[OFF_GCS + i] = (j < 2) ? a.in[5][((size_t)b * 3 + j + 1) * 3072 + c] : bf2f(z[(size_t)(NP + b) * ZLD + c]);
    }
    for (int i = vt; i < 8 * 128 * 256; i += nvt) {
        const int b = i >> 15, w = (i >> 8) & 127, c = i & 255;
        const u16* zr = z + (size_t)(b * 2048 + 1920 + w) * ZLD;
        out[OFF_KP + i] = bf2f(zr[ZSK + c]); out[OFF_VP + i] = bf2f(zr[ZSV + c]);
    }
    for (int i = vt; i < 128 * 128 * 64; i += nvt) {
        const int b = i >> 13, w = (i >> 6) & 127, c = (i & 63) * 4;
        f32x4 kv, vv;
        if (w < 127) { const size_t o = ((size_t)b * 128 + w + 1) * 256 + c; kv = *(const f32x4*)(a.in[6] + o); vv = *(const f32x4*)(a.in[7] + o); }
        else { const u16* zr = z + (size_t)(NP + b) * ZLD;
            kv = (f32x4){bf2f(zr[ZSK + c]), bf2f(zr[ZSK + c + 1]), bf2f(zr[ZSK + c + 2]), bf2f(zr[ZSK + c + 3])};
            vv = (f32x4){bf2f(zr[ZSV + c]), bf2f(zr[ZSV + c + 1]), bf2f(zr[ZSV + c + 2]), bf2f(zr[ZSV + c + 3])}; }
        __builtin_nontemporal_store(kv, (f32x4*)(out + OFF_KS + (size_t)i * 4)); __builtin_nontemporal_store(vv, (f32x4*)(out + OFF_VS + (size_t)i * 4));
    }
}

__global__ void __launch_bounds__(512, 2) fwd_megakernel(Args a) {
    extern __shared__ __attribute__((aligned(16))) unsigned char smem[];
    LAS unsigned char* lds = (LAS unsigned char*)smem;
    cg::grid_group grid = cg::this_grid();
    if (a.ws == nullptr) grid.sync();
    { volatile LAS unsigned* st_ = (volatile LAS unsigned*)(lds + LDS_XB); if (threadIdx.x < 4) st_[threadIdx.x] = 0u; }
    __syncthreads();
    const XcdBarrier xbar = xcd_barrier_post((unsigned*)(a.ws + WS_BAR), (volatile LAS unsigned*)(lds + LDS_XB));
    u16* H = (u16*)(a.ws + WS_H);
    u16* Z = (u16*)(a.ws + WS_Z);
    phase0(a, lds);
    xcd_barrier(xbar);
    phase_norm<0>(a);
    xcd_barrier(xbar);
    { EpiZ e; e.z = Z; e.gab = (u16*)a.out; e.zb = (float*)(a.ws + WS_ZB); e.halo = (u16*)(a.ws + WS_HALO);
      run_gemm(lds, H, 1024, (const u16*)(a.ws + WS_RA), 1024, MP, N1, 1024, e); }
    xcd_barrier(xbar);
    phase_prep(a, lds);
    xcd_barrier(xbar);
    if (blockIdx.x < 64) {
        phase_scan(a, lds, blockIdx.x);
        __syncthreads();
    } else {
        const int v = blockIdx.x - 64, nv = gridDim.x - 64, v2 = (v + 64) % nv;
        if (gridDim.x == 256) {
            const int xcd = blockIdx.x & 7, j = v >> 3;
            for (int m = j; m < 64; m += 24) swa_prompt_item(a, lds, (xcd + 8 * (m >> 4)) * 16 + (m & 15));
        } else {
            for (int it = v; it < 512; it += nv) swa_prompt_item(a, lds, it);
        }
        for (int it = v2; it < 1024; it += nv) gdn_sample_item(a, lds, it);
        for (int it = v2; it < 512; it += nv) swa_sample_item(a, lds, it);
        state_copies(a, v * 512 + otid(), nv * 512);
    }
    xcd_barrier(xbar);
    skinny_phase<0>(a, lds);
    { EpiMixBoth e; e.e0.mix = H; e.e0.gab = (const u16*)a.out; e.e1.mix = H; e.e1.gab = (const u16*)a.out;
      pg8::Gemm g; g.A = Z + ZG; g.Bt = (const u16*)(a.ws + WS_WA); g.A2 = Z + ZSQ; g.Bt2 = (const u16*)(a.ws + WS_WB); g.M = NP; g.N = 1024; g.K = 1024; g.lda = ZLD; g.ldb = 1024;
      MixOrder S; S.base.init(NP, 1024, (int)gridDim.x, (int)blockIdx.x);
      pg8::gemm_phase<EpiMixBoth, MixOrder, false>((PG8_LAS unsigned char*)lds, g, S, e, nullptr); }
    xcd_barrier(xbar);
    { EpiRes<0> e; e.out = a.out; e.xp = a.in[0]; e.xs = a.in[1]; e.mod = (const float*)(a.ws + WS_MOD); e.xh = nullptr; skinny_phase<1>(a, lds);
      run_gemm(lds, H, 1024, (const u16*)(a.ws + WS_WO), 1024, NP, 1024, 1024, e); }
    xcd_barrier(xbar);
    phase_norm<1>(a);
    xcd_barrier(xbar);
    { EpiPlain e; e.o = Z; e.ld = FF; run_gemm(lds, H, 1024, (const u16*)(a.ws + WS_WG), 1024, MP, FF, 1024, e); }
    xcd_barrier(xbar);
    { EpiAct e; e.act = Z + (size_t)MP * FF; e.gate = Z; e.cw = a.in[24]; e.cb = a.in[25]; e.sf = a.in[8]; e.out = a.out;
      run_gemm(lds, H, 1024, (const u16*)(a.ws + WS_WU), 1024, MP, FF, 1024, e); }
    xcd_barrier(xbar);
    { EpiRes<1> e; e.out = a.out; e.xp = a.in[0]; e.xs = a.in[1]; e.mod = (const float*)(a.ws + WS_MOD); e.xh = H; skinny_phase<2>(a, lds);
      run_gemm(lds, Z + (size_t)MP * FF, FF, (const u16*)(a.ws + WS_WD), FF, NP, 1024, FF, e); }
    xcd_barrier(xbar);
    phase_final(a);
}

extern "C" void kernel_launch(void* const* d_in, const int* in_sizes, int n_in, void* d_out, int out_size, void* d_ws, size_t ws_size, hipStream_t stream) {
    static int grid = 0;
    if (grid == 0) {
        if (n_in != 28 || ws_size < WS_END) { fprintf(stderr, "kernel_launch: expected 28 inputs and >= %zu bytes of workspace (got %d, %zu)\n", (size_t)WS_END, n_in, ws_size); grid = -1; return; }
        int dev = 0, cus = 0, per_cu = 0;
        hipGetDevice(&dev);
        hipDeviceGetAttribute(&cus, hipDeviceAttributeMultiprocessorCount, dev);
        if (hipFuncSetAttribute((const void*)fwd_megakernel, hipFuncAttributeMaxDynamicSharedMemorySize, LDS_BYTES) != hipSuccess) { fprintf(stderr, "kernel_launch: hipFuncSetAttribute failed\n"); grid = -1; return; }
        hipOccupancyMaxActiveBlocksPerMultiprocessor(&per_cu, (const void*)fwd_megakernel, 512, LDS_BYTES);
        if (per_cu < 1) fprintf(stderr, "kernel_launch: occupancy query says %d blocks per CU\n", per_cu);
        (void)hipGetLastError();
        grid = cus;
    }
    if (grid < 0) return;
    if (hipMemsetAsync((char*)d_ws + WS_BAR, 0, 16384, stream) != hipSuccess) { fprintf(stderr, "kernel_launch: memset of the barrier words failed\n"); return; }
    Args a{};
    for (int i = 0; i < 28; ++i) a.in[i] = (const float*)d_in[i];
    a.out = (float*)d_out; a.ws = (unsigned char*)d_ws;
    void* args[] = {&a};
    hipError_t e = hipLaunchCooperativeKernel((const void*)fwd_megakernel, dim3(grid), dim3(512), args, LDS_BYTES, stream);
    if (e != hipSuccess) fprintf(stderr, "cooperative launch failed: %s (grid %d)\n", hipGetErrorString(e), grid);
}
```

```cpp
#include <hip/hip_runtime.h>
#include <hip/hip_cooperative_groups.h>
#include <cstdio>
namespace cg = cooperative_groups;
__device__ __forceinline__ int otid() { int t = threadIdx.x; asm volatile("" : "+v"(t)); return t; }
namespace pg8 {
#define PG8_LAS __attribute__((address_space(3)))
typedef unsigned short bf16_t;
typedef short bf16x8 __attribute__((ext_vector_type(8)));
typedef float f32x4 __attribute__((ext_vector_type(4)));
typedef unsigned u32x4 __attribute__((ext_vector_type(4)));
constexpr int BM = 256, BK = 64, HALF = 128, HTB = HALF * BK * 2  , STAGE_BYTES = 8 * HTB, NXCD = 8, WGM = 8;

__host__ __device__ __forceinline__ int lds_byte(int r, int c) { const int st = (r >> 4) * 2 + (c >> 5), rr = r & 15, cc = c & 31, ob = rr * 64 + cc * 2; return st * 1024 + (ob ^ (((ob >> 9) & 1) << 5)); }
__host__ __device__ __forceinline__ void stage_rc(int b, int& R, int& C) { const int st = b / 1024, sb = b % 1024, swz = sb ^ (((sb >> 9) & 1) << 5); R = (st >> 1) * 16 + swz / 64; C = (st & 1) * 32 + (swz % 64) / 2; }
__host__ __device__ __forceinline__ int perm32(int rho) { const int n = rho >> 4, i = rho & 15; return 8 * (i >> 2) + 4 * n + (i & 3); }

struct Unit { int pm, pn, sel = 0; };
struct Gemm { const bf16_t* A; const bf16_t* Bt; int M, N, K, lda, ldb; const bf16_t* A2 = nullptr; const bf16_t* Bt2 = nullptr; };

struct StaticOrder {
    int nM, nN, nwg, G, c;
    __host__ __device__ void init(int M, int N, int G_, int c_) { nM = M / BM; nN = N / BM; nwg = nM * nN; G = G_; c = c_; }
    __host__ __device__ bool next(int i, Unit& u) const {
        const long L = (long)i * G + c; if (L >= nwg) return false;
        int wgid = (int)L; { const int q = nwg / NXCD, r = nwg % NXCD, xcd = wgid % NXCD, off = wgid / NXCD; wgid = (xcd < r ? xcd * (q + 1) : r * (q + 1) + (xcd - r) * q) + off; }
        const int nig = WGM * nN, gid = wgid / nig, fm = gid * WGM, gsz = (nM - fm) < WGM ? (nM - fm) : WGM;
        u.pm = fm + ((wgid % nig) % gsz); u.pn = (wgid % nig) / gsz; return true;
    }
    __device__ __forceinline__ void a_ready(const Unit&) const {}
    __device__ __forceinline__ void done(const Unit&) const {}
};

template <class Epi, class Sched, bool STAMP = false>
__device__ __forceinline__ void gemm_phase(PG8_LAS unsigned char* lds, const Gemm g, const Sched& S, const Epi& E, unsigned long long* stamps) {
    const int tid = otid(), wid = __builtin_amdgcn_readfirstlane(tid >> 6), lane = tid & 63, wr = wid >> 2, wc = wid & 3, fr = lane & 15, fq = lane >> 4;
    const int K = g.K, nt = K / BK;
    int ts_lo = 0, ts_hi = 0, nts = 0; const unsigned long long rt_entry = STAMP ? (unsigned long long)wall_clock64() : 0ull;
#define PG8_STAMP() do { if (STAMP && wid == 0 && nts < 64) { const unsigned long long _c = (unsigned long long)clock64(); \
        ts_lo = (lane == nts) ? (int)(unsigned)_c : ts_lo; ts_hi = (lane == nts) ? (int)(unsigned)(_c >> 32) : ts_hi; ++nts; } } while (0)
    PG8_STAMP();
    unsigned voffA[2], voffB[2];
#pragma unroll
    for (int i = 0; i < 2; ++i) { int R, C; stage_rc(tid * 16 + i * 8192, R, C); const int Rb = Epi::PERM ? ((R & ~31) + perm32(R & 31)) : R;
        voffA[i] = (unsigned)(R * g.lda + C) * 2u; voffB[i] = (unsigned)(Rb * g.ldb + C) * 2u; }
    const size_t kstep = (size_t)(BK * 2);
    const size_t hstepA = (size_t)HALF * g.lda * 2, hstepB = (size_t)HALF * g.ldb * 2;
    const size_t tstepA = 2 * hstepA, tstepB = 2 * hstepB;
    const unsigned ldsw = (unsigned)wid * 1024u;
    const int aoff = lds_byte(wr * 64 + fr, fq * 8), boff = lds_byte(wc * 32 + fr, fq * 8);
#define PG8_SA(b, h) (((b) * 2 + (h)) * HTB)
#define PG8_SB(b, h) ((4 + (b) * 2 + (h)) * HTB)
#define PG8_STAGE(bufoff, gbase, voff) do { _Pragma("unroll") for (int _i = 0; _i < 2; ++_i) \
        __builtin_amdgcn_global_load_lds((const unsigned*)((const char*)(gbase) + (voff)[_i]), (PG8_LAS unsigned*)(lds + (bufoff) + ldsw + _i * 8192), 16, 0, 0); } while (0)
#define PG8_LDA(dst, b, h) do { _Pragma("unroll") for (int m = 0; m < 4; ++m) _Pragma("unroll") for (int k = 0; k < 2; ++k) dst[m][k] = *(const PG8_LAS bf16x8*)(lds + PG8_SA(b, h) + aoff + m * 2048 + k * 1024); } while (0)
#define PG8_LDB(dst, b, h) do { _Pragma("unroll") for (int n = 0; n < 2; ++n) _Pragma("unroll") for (int k = 0; k < 2; ++k) dst[n][k] = *(const PG8_LAS bf16x8*)(lds + PG8_SB(b, h) + boff + n * 2048 + k * 1024); } while (0)
#define PG8_MMA(ai, bj, At, Bt) do { __builtin_amdgcn_s_setprio(1); _Pragma("unroll") for (int m = 0; m < 4; ++m) _Pragma("unroll") for (int n = 0; n < 2; ++n) _Pragma("unroll") for (int k = 0; k < 2; ++k) \
        acc[ai][bj][m][n] = __builtin_amdgcn_mfma_f32_16x16x32_bf16(Bt[n][k], At[m][k], acc[ai][bj][m][n], 0, 0, 0); __builtin_amdgcn_s_setprio(0); } while (0)
#define PG8_WAIT_V(n) asm volatile("s_waitcnt vmcnt(" #n ")" ::: "memory")
#define PG8_WAIT_L(n) asm volatile("s_waitcnt lgkmcnt(" #n ")" ::: "memory")
#define PG8_BAR __builtin_amdgcn_s_barrier()
#define PG8_SCHED __builtin_amdgcn_sched_barrier(0)
    Unit cur, nxt; int ui = 0;
    if (!S.next(0, cur)) return;
    f32x4 acc[2][2][4][2];
#pragma unroll
    for (int a = 0; a < 2; ++a)
#pragma unroll
        for (int b = 0; b < 2; ++b)
#pragma unroll
            for (int m = 0; m < 4; ++m)
#pragma unroll
                for (int n = 0; n < 2; ++n) acc[a][b][m][n] = (f32x4){0.f, 0.f, 0.f, 0.f};
    bf16x8 At[4][2], B0[2][2], B1[2][2];
    const char* cA = (const char*)(cur.sel ? g.A2 : g.A) + (size_t)cur.pm * tstepA; const char* cB = (const char*)(cur.sel ? g.Bt2 : g.Bt) + (size_t)cur.pn * tstepB;
    S.a_ready(cur);
    PG8_STAGE(PG8_SB(0, 0), cB, voffB); PG8_STAGE(PG8_SA(0, 0), cA, voffA); PG8_STAGE(PG8_SB(0, 1), cB + hstepB, voffB); PG8_STAGE(PG8_SA(0, 1), cA + hstepA, voffA);
    if (wr == 1) PG8_BAR;
    PG8_WAIT_V(4); PG8_BAR;
    PG8_STAGE(PG8_SB(1, 0), cB + kstep, voffB); PG8_STAGE(PG8_SA(1, 0), cA + kstep, voffA); PG8_STAGE(PG8_SB(1, 1), cB + hstepB + kstep, voffB);
    PG8_WAIT_V(6); PG8_BAR;
    PG8_STAMP();
    for (;;) {
        const bool has_next = S.next(ui + 1, nxt);
        const char* nA = has_next ? (const char*)(nxt.sel ? g.A2 : g.A) + (size_t)nxt.pm * tstepA : cA; const char* nB = has_next ? (const char*)(nxt.sel ? g.Bt2 : g.Bt) + (size_t)nxt.pn * tstepB : cB;
        for (int t = 0; t < nt; t += 2) {
            const bool last = (t == nt - 2);
            const char* a1 = cA + (size_t)(t + 1) * kstep;
            const char* a2 = last ? nA : cA + (size_t)(t + 2) * kstep; const char* b2 = last ? nB : cB + (size_t)(t + 2) * kstep;
            const char* a3 = a2 + kstep; const char* b3 = b2 + kstep;
            if (last && has_next) S.a_ready(nxt);
            PG8_LDB(B0, 0, 0); PG8_SCHED; PG8_LDA(At, 0, 0); PG8_STAGE(PG8_SA(1, 1), a1 + hstepA, voffA);
            PG8_WAIT_L(8); PG8_BAR; PG8_WAIT_L(0); PG8_MMA(0, 0, At, B0); PG8_BAR; PG8_SCHED;
            PG8_LDB(B1, 0, 1); PG8_STAGE(PG8_SB(0, 0), b2, voffB);
            PG8_BAR; PG8_WAIT_L(0); PG8_MMA(0, 1, At, B1); PG8_BAR;
            PG8_LDA(At, 0, 1); PG8_STAGE(PG8_SA(0, 0), a2, voffA);
            PG8_BAR; PG8_WAIT_L(0); PG8_MMA(1, 0, At, B0); PG8_BAR; PG8_SCHED;
            PG8_STAGE(PG8_SB(0, 1), b2 + hstepB, voffB);
            PG8_WAIT_V(6); PG8_BAR; PG8_MMA(1, 1, At, B1); PG8_BAR;
            PG8_LDB(B0, 1, 0); PG8_SCHED; PG8_LDA(At, 1, 0); PG8_STAGE(PG8_SA(0, 1), a2 + hstepA, voffA);
            PG8_WAIT_L(8); PG8_BAR; PG8_WAIT_L(0); PG8_MMA(0, 0, At, B0); PG8_BAR; PG8_SCHED;
            PG8_LDB(B1, 1, 1); PG8_STAGE(PG8_SB(1, 0), b3, voffB);
            PG8_BAR; PG8_WAIT_L(0); PG8_MMA(0, 1, At, B1); PG8_BAR;
            PG8_LDA(At, 1, 1); PG8_STAGE(PG8_SA(1, 0), a3, voffA);
            PG8_BAR; PG8_WAIT_L(0); PG8_MMA(1, 0, At, B0); PG8_BAR; PG8_SCHED;
            PG8_STAGE(PG8_SB(1, 1), b3 + hstepB, voffB);
            PG8_WAIT_V(6); PG8_BAR; PG8_MMA(1, 1, At, B1); PG8_BAR;
        }
        PG8_STAMP();
        if constexpr (!Epi::AFTER_DRAIN) { E(acc, cur, wr, wc, fr, fq); S.done(cur); }
        PG8_STAMP();
        if (!has_next) break;
#pragma unroll
        for (int a = 0; a < 2; ++a)
#pragma unroll
            for (int b = 0; b < 2; ++b)
#pragma unroll
                for (int m = 0; m < 4; ++m)
#pragma unroll
                    for (int n = 0; n < 2; ++n) acc[a][b][m][n] = (f32x4){0.f, 0.f, 0.f, 0.f};
        cur = nxt; cA = nA; cB = nB; ++ui;
    }
    PG8_WAIT_V(0);
    if (wr == 0) PG8_BAR;
    PG8_BAR;
    if constexpr (Epi::AFTER_DRAIN) { E.fused(acc, cur, wr, wc, fr, fq, lds, wid, lane); S.done(cur); }
    PG8_STAMP();
    if (STAMP && wid == 0) { stamps[lane] = lane < nts ? (((unsigned long long)(unsigned)ts_hi << 32) | (unsigned)ts_lo) : 0ull;
        if (lane == 62) stamps[62] = rt_entry; if (lane == 63) stamps[63] = (unsigned long long)wall_clock64(); }
#undef PG8_STAMP
#undef PG8_SA
#undef PG8_SB
#undef PG8_STAGE
#undef PG8_LDA
#undef PG8_LDB
#undef PG8_MMA
#undef PG8_WAIT_V
#undef PG8_WAIT_L
#undef PG8_BAR
#undef PG8_SCHED
}
}


typedef unsigned short u16;
typedef short bf16x8 __attribute__((ext_vector_type(8)));
typedef float f32x4 __attribute__((ext_vector_type(4)));
typedef unsigned u32x4 __attribute__((ext_vector_type(4)));
typedef unsigned u32x2 __attribute__((ext_vector_type(2)));
#define LAS __attribute__((address_space(3)))
#define DI __device__ __forceinline__
#define MFMA16(a, b, c) __builtin_amdgcn_mfma_f32_16x16x32_bf16((a), (b), (c), 0, 0, 0)

#define XB_TMO      128
#define XB_XCNT(j)  (256  + 64 * (j))
#define XB_XSUB(j)  (1280 + 64 * (j))
#define XB_XGEN(j)  (2304 + 64 * (j))
#define XB_TOP      3328
#define XB_TOPGEN   3392
#define XCD_BAR_WORDS 3456
#define XB_SPIN_CAP (1u << 18)

__device__ __forceinline__ unsigned xb_ld(unsigned* p)              { return __hip_atomic_load(p, __ATOMIC_RELAXED, __HIP_MEMORY_SCOPE_AGENT); }
__device__ __forceinline__ unsigned xb_add(unsigned* p, unsigned v) { return __hip_atomic_fetch_add(p, v, __ATOMIC_RELAXED, __HIP_MEMORY_SCOPE_AGENT); }
__device__ __forceinline__ unsigned xb_xcc_id() { return (unsigned)__builtin_amdgcn_s_getreg((3 << 11) | 20) & 0xFu; }
#define XB_SPIN(cond, bar) do { unsigned _sp = 0; while (cond) { __builtin_amdgcn_s_sleep(1); \
    if ((++_sp & 255u) == 0u) { if (xb_ld(&(bar)[XB_TMO])) break; if (_sp > XB_SPIN_CAP) { atomicAdd(&(bar)[XB_TMO], 1u); break; } } } } while (0)

struct XcdBarrier {
    unsigned* bar; unsigned x;
    volatile LAS unsigned* st;
};

__device__ __forceinline__ XcdBarrier xcd_barrier_post(unsigned* bar, volatile LAS unsigned* st) {
    XcdBarrier b; b.bar = bar; b.x = xb_xcc_id(); b.st = st;
    if (threadIdx.x == 0) (void)xb_add(&bar[XB_XCNT(b.x)], 1u);
    return b;
}
__device__ __forceinline__ void xcd_barrier_complete(unsigned* bar, unsigned x, unsigned& nloc, unsigned& nx) {
    const unsigned G = gridDim.x * gridDim.y * gridDim.z;
    unsigned sum, cnt, mine, sp = 0u;
    for (;;) {
        sum = 0u; cnt = 0u; mine = 0u;
#pragma unroll
        for (unsigned j = 0; j < 16; ++j) { const unsigned c = xb_ld(&bar[XB_XCNT(j)]); sum += c; cnt += (c > 0u) ? 1u : 0u; mine = (j == x) ? c : mine; }
        if (sum == G) break;
        __builtin_amdgcn_s_sleep(1);
        if ((++sp & 255u) == 0u) { if (xb_ld(&bar[XB_TMO])) break; if (sp > XB_SPIN_CAP) { atomicAdd(&bar[XB_TMO], 1u); break; } }
    }
    nloc = mine > 0u ? mine : 1u; nx = cnt > 0u ? cnt : 1u;
}

__device__ __forceinline__ void xcd_barrier(const XcdBarrier& b) {
    asm volatile("s_waitcnt vmcnt(0)" ::: "memory");
    __syncthreads();
    if (threadIdx.x == 0) {
        unsigned* bar = b.bar;
        __builtin_amdgcn_s_waitcnt(0);
        unsigned nloc = b.st[0], nx = b.st[1];
        if (nloc == 0u) { xcd_barrier_complete(bar, b.x, nloc, nx); b.st[0] = nloc; b.st[1] = nx; }
        const unsigned old = xb_add(&bar[XB_XSUB(b.x)], 1u);
        const unsigned gen = old / nloc;
        if (old + 1u == (gen + 1u) * nloc) {
            __builtin_amdgcn_fence(__ATOMIC_RELEASE, "agent");
            asm volatile("s_waitcnt vmcnt(0)" ::: "memory");
            const unsigned og = xb_add(&bar[XB_TOP], 1u);
            const unsigned tg = og / nx;
            if (og + 1u == (tg + 1u) * nx) xb_add(&bar[XB_TOPGEN], 1u);
            else XB_SPIN(xb_ld(&bar[XB_TOPGEN]) == tg, bar);
            __builtin_amdgcn_fence(__ATOMIC_ACQUIRE, "agent");
            xb_add(&bar[XB_XGEN(b.x)], 1u);
            asm volatile("s_waitcnt vmcnt(0)" ::: "memory");
        } else {
            XB_SPIN(xb_ld(&bar[XB_XGEN(b.x)]) == gen, bar);
            __builtin_amdgcn_fence(__ATOMIC_ACQUIRE, "agent");
            asm volatile("s_waitcnt vmcnt(0)" ::: "memory");
        }
    }
    __syncthreads();
}


constexpr int NP = 16384, NS = 128, NR = 16512, MP = 16640;
constexpr int ZLD = 5632, FF = 2816, N1 = 7936;
constexpr int ZQ = 0, ZK = 1024, ZV = 2048, ZG = 3072, ZSQ = 4096, ZSK = 5120, ZSV = 5376;
constexpr float EPS = 1e-6f;
constexpr size_t WS_RA = 0;
constexpr size_t WS_WA = WS_RA + 16777216;
constexpr size_t WS_WB = WS_WA + 2097152;
constexpr size_t WS_WO = WS_WB + 2097152;
constexpr size_t WS_WG = WS_WO + 2097152;
constexpr size_t WS_WU = WS_WG + 5767168;
constexpr size_t WS_WD = WS_WU + 5767168;
constexpr size_t WS_MOD = WS_WD + 5767168;
constexpr size_t WS_ZB = WS_MOD + 3342336;
constexpr size_t WS_HALO = WS_ZB + 1064960;
constexpr size_t WS_LAST = WS_HALO + 4718592;
constexpr size_t WS_H = WS_LAST + 8192;
constexpr size_t WS_Z = WS_H + 34078720;
constexpr size_t WS_BAR = WS_Z + 187432960;
constexpr size_t WS_END = WS_BAR + 16384;
constexpr size_t OFF_YS = 16777216, OFF_GSP = 16908288, OFF_GSS = 17956864, OFF_GCP = 34734080, OFF_GCS = 34807808, OFF_KP = 35987456,
                 OFF_KS = 36249600, OFF_VP = 40443904, OFF_VS = 40706048, OFF_FP = 44900352, OFF_FS = 44945408;
constexpr int LDS_BYTES = 155648, LDS_XB = 155632;

struct Args { const float* in[28]; float* out; unsigned char* ws; };

typedef __bf16 bf16x2_t __attribute__((ext_vector_type(2)));
typedef float f32x2_t __attribute__((ext_vector_type(2)));
DI unsigned pack2(float a, float b) { f32x2_t v = {a, b}; bf16x2_t r = __builtin_convertvector(v, bf16x2_t); return __builtin_bit_cast(unsigned, r); }
DI u16 f2bf(float f) { return (u16)(pack2(f, 0.f) & 0xFFFFu); }
DI float bf2f(u16 b) { return __uint_as_float(((unsigned)b) << 16); }
DI float bflo(unsigned w) { return __uint_as_float(w << 16); }
DI float bfhi(unsigned w) { return __uint_as_float(w & 0xFFFF0000u); }
DI float sigm(float x) { return __builtin_amdgcn_rcpf(1.f + __expf(-x)); }
DI float silu(float x) { return x * __builtin_amdgcn_rcpf(1.f + __expf(-x)); }
#define DPP_F(v, ctrl) __builtin_bit_cast(float, __builtin_amdgcn_update_dpp(0, __builtin_bit_cast(int, (v)), (ctrl), 0xF, 0xF, false))
DI float row_sum16(float v) { v += DPP_F(v, 0x128); v += DPP_F(v, 0x124); v += DPP_F(v, 0x122); v += DPP_F(v, 0x121); return v; }
DI float row_max16(float v) { v = fmaxf(v, DPP_F(v, 0x128)); v = fmaxf(v, DPP_F(v, 0x124)); v = fmaxf(v, DPP_F(v, 0x122)); v = fmaxf(v, DPP_F(v, 0x121)); return v; }
DI float softplus(float x) { return x > 20.f ? x : log1pf(__expf(x)); }
DI f32x4 zero4() { return (f32x4){0.f, 0.f, 0.f, 0.f}; }
DI u32x4 pack8(f32x4 a, f32x4 b) { u32x4 w; w.x = pack2(a[0], a[1]); w.y = pack2(a[2], a[3]); w.z = pack2(b[0], b[1]); w.w = pack2(b[2], b[3]); return w; }
DI int row_bidx(int row) { return row < NP ? (row >> 11) : 8 + row - NP; }

struct EpiZ {
    static constexpr bool PERM = true, AFTER_DRAIN = false;
    u16* z; u16* gab; float* zb; u16* halo;
    DI void operator()(const f32x4 (&acc)[2][2][4][2], const pg8::Unit& u, int wr, int wc, int fr, int fq) const {
        const int row0 = u.pm * 256 + wr * 64 + fr;
        if (u.pn < 22) {
            const int col0 = u.pn * 256 + wc * 32 + 8 * fq;
            const bool gatecols = (u.pn >= 12) && (u.pn < 16);
#pragma unroll
            for (int ai = 0; ai < 2; ++ai)
#pragma unroll
                for (int m = 0; m < 4; ++m) {
                    const int row = row0 + ai * 128 + m * 16;
                    u16* rowp = z + (size_t)row * ZLD + col0;
                    const bool hal = (u.pn < 12) && (row < NP) && ((row & 63) >= 61);
#pragma unroll
                    for (int bj = 0; bj < 2; ++bj) {
                        f32x4 v0 = acc[ai][bj][m][0], v1 = acc[ai][bj][m][1];
                        if (gatecols) {
#pragma unroll
                            for (int j = 0; j < 4; ++j) { v0[j] = silu(v0[j]); v1[j] = silu(v1[j]); }
                        }
                        const u32x4 w = pack8(v0, v1);
                        __builtin_nontemporal_store(w, (u32x4*)(rowp + bj * 128));
                        if (hal) *(u32x4*)(halo + ((size_t)(row >> 6) * 3 + ((row & 63) - 61)) * 3072 + col0 + bj * 128) = w;
                    }
                }
        } else if (u.pn < 30) {
            const int col0 = (u.pn - 22) * 256 + wc * 32 + 8 * fq;
#pragma unroll
            for (int ai = 0; ai < 2; ++ai)
#pragma unroll
                for (int m = 0; m < 4; ++m) {
                    const int row = row0 + ai * 128 + m * 16;
                    if (row < NR) {
                        u16* rowp = gab + (size_t)row * 2048 + col0;
#pragma unroll
                        for (int bj = 0; bj < 2; ++bj) *(u32x4*)(rowp + bj * 128) = pack8(acc[ai][bj][m][0], acc[ai][bj][m][1]);
                    }
                }
        } else if (wc == 0 && fq < 2) {
#pragma unroll
            for (int ai = 0; ai < 2; ++ai)
#pragma unroll
                for (int m = 0; m < 4; ++m) {
                    const int row = row0 + ai * 128 + m * 16;
#pragma unroll
                    for (int n = 0; n < 2; ++n) *(f32x4*)(zb + (size_t)row * 16 + 8 * fq + 4 * n) = acc[ai][0][m][n];
                }
        }
    }
};
template <int WHICH> struct EpiMix {
    static constexpr bool PERM = true, AFTER_DRAIN = false;
    u16* mix; const u16* gab;
    DI void operator()(const f32x4 (&acc)[2][2][4][2], const pg8::Unit& u, int wr, int wc, int fr, int fq) const {
        const int row0 = u.pm * 256 + wr * 64 + fr, col0 = u.pn * 256 + wc * 32 + 8 * fq;
#pragma unroll
        for (int ai = 0; ai < 2; ++ai)
#pragma unroll
            for (int mp = 0; mp < 4; mp += 2) {
                u32x4 gv[2][2], pv[2][2];
#pragma unroll
                for (int mm = 0; mm < 2; ++mm) {
                    const int row = row0 + ai * 128 + (mp + mm) * 16;
#pragma unroll
                    for (int bj = 0; bj < 2; ++bj) {
                        gv[mm][bj] = (u32x4){0u, 0u, 0u, 0u}; pv[mm][bj] = gv[mm][bj];
                        if (row < NR) gv[mm][bj] = *(const u32x4*)(gab + (size_t)row * 2048 + WHICH * 1024 + col0 + bj * 128);
                        if (WHICH == 1) pv[mm][bj] = *(const u32x4*)(mix + (size_t)row * 1024 + col0 + bj * 128);
                    }
                }
#pragma unroll
                for (int mm = 0; mm < 2; ++mm) {
                    const int row = row0 + ai * 128 + (mp + mm) * 16;
#pragma unroll
                    for (int bj = 0; bj < 2; ++bj) {
                        const u32x4 g_ = gv[mm][bj], p_ = pv[mm][bj];
                        f32x4 a0 = acc[ai][bj][mp + mm][0], a1 = acc[ai][bj][mp + mm][1];
                        a0[0] *= sigm(bflo(g_.x)); a0[1] *= sigm(bfhi(g_.x)); a0[2] *= sigm(bflo(g_.y)); a0[3] *= sigm(bfhi(g_.y));
                        a1[0] *= sigm(bflo(g_.z)); a1[1] *= sigm(bfhi(g_.z)); a1[2] *= sigm(bflo(g_.w)); a1[3] *= sigm(bfhi(g_.w));
                        if (WHICH == 1) {
                            a0[0] += bflo(p_.x); a0[1] += bfhi(p_.x); a0[2] += bflo(p_.y); a0[3] += bfhi(p_.y);
                            a1[0] += bflo(p_.z); a1[1] += bfhi(p_.z); a1[2] += bflo(p_.w); a1[3] += bfhi(p_.w);
                        }
                        *(u32x4*)(mix + (size_t)row * 1024 + col0 + bj * 128) = pack8(a0, a1);
                    }
                }
            }
    }
};
template <int WHICH> struct EpiRes {
    static constexpr bool PERM = false, AFTER_DRAIN = false;
    float* out; const float* xp; const float* xs; const float* mod; u16* xh;
    DI void operator()(const f32x4 (&acc)[2][2][4][2], const pg8::Unit& u, int wr, int wc, int fr, int fq) const {
        const int row0 = u.pm * 256 + wr * 64 + fr, col0 = u.pn * 256 + wc * 32 + 4 * fq;
        constexpr int GOFF = WHICH ? 5120 : 2048;
        if (u.pm < 64) {
            f32x4 gtv[2][2];
            const float* gt = mod + (size_t)(u.pm >> 3) * 6144 + GOFF + col0;
#pragma unroll
            for (int bj = 0; bj < 2; ++bj)
#pragma unroll
                for (int n = 0; n < 2; ++n) gtv[bj][n] = *(const f32x4*)(gt + bj * 128 + n * 16);
#pragma unroll
            for (int ai = 0; ai < 2; ++ai)
#pragma unroll
                for (int mp = 0; mp < 4; mp += 2) {
                    f32x4 xv[2][2][2];
#pragma unroll
                    for (int mm = 0; mm < 2; ++mm) {
                        const size_t ro = (size_t)(row0 + ai * 128 + (mp + mm) * 16) * 1024 + col0;
                        const float* xr = xp + ro; const u16* xb = (const u16*)out + ro;
#pragma unroll
                        for (int bj = 0; bj < 2; ++bj)
#pragma unroll
                            for (int n = 0; n < 2; ++n) {
                                if (WHICH) { const u32x2 q_ = *(const u32x2*)(xb + bj * 128 + n * 16); xv[mm][bj][n] = (f32x4){bflo(q_.x), bfhi(q_.x), bflo(q_.y), bfhi(q_.y)}; }
                                else xv[mm][bj][n] = *(const f32x4*)(xr + bj * 128 + n * 16);
                            }
                    }
#pragma unroll
                    for (int mm = 0; mm < 2; ++mm) {
                        float* op = out + (size_t)(row0 + ai * 128 + (mp + mm) * 16) * 1024 + col0;
#pragma unroll
                        for (int bj = 0; bj < 2; ++bj)
#pragma unroll
                            for (int n = 0; n < 2; ++n) {
                                const f32x4 r_ = xv[mm][bj][n] + gtv[bj][n] * acc[ai][bj][mp + mm][n];
                                if (WHICH) *(u32x2*)(xh + (size_t)(row0 + ai * 128 + (mp + mm) * 16) * 1024 + col0 + bj * 128 + n * 16) = (u32x2){pack2(r_[0], r_[1]), pack2(r_[2], r_[3])};
                                else *(u32x2*)((u16*)out + (size_t)(row0 + ai * 128 + (mp + mm) * 16) * 1024 + col0 + bj * 128 + n * 16) = (u32x2){pack2(r_[0], r_[1]), pack2(r_[2], r_[3])};
                            }
                    }
                }
        } else {
#pragma unroll
            for (int ai = 0; ai < 2; ++ai)
#pragma unroll
                for (int m = 0; m < 4; ++m) {
                    const int row = row0 + ai * 128 + m * 16;
                    if (row < NR) {
                        float* op = out + (size_t)row * 1024 + col0;
                        const float* xr = WHICH ? op : (xs + (size_t)(row - NP) * 1024 + col0);
                        const float* gt = mod + (size_t)row_bidx(row) * 6144 + GOFF + col0;
                        f32x4 xv[2][2], gv[2][2];
#pragma unroll
                        for (int bj = 0; bj < 2; ++bj)
#pragma unroll
                            for (int n = 0; n < 2; ++n) { xv[bj][n] = *(const f32x4*)(xr + bj * 128 + n * 16); gv[bj][n] = *(const f32x4*)(gt + bj * 128 + n * 16); }
#pragma unroll
                        for (int bj = 0; bj < 2; ++bj)
#pragma unroll
                            for (int n = 0; n < 2; ++n) {
                                const f32x4 r_ = xv[bj][n] + gv[bj][n] * acc[ai][bj][m][n];
                                if (WHICH) *(u32x2*)(xh + (size_t)row * 1024 + col0 + bj * 128 + n * 16) = (u32x2){pack2(r_[0], r_[1]), pack2(r_[2], r_[3])};
                                else *(f32x4*)(op + bj * 128 + n * 16) = r_;
                            }
                    }
                }
        }
    }
};
struct EpiPlain {
    static constexpr bool PERM = true, AFTER_DRAIN = false;
    u16* o; int ld;
    DI void operator()(const f32x4 (&acc)[2][2][4][2], const pg8::Unit& u, int wr, int wc, int fr, int fq) const {
        const int row0 = u.pm * 256 + wr * 64 + fr, col0 = u.pn * 256 + wc * 32 + 8 * fq;
#pragma unroll
        for (int ai = 0; ai < 2; ++ai)
#pragma unroll
            for (int m = 0; m < 4; ++m) {
                u16* rowp = o + (size_t)(row0 + ai * 128 + m * 16) * ld + col0;
#pragma unroll
                for (int bj = 0; bj < 2; ++bj) *(u32x4*)(rowp + bj * 128) = pack8(acc[ai][bj][m][0], acc[ai][bj][m][1]);
            }
    }
};
struct EpiAct {
    static constexpr bool PERM = true, AFTER_DRAIN = false;
    u16* act; const u16* gate; const float* cw; const float* cb; const float* sf; float* out;
    DI void finish(const float (&f0)[8], const float (&f1)[8], const float (&f2)[8], const f32x4 (&w)[8], const f32x4 a0, const f32x4 a1, u16* dst) const {
        float r[8];
#pragma unroll
        for (int j = 0; j < 8; ++j) {
            const float gc = w[(j >> 2)][j & 3] * f2[j] + w[2 + (j >> 2)][j & 3] * f1[j] + w[4 + (j >> 2)][j & 3] * f0[j] + w[6 + (j >> 2)][j & 3];
            r[j] = silu(gc) * (j < 4 ? a0[j & 3] : a1[j & 3]);
        }
        *(u32x4*)dst = (u32x4){pack2(r[0], r[1]), pack2(r[2], r[3]), pack2(r[4], r[5]), pack2(r[6], r[7])};
    }
    DI void operator()(const f32x4 (&acc)[2][2][4][2], const pg8::Unit& u, int wr, int wc, int fr, int fq) const {
        const int row0 = u.pm * 256 + wr * 64 + fr, col0 = u.pn * 256 + wc * 32 + 8 * fq;
#pragma unroll
        for (int bj = 0; bj < 2; ++bj) {
            const int c = col0 + bj * 128;
            f32x4 w[8];
#pragma unroll
            for (int q = 0; q < 3; ++q) { w[2 * q] = *(const f32x4*)(cw + q * FF + c); w[2 * q + 1] = *(const f32x4*)(cw + q * FF + c + 4); }
            w[6] = *(const f32x4*)(cb + c); w[7] = *(const f32x4*)(cb + c + 4);
            if (u.pm < 64) {
#pragma unroll
                for (int ai = 0; ai < 2; ++ai)
#pragma unroll
                    for (int mp = 0; mp < 4; mp += 2) {
                        u32x4 g0[2], g1[2], g2[2];
#pragma unroll
                        for (int mm = 0; mm < 2; ++mm) {
                            const int row = row0 + ai * 128 + (mp + mm) * 16, t = row & 2047;
                            const u16* gp = gate + (size_t)row * FF + c;
                            g0[mm] = *(const u32x4*)gp;
                            g1[mm] = (t >= 1) ? *(const u32x4*)(gp - FF) : (u32x4){0u, 0u, 0u, 0u};
                            g2[mm] = (t >= 2) ? *(const u32x4*)(gp - 2 * FF) : (u32x4){0u, 0u, 0u, 0u};
                        }
#pragma unroll
                        for (int mm = 0; mm < 2; ++mm) {
                            const int row = row0 + ai * 128 + (mp + mm) * 16, t = row & 2047;
                            float f0[8], f1[8], f2[8];
                            f0[0] = bflo(g0[mm].x); f0[1] = bfhi(g0[mm].x); f0[2] = bflo(g0[mm].y); f0[3] = bfhi(g0[mm].y); f0[4] = bflo(g0[mm].z); f0[5] = bfhi(g0[mm].z); f0[6] = bflo(g0[mm].w); f0[7] = bfhi(g0[mm].w);
                            f1[0] = bflo(g1[mm].x); f1[1] = bfhi(g1[mm].x); f1[2] = bflo(g1[mm].y); f1[3] = bfhi(g1[mm].y); f1[4] = bflo(g1[mm].z); f1[5] = bfhi(g1[mm].z); f1[6] = bflo(g1[mm].w); f1[7] = bfhi(g1[mm].w);
                            f2[0] = bflo(g2[mm].x); f2[1] = bfhi(g2[mm].x); f2[2] = bflo(g2[mm].y); f2[3] = bfhi(g2[mm].y); f2[4] = bflo(g2[mm].z); f2[5] = bfhi(g2[mm].z); f2[6] = bflo(g2[mm].w); f2[7] = bfhi(g2[mm].w);
                            if (t >= 2046) { float* fp = out + OFF_FP + ((size_t)(row >> 11) * 2 + (t - 2046)) * FF + c;
                                *(f32x4*)fp = (f32x4){f0[0], f0[1], f0[2], f0[3]}; *(f32x4*)(fp + 4) = (f32x4){f0[4], f0[5], f0[6], f0[7]}; }
                            finish(f0, f1, f2, w, acc[ai][bj][mp + mm][0], acc[ai][bj][mp + mm][1], act + (size_t)row * FF + c);
                        }
                    }
            } else {
#pragma unroll
                for (int ai = 0; ai < 2; ++ai)
#pragma unroll
                    for (int m = 0; m < 4; ++m) {
                        const int row = row0 + ai * 128 + m * 16;
                        if (row >= NR) continue;
                        float f0[8], f1[8], f2[8];
                        const u32x4 g0 = *(const u32x4*)(gate + (size_t)row * FF + c);
                        f0[0] = bflo(g0.x); f0[1] = bfhi(g0.x); f0[2] = bflo(g0.y); f0[3] = bfhi(g0.y); f0[4] = bflo(g0.z); f0[5] = bfhi(g0.z); f0[6] = bflo(g0.w); f0[7] = bfhi(g0.w);
                        const float* sp = sf + (size_t)(row - NP) * 2 * FF + c;
                        const f32x4 p0 = *(const f32x4*)sp, p1 = *(const f32x4*)(sp + 4), q0 = *(const f32x4*)(sp + FF), q1 = *(const f32x4*)(sp + FF + 4);
#pragma unroll
                        for (int j = 0; j < 4; ++j) { f2[j] = p0[j]; f2[4 + j] = p1[j]; f1[j] = q0[j]; f1[4 + j] = q1[j]; }
                        float* fp = out + OFF_FS + (size_t)(row - NP) * 2 * FF + c;
                        *(f32x4*)fp = q0; *(f32x4*)(fp + 4) = q1;
                        *(f32x4*)(fp + FF) = (f32x4){f0[0], f0[1], f0[2], f0[3]}; *(f32x4*)(fp + FF + 4) = (f32x4){f0[4], f0[5], f0[6], f0[7]};
                        finish(f0, f1, f2, w, acc[ai][bj][m][0], acc[ai][bj][m][1], act + (size_t)row * FF + c);
                    }
            }
        }
    }
};
struct MixOrder {
    pg8::StaticOrder base;
    DI bool next(int i, pg8::Unit& u) const { if (!base.next(i >> 1, u)) return false; u.sel = i & 1; return true; }
    DI void a_ready(const pg8::Unit&) const {}
    DI void done(const pg8::Unit&) const {}
};
struct EpiMixBoth {
    static constexpr bool PERM = true, AFTER_DRAIN = false;
    EpiMix<0> e0; EpiMix<1> e1;
    DI void operator()(const f32x4 (&acc)[2][2][4][2], const pg8::Unit& u, int wr, int wc, int fr, int fq) const { if (u.sel) e1(acc, u, wr, wc, fr, fq); else e0(acc, u, wr, wc, fr, fq); }
};
template <class Epi> DI void run_gemm(LAS unsigned char* lds, const u16* A, int lda, const u16* Bt, int ldb, int M, int N, int K, const Epi& E) {
    pg8::Gemm g; g.A = A; g.Bt = Bt; g.M = M; g.N = N; g.K = K; g.lda = lda; g.ldb = ldb;
    pg8::StaticOrder S; S.init(M, N, (int)gridDim.x, (int)blockIdx.x);
    pg8::gemm_phase<Epi, pg8::StaticOrder, false>((PG8_LAS unsigned char*)lds, g, S, E, nullptr);
}

DI f32x4 skinny_part(const u16* A, int lda, const u16* Bt, int ldb, int K, int mt, int nt) {
    const int lane = otid() & 63, wid = otid() >> 6, r16 = lane & 15, g = lane >> 4;
    const int ks = K >> 3;
    const u16* ap = A + (size_t)(16 * mt + r16) * lda + wid * ks + g * 8;
    const u16* bp = Bt + (size_t)(16 * nt + r16) * ldb + wid * ks + g * 8;
    f32x4 c = zero4();
#pragma unroll 11
    for (int k = 0; k < ks; k += 32) c = MFMA16(*(const bf16x8*)(ap + k), *(const bf16x8*)(bp + k), c);
    return c;
}
template <int WHICH> DI void skinny_phase(const Args& a, LAS unsigned char* lds) {
    const int tid = otid(), lane = tid & 63, wid = tid >> 6;
    LAS float* red = (LAS float*)lds;
    const u16* Z = (const u16*)(a.ws + WS_Z);
    for (int t = blockIdx.x; t < 512; t += gridDim.x) {
        const int mt = t & 7, nt = t >> 3;
        f32x4 c0, c1 = zero4();
        if (WHICH == 0) { c0 = skinny_part(Z + (size_t)NP * ZLD + ZG, ZLD, (const u16*)(a.ws + WS_WA), 1024, 1024, mt, nt); c1 = skinny_part(Z + (size_t)NP * ZLD + ZSQ, ZLD, (const u16*)(a.ws + WS_WB), 1024, 1024, mt, nt); }
        else if (WHICH == 1) c0 = skinny_part((const u16*)(a.ws + WS_H) + (size_t)NP * 1024, 1024, (const u16*)(a.ws + WS_WO), 1024, 1024, mt, nt);
        else c0 = skinny_part(Z + (size_t)MP * FF + (size_t)NP * FF, FF, (const u16*)(a.ws + WS_WD), FF, FF, mt, nt);
        *(LAS f32x4*)(red + (wid * 64 + lane) * 4) = c0;
        if (WHICH == 0) *(LAS f32x4*)(red + 2048 + (wid * 64 + lane) * 4) = c1;
        __syncthreads();
        if (tid < 256) {
            const int l = tid >> 2, i = tid & 3, row = 16 * mt + 4 * (l >> 4) + i, col = 16 * nt + (l & 15);
            float s0 = 0.f, s1 = 0.f;
#pragma unroll
            for (int w = 0; w < 8; ++w) { s0 += red[w * 256 + tid]; if (WHICH == 0) s1 += red[2048 + w * 256 + tid]; }
            if (WHICH == 0) {
                const u16* gab = (const u16*)a.out + (size_t)(NP + row) * 2048;
                ((u16*)(a.ws + WS_H))[(size_t)(NP + row) * 1024 + col] = f2bf(sigm(bf2f(gab[col])) * s0 + sigm(bf2f(gab[1024 + col])) * s1);
            } else {
                float* op = a.out + (size_t)(NP + row) * 1024 + col;
                u16* x1p = (u16*)a.out + (size_t)(NP + row) * 1024 + col;
                const float base = (WHICH == 2) ? bf2f(*x1p) : a.in[1][(size_t)row * 1024 + col];
                const float r_ = base + ((const float*)(a.ws + WS_MOD))[(size_t)(8 + row) * 6144 + (WHICH == 2 ? 5120 : 2048) + col] * s0;
                if (WHICH == 2) ((u16*)(a.ws + WS_H))[(size_t)(NP + row) * 1024 + col] = f2bf(r_); else *x1p = f2bf(r_);
            }
        }
        __syncthreads();
    }
}

DI void convert_weights(const Args& a, LAS unsigned char* lds, int tlo, int thi, int v, int nv);
DI void phase0(const Args& a, LAS unsigned char* lds) {
    const int tid = otid(), lane = tid & 63, wid = tid >> 6, r16 = lane & 15, g = lane >> 4;
    float* mod = (float*)(a.ws + WS_MOD);
    const float* wmod = a.in[9]; const float* bmod = a.in[10];
    LAS float* red = (LAS float*)lds;
    for (int task = blockIdx.x; task < 192; task += gridDim.x) {
        const int n0 = task * 32;
        f32x4 acc[2][9];
#pragma unroll
        for (int t = 0; t < 2; ++t)
#pragma unroll
            for (int mt = 0; mt < 9; ++mt) acc[t][mt] = zero4();
#pragma unroll 1
        for (int ks = 0; ks < 4; ++ks) {
            const int k0 = wid * 128 + ks * 32 + g * 8;
            bf16x8 bfr0, bfr1;
#pragma unroll
            for (int j = 0; j < 8; ++j) { const float* wp = wmod + (size_t)(k0 + j) * 6144 + n0 + r16; bfr0[j] = (short)f2bf(wp[0]); bfr1[j] = (short)f2bf(wp[16]); }
#pragma unroll
            for (int mt = 0; mt < 9; ++mt) {
                const int r = mt * 16 + r16;
                bf16x8 af = (bf16x8){0, 0, 0, 0, 0, 0, 0, 0};
                if (r < 136) {
                    const float* cp = (r < 8 ? a.in[2] + r * 1024 : a.in[3] + (r - 8) * 1024) + k0;
                    const f32x4 v0 = *(const f32x4*)cp, v1 = *(const f32x4*)(cp + 4);
#pragma unroll
                    for (int j = 0; j < 4; ++j) { af[j] = (short)f2bf(silu(v0[j])); af[4 + j] = (short)f2bf(silu(v1[j])); }
                }
                acc[0][mt] = MFMA16(af, bfr0, acc[0][mt]);
                acc[1][mt] = MFMA16(af, bfr1, acc[1][mt]);
            }
        }
#pragma unroll
        for (int t = 0; t < 2; ++t) {
#pragma unroll
            for (int mt = 0; mt < 9; ++mt) *(LAS f32x4*)(red + ((wid * 9 + mt) * 64 + lane) * 4) = acc[t][mt];
            __syncthreads();
            for (int idx = tid; idx < 2304; idx += 512) {
                const int mt = idx >> 8, rem = idx & 255, l = rem >> 2, i = rem & 3;
                float s = 0.f;
#pragma unroll
                for (int w = 0; w < 8; ++w) s += red[((w * 9 + mt) * 64 + l) * 4 + i];
                const int row = mt * 16 + 4 * (l >> 4) + i, col = n0 + 16 * t + (l & 15);
                if (row < 136) mod[(size_t)row * 6144 + col] = s + bmod[col];
            }
            __syncthreads();
        }
    }
    convert_weights(a, lds, 0, 4864, blockIdx.x, gridDim.x);
}
DI void convert_weights(const Args& a, LAS unsigned char* lds, int tlo, int thi, int v, int nv) {
    const int tid = otid();
    LAS u16* T = (LAS u16*)lds;
    for (int t0 = tlo + v * 4; t0 < thi; t0 += nv * 4) {
        f32x4 v0[4], v1[4]; u16* dstp[4];
#pragma unroll
        for (int q = 0; q < 4; ++q) {
            const int t = t0 + q;
            const float* src; u16* dst; int ldsrc, K, tl = t, mode = 0;
            if (tl < 1984) { src = a.in[13]; ldsrc = 7696; K = 1024; dst = (u16*)(a.ws + WS_RA); mode = 1; }
            else if ((tl -= 1984) < 256) { src = a.in[18]; ldsrc = 1024; K = 1024; dst = (u16*)(a.ws + WS_WA); }
            else if ((tl -= 256) < 256) { src = a.in[20]; ldsrc = 1024; K = 1024; dst = (u16*)(a.ws + WS_WB); }
            else if ((tl -= 256) < 256) { src = a.in[21]; ldsrc = 1024; K = 1024; dst = (u16*)(a.ws + WS_WO); }
            else if ((tl -= 256) < 704) { src = a.in[22]; ldsrc = 2816; K = 1024; dst = (u16*)(a.ws + WS_WG); }
            else if ((tl -= 704) < 704) { src = a.in[23]; ldsrc = 2816; K = 1024; dst = (u16*)(a.ws + WS_WU); }
            else { tl -= 704; src = a.in[26]; ldsrc = 1024; K = 2816; dst = (u16*)(a.ws + WS_WD); }
            const int ktiles = K >> 6, nt = tl / ktiles, kt = tl - nt * ktiles, n0 = nt * 64, k0 = kt * 64;
            const int k = tid & 63, n8 = (tid >> 6) * 8, n = n0 + n8;
            int sc = n; bool valid = true;
            if (mode == 1) { if (n < 4096) sc = n; else if (n < 7680) sc = n + 16; else if (n < 7696) sc = 4096 + (n - 7680); else valid = false; }
            v0[q] = zero4(); v1[q] = zero4();
            if (valid) { const float* p = src + (size_t)(k0 + k) * ldsrc + sc; v0[q] = *(const f32x4*)p; v1[q] = *(const f32x4*)(p + 4); }
            dstp[q] = dst + (size_t)(n0 + (tid >> 3)) * K + k0 + (tid & 7) * 8;
        }
#pragma unroll
        for (int q = 0; q < 4; ++q) {
            const int k = tid & 63, n8 = (tid >> 6) * 8;
            LAS u16* Tq = T + q * (64 * 72);
#pragma unroll
            for (int j = 0; j < 4; ++j) { Tq[(n8 + j) * 72 + k] = f2bf(v0[q][j]); Tq[(n8 + 4 + j) * 72 + k] = f2bf(v1[q][j]); }
        }
        __syncthreads();
#pragma unroll
        for (int q = 0; q < 4; ++q) *(u32x4*)dstp[q] = *(LAS u32x4*)(T + q * (64 * 72) + (tid >> 3) * 72 + (tid & 7) * 8);
        __syncthreads();
    }
}

template <int WHICH> DI void phase_norm(const Args& a) {
    const int tid = otid(), lane = tid & 63, gw = blockIdx.x * 8 + (tid >> 6), nw = gridDim.x * 8;
    u16* hb = (u16*)(a.ws + WS_H);
    const float* mod = (const float*)(a.ws + WS_MOD);
    const float* nwt = a.in[WHICH ? 12 : 11];
    f32x4 w[4];
#pragma unroll
    for (int i = 0; i < 4; ++i) w[i] = *(const f32x4*)(nwt + lane * 4 + 256 * i);
    for (int row0 = gw; row0 < MP; row0 += 2 * nw) {
        f32x4 v[2][4];
#pragma unroll
        for (int rr = 0; rr < 2; ++rr) {
            const int row = row0 + rr * nw;
            if (row < NR) {
                const float* xr = (row < NP ? a.in[0] + (size_t)row * 1024 : a.in[1] + (size_t)(row - NP) * 1024);
#pragma unroll
                for (int i = 0; i < 4; ++i) {
                    if (WHICH) { const u32x2 q_ = *(const u32x2*)((const u16*)a.out + (size_t)row * 1024 + lane * 4 + 256 * i); v[rr][i] = (f32x4){bflo(q_.x), bfhi(q_.x), bflo(q_.y), bfhi(q_.y)}; }
                    else v[rr][i] = *(const f32x4*)(xr + lane * 4 + 256 * i);
                }
            } else {
#pragma unroll
                for (int i = 0; i < 4; ++i) v[rr][i] = zero4();
            }
        }
#pragma unroll
        for (int rr = 0; rr < 2; ++rr) {
            const int row = row0 + rr * nw;
            if (row >= MP) continue;
            u16* hp = hb + (size_t)row * 1024;
            if (row >= NR) {
#pragma unroll
                for (int i = 0; i < 4; ++i) *(u32x2*)(hp + lane * 4 + 256 * i) = (u32x2){0u, 0u};
                continue;
            }
            const float* mr = mod + (size_t)row_bidx(row) * 6144 + (WHICH ? 3072 : 0);
            float ss = 0.f;
#pragma unroll
            for (int i = 0; i < 4; ++i) ss += v[rr][i][0] * v[rr][i][0] + v[rr][i][1] * v[rr][i][1] + v[rr][i][2] * v[rr][i][2] + v[rr][i][3] * v[rr][i][3];
            ss = row_sum16(ss); ss += __shfl_xor(ss, 16); ss += __shfl_xor(ss, 32);
            const float rstd = rsqrtf(ss * (1.f / 1024.f) + EPS);
#pragma unroll
            for (int i = 0; i < 4; ++i) {
                const int c = lane * 4 + 256 * i;
                const f32x4 sh = *(const f32x4*)(mr + c), sc = *(const f32x4*)(mr + 1024 + c);
                f32x4 y;
#pragma unroll
                for (int j = 0; j < 4; ++j) y[j] = v[rr][i][j] * rstd * w[i][j] * (1.f + sc[j]) + sh[j];
                *(u32x2*)(hp + c) = (u32x2){pack2(y[0], y[1]), pack2(y[2], y[3])};
            }
        }
    }
}
DI void phase_final(const Args& a) {
    const int tid = otid(), lane = tid & 63, gw = blockIdx.x * 8 + (tid >> 6), nw = gridDim.x * 8;
    const float* fw = a.in[27];
    f32x4 w[4];
#pragma unroll
    for (int i = 0; i < 4; ++i) w[i] = *(const f32x4*)(fw + lane * 4 + 256 * i);
    for (int row0 = gw; row0 < NR; row0 += 2 * nw) {
        f32x4 v[2][4];
#pragma unroll
        for (int rr = 0; rr < 2; ++rr) {
            const int row = row0 + rr * nw;
#pragma unroll
            for (int i = 0; i < 4; ++i) {
                v[rr][i] = zero4();
                if (row < NR) { const u32x2 q_ = *(const u32x2*)((const u16*)(a.ws + WS_H) + (size_t)row * 1024 + lane * 4 + 256 * i); v[rr][i] = (f32x4){bflo(q_.x), bfhi(q_.x), bflo(q_.y), bfhi(q_.y)}; }
            }
        }
#pragma unroll
        for (int rr = 0; rr < 2; ++rr) {
            const int row = row0 + rr * nw;
            if (row >= NR) continue;
            float ss = 0.f;
#pragma unroll
            for (int i = 0; i < 4; ++i) ss += v[rr][i][0] * v[rr][i][0] + v[rr][i][1] * v[rr][i][1] + v[rr][i][2] * v[rr][i][2] + v[rr][i][3] * v[rr][i][3];
            ss = row_sum16(ss); ss += __shfl_xor(ss, 16); ss += __shfl_xor(ss, 32);
            const float rstd = rsqrtf(ss * (1.f / 1024.f) + EPS);
#pragma unroll
            for (int i = 0; i < 4; ++i) __builtin_nontemporal_store(v[rr][i] * rstd * w[i], (f32x4*)(a.out + (size_t)row * 1024 + lane * 4 + 256 * i));
        }
    }
}

DI void unpack8(const u32x4 q, float (&f)[8]) { f[0] = bflo(q.x); f[1] = bfhi(q.x); f[2] = bflo(q.y); f[3] = bfhi(q.y); f[4] = bflo(q.z); f[5] = bfhi(q.z); f[6] = bflo(q.w); f[7] = bfhi(q.w); }
DI void phase_act(const Args& a) {
    const u16* gate = (const u16*)(a.ws + WS_Z);
    u16* up = (u16*)(a.ws + WS_Z) + (size_t)MP * FF;
    const float* cw = a.in[24]; const float* cb = a.in[25]; const float* sf = a.in[8];
    const int nthr = gridDim.x * 512, t0 = blockIdx.x * 512 + otid();
    for (int idx0 = t0; idx0 < NP * 352; idx0 += 2 * nthr) {
        u32x4 gv[2], g1[2], g2[2], uv[2]; int row[2], c[2]; bool ok[2];
#pragma unroll
        for (int q = 0; q < 2; ++q) {
            const int idx = idx0 + q * nthr;
            ok[q] = idx < NP * 352;
            row[q] = ok[q] ? idx / 352 : 0; c[q] = ok[q] ? (idx - row[q] * 352) * 8 : 0;
            const int t = row[q] & 2047;
            const u16* gp = gate + (size_t)row[q] * FF + c[q];
            gv[q] = *(const u32x4*)gp;
            g1[q] = (t >= 1) ? *(const u32x4*)(gp - FF) : (u32x4){0u, 0u, 0u, 0u};
            g2[q] = (t >= 2) ? *(const u32x4*)(gp - 2 * FF) : (u32x4){0u, 0u, 0u, 0u};
            uv[q] = *(const u32x4*)(up + (size_t)row[q] * FF + c[q]);
        }
#pragma unroll
        for (int q = 0; q < 2; ++q) {
            if (!ok[q]) continue;
            float f0[8], f1[8], f2[8], fu[8], r[8];
            unpack8(gv[q], f0); unpack8(g1[q], f1); unpack8(g2[q], f2); unpack8(uv[q], fu);
            const int t = row[q] & 2047;
            if (t >= 2046) { float* fp = a.out + OFF_FP + ((size_t)(row[q] >> 11) * 2 + (t - 2046)) * FF + c[q];
                *(f32x4*)fp = (f32x4){f0[0], f0[1], f0[2], f0[3]}; *(f32x4*)(fp + 4) = (f32x4){f0[4], f0[5], f0[6], f0[7]}; }
            const float* w0 = cw + c[q];
#pragma unroll
            for (int j = 0; j < 8; ++j) r[j] = silu(w0[j] * f2[j] + w0[FF + j] * f1[j] + w0[2 * FF + j] * f0[j] + cb[c[q] + j]) * fu[j];
            *(u32x4*)(up + (size_t)row[q] * FF + c[q]) = (u32x4){pack2(r[0], r[1]), pack2(r[2], r[3]), pack2(r[4], r[5]), pack2(r[6], r[7])};
        }
    }
    for (int idx = t0; idx < NS * 352; idx += nthr) {
        const int b = idx / 352, c = (idx - b * 352) * 8, row = NP + b;
        float f0[8], fu[8], r[8];
        unpack8(*(const u32x4*)(gate + (size_t)row * FF + c), f0);
        u16* upp = up + (size_t)row * FF + c;
        unpack8(*(const u32x4*)upp, fu);
        const float* s0 = sf + ((size_t)b * 2) * FF + c;
        const f32x4 p0 = *(const f32x4*)s0, p1 = *(const f32x4*)(s0 + 4), q0 = *(const f32x4*)(s0 + FF), q1 = *(const f32x4*)(s0 + FF + 4);
        float* fp = a.out + OFF_FS + ((size_t)b * 2) * FF + c;
        *(f32x4*)fp = q0; *(f32x4*)(fp + 4) = q1;
        *(f32x4*)(fp + FF) = (f32x4){f0[0], f0[1], f0[2], f0[3]}; *(f32x4*)(fp + FF + 4) = (f32x4){f0[4], f0[5], f0[6], f0[7]};
        const float* w0 = cw + c;
#pragma unroll
        for (int j = 0; j < 8; ++j) r[j] = silu(w0[j] * (j < 4 ? p0[j & 3] : p1[j & 3]) + w0[FF + j] * (j < 4 ? q0[j & 3] : q1[j & 3]) + w0[2 * FF + j] * f0[j] + cb[c + j]) * fu[j];
        *(u32x4*)upp = (u32x4){pack2(r[0], r[1]), pack2(r[2], r[3]), pack2(r[4], r[5]), pack2(r[6], r[7])};
    }
}

DI void phase_prep(const Args& a, LAS unsigned char* lds) {
    const int tid = otid(), lane = tid & 63, wid = tid >> 6, r16 = lane & 15, g = lane >> 4;
    u16* z = (u16*)(a.ws + WS_Z);
    const float* zb = (const float*)(a.ws + WS_ZB);
    const u16* halo = (const u16*)(a.ws + WS_HALO);
    u16* wbuf = (u16*)(a.ws + WS_H);
    u16* abuf = (u16*)(a.ws + WS_RA);
    float* Mbuf = a.out + OFF_KS;
    float* lastbuf = (float*)(a.ws + WS_LAST);
    const float* cw = a.in[14];
    LAS float* dec = (LAS float*)lds;
    LAS float* bet = dec + 512;
    LAS u16* qn = (LAS u16*)(lds + 4096);
    LAS u16* kn = qn + 64 * 136;
    const int item = blockIdx.x;
    if (item < 256) {
        const int b = item >> 5, ck = item & 31, R0 = b * 2048 + ck * 64;
        {
            const int h = wid;
            const float* zr = zb + (size_t)(R0 + lane) * 16;
            const float be = sigm(zr[h]);
            float s = -__expf(a.in[15][h]) * softplus(zr[8 + h] + a.in[16][h]);
#pragma unroll
            for (int off = 1; off < 64; off <<= 1) { const float t = __shfl_up(s, off); if (lane >= off) s += t; }
            dec[h * 64 + lane] = s; bet[h * 64 + lane] = be;
            if (lane == 63) lastbuf[item * 8 + h] = __expf(s);
        }
        __syncthreads();
#pragma unroll 1
        for (int h = 0; h < 8; ++h) {
            int tok = tid >> 3, cgp = tid & 7; asm volatile("" : "+v"(tok), "+v"(cgp));
            const float dtok = dec[h * 64 + tok], ed = __expf(dtok), edl = __expf(dec[h * 64 + 63] - dtok), be = bet[h * 64 + tok];
            u32x4 oq0, oq1, ok0, ok1, okb0, okb1, ov0, ov1;
            u32x4 tp[2][4][2];
#define PREP_TAPS(set_, part_) _Pragma("unroll") for (int j_ = 0; j_ < 4; ++j_) { const int col_ = (part_) * 1024 + h * 128 + cgp * 16, srow_ = tok - 3 + j_, pos_ = ck * 64 + srow_; \
                tp[set_][j_][0] = (u32x4){0u, 0u, 0u, 0u}; tp[set_][j_][1] = tp[set_][j_][0]; \
                if (pos_ >= 0) { const u16* p_ = (srow_ < 0) ? halo + ((size_t)((b * 32 + ck - 1) * 3 + 3 + srow_)) * 3072 + col_ : z + (size_t)(R0 + srow_) * ZLD + col_; \
                    tp[set_][j_][0] = *(const u32x4*)p_; tp[set_][j_][1] = *(const u32x4*)(p_ + 8); } }
            PREP_TAPS(0, 0);
#pragma unroll
            for (int part = 0; part < 3; ++part) {
                const int col = part * 1024 + h * 128 + cgp * 16;
                if (part < 2) { PREP_TAPS((part + 1) & 1, part + 1); }
                float v[16];
#pragma unroll
                for (int c = 0; c < 16; ++c) v[c] = 0.f;
#pragma unroll
                for (int j = 0; j < 4; ++j) {
                    const u32x4 x0 = tp[part & 1][j][0], x1 = tp[part & 1][j][1];
                    const float* wp = cw + j * 3072 + col;
                    const f32x4 w0 = *(const f32x4*)wp, w1 = *(const f32x4*)(wp + 4), w2 = *(const f32x4*)(wp + 8), w3 = *(const f32x4*)(wp + 12);
                    v[0] += w0[0] * bflo(x0.x); v[1] += w0[1] * bfhi(x0.x); v[2] += w0[2] * bflo(x0.y); v[3] += w0[3] * bfhi(x0.y);
                    v[4] += w1[0] * bflo(x0.z); v[5] += w1[1] * bfhi(x0.z); v[6] += w1[2] * bflo(x0.w); v[7] += w1[3] * bfhi(x0.w);
                    v[8] += w2[0] * bflo(x1.x); v[9] += w2[1] * bfhi(x1.x); v[10] += w2[2] * bflo(x1.y); v[11] += w2[3] * bfhi(x1.y);
                    v[12] += w3[0] * bflo(x1.z); v[13] += w3[1] * bfhi(x1.z); v[14] += w3[2] * bflo(x1.w); v[15] += w3[3] * bfhi(x1.w);
                }
                float ss = 0.f;
#pragma unroll
                for (int c = 0; c < 16; ++c) { v[c] = silu(v[c]); ss += v[c] * v[c]; }
                if (part < 2) {
                    ss += __shfl_xor(ss, 1); ss += __shfl_xor(ss, 2); ss += __shfl_xor(ss, 4);
                    const float sc = rsqrtf(ss + EPS) * (part == 0 ? 0.08838834764831845f : 1.f);
#pragma unroll
                    for (int c = 0; c < 16; ++c) v[c] *= sc;
                    LAS u16* dstl = (part == 0 ? qn : kn) + tok * 136 + cgp * 16;
                    *(LAS u32x4*)dstl = (u32x4){pack2(v[0], v[1]), pack2(v[2], v[3]), pack2(v[4], v[5]), pack2(v[6], v[7])};
                    *(LAS u32x4*)(dstl + 8) = (u32x4){pack2(v[8], v[9]), pack2(v[10], v[11]), pack2(v[12], v[13]), pack2(v[14], v[15])};
                }
                if (part == 0) {
                    oq0 = (u32x4){pack2(v[0] * ed, v[1] * ed), pack2(v[2] * ed, v[3] * ed), pack2(v[4] * ed, v[5] * ed), pack2(v[6] * ed, v[7] * ed)};
                    oq1 = (u32x4){pack2(v[8] * ed, v[9] * ed), pack2(v[10] * ed, v[11] * ed), pack2(v[12] * ed, v[13] * ed), pack2(v[14] * ed, v[15] * ed)};
                } else if (part == 1) {
                    ok0 = (u32x4){pack2(v[0] * edl, v[1] * edl), pack2(v[2] * edl, v[3] * edl), pack2(v[4] * edl, v[5] * edl), pack2(v[6] * edl, v[7] * edl)};
                    ok1 = (u32x4){pack2(v[8] * edl, v[9] * edl), pack2(v[10] * edl, v[11] * edl), pack2(v[12] * edl, v[13] * edl), pack2(v[14] * edl, v[15] * edl)};
                    const float kb = be * ed;
                    okb0 = (u32x4){pack2(v[0] * kb, v[1] * kb), pack2(v[2] * kb, v[3] * kb), pack2(v[4] * kb, v[5] * kb), pack2(v[6] * kb, v[7] * kb)};
                    okb1 = (u32x4){pack2(v[8] * kb, v[9] * kb), pack2(v[10] * kb, v[11] * kb), pack2(v[12] * kb, v[13] * kb), pack2(v[14] * kb, v[15] * kb)};
                } else {
                    ov0 = (u32x4){pack2(v[0] * be, v[1] * be), pack2(v[2] * be, v[3] * be), pack2(v[4] * be, v[5] * be), pack2(v[6] * be, v[7] * be)};
                    ov1 = (u32x4){pack2(v[8] * be, v[9] * be), pack2(v[10] * be, v[11] * be), pack2(v[12] * be, v[13] * be), pack2(v[14] * be, v[15] * be)};
                }
            }
            __syncthreads();
            {
                u16* zr = z + (size_t)(R0 + tok) * ZLD + h * 128 + cgp * 16;
                *(u32x4*)(zr + ZQ) = oq0; *(u32x4*)(zr + ZQ + 8) = oq1;
                *(u32x4*)(zr + ZK) = ok0; *(u32x4*)(zr + ZK + 8) = ok1;
                *(u32x4*)(zr + ZV) = ov0; *(u32x4*)(zr + ZV + 8) = ov1;
                u16* wr_ = wbuf + ((size_t)(item * 8 + h) * 64 + tok) * 128 + cgp * 16;
                *(u32x4*)wr_ = okb0; *(u32x4*)(wr_ + 8) = okb1;
            }
            {
                const int which = wid >> 2, mi = wid & 3;
                LAS u16* As = which ? qn : kn;
                f32x4 acc[4];
#pragma unroll
                for (int ni = 0; ni < 4; ++ni) acc[ni] = zero4();
#pragma unroll
                for (int ks = 0; ks < 4; ++ks) {
                    const bf16x8 af = *(LAS bf16x8*)(As + (16 * mi + r16) * 136 + ks * 32 + g * 8);
#pragma unroll
                    for (int ni = 0; ni < 4; ++ni) acc[ni] = MFMA16(af, *(LAS bf16x8*)(kn + (16 * ni + r16) * 136 + ks * 32 + g * 8), acc[ni]);
                }
#pragma unroll
                for (int ni = 0; ni < 4; ++ni)
#pragma unroll
                    for (int i = 0; i < 4; ++i) {
                        const int ti = 16 * mi + 4 * g + i, tj = 16 * ni + r16;
                        const float e = (ti >= tj) ? __expf(dec[h * 64 + ti] - dec[h * 64 + tj]) : 0.f;
                        if (which == 0) Mbuf[((size_t)(item * 8 + h) * 64 + ti) * 64 + tj] = (ti > tj) ? bet[h * 64 + ti] * acc[ni][i] * e : 0.f;
                        else abuf[((size_t)(item * 8 + h) * 64 + ti) * 64 + tj] = f2bf(acc[ni][i] * e);
                    }
            }
            asm volatile("s_waitcnt lgkmcnt(0)\n\ts_barrier" ::: "memory");
        }
        __syncthreads();
        {
            const int h = wid;
            LAS float* Ml = (LAS float*)(lds + 4096 + wid * 17408);
            const float* Mg = Mbuf + (size_t)(item * 8 + h) * 4096;
#pragma unroll
            for (int it = 0; it < 16; ++it) { const int idx = it * 64 + lane; *(LAS f32x4*)(Ml + (idx >> 4) * 68 + (idx & 15) * 4) = *(const f32x4*)(Mg + idx * 4); }
            {
                float t[64];
                t[0] = (lane == 0) ? 1.f : 0.f;
#pragma unroll
                for (int i = 1; i < 64; ++i) {
                    float s = (lane == i) ? 1.f : 0.f;
#pragma unroll
                    for (int j4 = 0; j4 < i; j4 += 4) {
                        const f32x4 m = *(LAS f32x4*)(Ml + i * 68 + j4);
                        s -= m[0] * t[j4];
                        if (j4 + 1 < i) s -= m[1] * t[j4 + 1];
                        if (j4 + 2 < i) s -= m[2] * t[j4 + 2];
                        if (j4 + 3 < i) s -= m[3] * t[j4 + 3];
                    }
                    t[i] = s;
                }
#pragma unroll
                for (int i = 0; i < 64; ++i) Ml[i * 68 + lane] = t[i];
            }
            bf16x8 at[4][2];
#pragma unroll
            for (int mt = 0; mt < 4; ++mt)
#pragma unroll
                for (int ks = 0; ks < 2; ++ks) {
                    const f32x4 t0 = *(LAS f32x4*)(Ml + (16 * mt + r16) * 68 + ks * 32 + g * 8), t1 = *(LAS f32x4*)(Ml + (16 * mt + r16) * 68 + ks * 32 + g * 8 + 4);
                    const u32x4 pk = pack8(t0, t1);
                    at[mt][ks] = __builtin_bit_cast(bf16x8, pk);
                }
#pragma unroll 1
            for (int pass = 0; pass < 2; ++pass) {
                u16* base = pass == 0 ? z + (size_t)R0 * ZLD + ZV + h * 128 : wbuf + (size_t)(item * 8 + h) * 64 * 128;
                const unsigned ld = pass == 0 ? ZLD : 128;
                const unsigned o0 = (unsigned)(g * 8) * ld + r16, o1 = o0 + 32u * ld, os = (unsigned)(4 * g) * ld + r16;
#pragma unroll 1
                for (int nh = 0; nh < 8; nh += 2) {
                    bf16x8 bb[2][2];
#pragma unroll
                    for (int nt = 0; nt < 2; ++nt)
#pragma unroll
                        for (int j = 0; j < 8; ++j) { bb[nt][0][j] = (short)base[(nh + nt) * 16 + o0 + j * ld]; bb[nt][1][j] = (short)base[(nh + nt) * 16 + o1 + j * ld]; }
#pragma unroll
                    for (int nt = 0; nt < 2; ++nt) {
                        f32x4 c[4];
#pragma unroll
                        for (int mt = 0; mt < 4; ++mt) { c[mt] = MFMA16(at[mt][0], bb[nt][0], zero4()); c[mt] = MFMA16(at[mt][1], bb[nt][1], c[mt]); }
#pragma unroll
                        for (int mt = 0; mt < 4; ++mt)
#pragma unroll
                            for (int i = 0; i < 4; ++i) base[(nh + nt) * 16 + os + (16 * mt + i) * ld] = f2bf(c[mt][i]);
                    }
                }
            }
        }
        __syncthreads();
    }
}

DI bf16x8 frag_perm(LAS u16* p) {
    const u32x2 lo = *(LAS u32x2*)p, hi = *(LAS u32x2*)(p + 16);
    const u32x4 v = (u32x4){lo.x, lo.y, hi.x, hi.y};
    return __builtin_bit_cast(bf16x8, v);
}
DI bf16x8 pack_pair(const f32x4 a, const f32x4 b) { const u32x4 v = (u32x4){pack2(a[0], a[1]), pack2(a[2], a[3]), pack2(b[0], b[1]), pack2(b[2], b[3])}; return __builtin_bit_cast(bf16x8, v); }
DI void phase_scan(const Args& a, LAS unsigned char* lds, int s) {
    const int tid = otid(), lane = tid & 63, wid = tid >> 6, r16 = lane & 15, g = lane >> 4;
    const int b = s >> 3, h = s & 7;
    u16* z = (u16*)(a.ws + WS_Z);
    const u16* wbuf = (const u16*)(a.ws + WS_H);
    const u16* abuf = (const u16*)(a.ws + WS_RA);
    const float* lastbuf = (const float*)(a.ws + WS_LAST);
    LAS u16* Wl = (LAS u16*)lds;
    LAS u16* Ql = Wl + 64 * 136;
    LAS u16* Al = Ql + 64 * 136;
    LAS u16* KT = Al + 64 * 72;
    LAS u16* Ul = KT + 128 * 72;
    LAS u16* Ol = Ul + 64 * 136;
    if (wid >= 4) {
        const int lt = tid - 256;
        const int t0 = lt >> 4, c80 = (lt & 15) * 8;
        const int pc = (c80 & ~31) + 8 * ((c80 >> 2) & 3) + 4 * ((c80 >> 4) & 1);
        const int ta = lt >> 3, ca = (lt & 7) * 8;
        const int pca = (ca & ~31) + 8 * ((ca >> 2) & 3) + 4 * ((ca >> 4) & 1);
        const int tk = lt & 63, dg = lt >> 6;
        const int ptk = (tk & ~31) + 8 * ((tk >> 2) & 3) + 4 * ((tk >> 4) & 1) + (tk & 3);
        const f32x4 ow0 = *(const f32x4*)(a.in[17] + c80), ow1 = *(const f32x4*)(a.in[17] + c80 + 4);
        u32x4 pw[4], pq[4], pu[4], pg[4], pk[4], pa[2], gc[4];
#define SCAN_LOAD(n_) do { const int R0_ = b * 2048 + (n_) * 64; const size_t ci_ = (size_t)((b * 32 + (n_)) * 8 + h); \
            _Pragma("unroll") for (int i_ = 0; i_ < 4; ++i_) { const int tr_ = t0 + 16 * i_; \
                pw[i_] = *(const u32x4*)(wbuf + ci_ * 8192 + tr_ * 128 + c80); \
                const u16* zz_ = z + (size_t)(R0_ + tr_) * ZLD + h * 128 + c80; \
                pq[i_] = *(const u32x4*)(zz_ + ZQ); pu[i_] = *(const u32x4*)(zz_ + ZV); pg[i_] = *(const u32x4*)(zz_ + ZG); \
                pk[i_] = *(const u32x4*)(z + (size_t)(R0_ + tk) * ZLD + ZK + h * 128 + (dg + 4 * i_) * 8); } \
            _Pragma("unroll") for (int i_ = 0; i_ < 2; ++i_) pa[i_] = *(const u32x4*)(abuf + ci_ * 4096 + (ta + 32 * i_) * 64 + ca); } while (0)
        SCAN_LOAD(0);
#pragma unroll 1
        for (int n = 0; n < 32; ++n) {
            const int R0 = b * 2048 + n * 64;
#pragma unroll
            for (int i = 0; i < 4; ++i) {
                const int tr = t0 + 16 * i;
                *(LAS u32x2*)(Wl + tr * 136 + pc) = (u32x2){pw[i].x, pw[i].y}; *(LAS u32x2*)(Wl + tr * 136 + pc + 8) = (u32x2){pw[i].z, pw[i].w};
                *(LAS u32x2*)(Ql + tr * 136 + pc) = (u32x2){pq[i].x, pq[i].y}; *(LAS u32x2*)(Ql + tr * 136 + pc + 8) = (u32x2){pq[i].z, pq[i].w};
                *(LAS u32x4*)(Ul + tr * 136 + c80) = pu[i];
                gc[i] = pg[i];
                const unsigned e[4] = {pk[i].x, pk[i].y, pk[i].z, pk[i].w};
                const int d0 = (dg + 4 * i) * 8;
#pragma unroll
                for (int j = 0; j < 4; ++j) { KT[(d0 + 2 * j) * 72 + ptk] = (u16)(e[j] & 0xFFFFu); KT[(d0 + 2 * j + 1) * 72 + ptk] = (u16)(e[j] >> 16); }
            }
#pragma unroll
            for (int i = 0; i < 2; ++i) { *(LAS u32x2*)(Al + (ta + 32 * i) * 72 + pca) = (u32x2){pa[i].x, pa[i].y}; *(LAS u32x2*)(Al + (ta + 32 * i) * 72 + pca + 8) = (u32x2){pa[i].z, pa[i].w}; }
            __syncthreads();
            if (n + 1 < 32) SCAN_LOAD(n + 1);
            asm volatile("s_waitcnt lgkmcnt(0)\n\ts_barrier" ::: "memory");
#pragma unroll
            for (int i = 0; i < 4; ++i) {
                const int tok = t0 + 16 * i;
                const u32x4 ov = *(LAS u32x4*)(Ol + tok * 136 + c80);
                const float q2 = bflo(ov.x) * bflo(ov.x) + bfhi(ov.x) * bfhi(ov.x) + bflo(ov.y) * bflo(ov.y) + bfhi(ov.y) * bfhi(ov.y) + bflo(ov.z) * bflo(ov.z) + bfhi(ov.z) * bfhi(ov.z) + bflo(ov.w) * bflo(ov.w) + bfhi(ov.w) * bfhi(ov.w);
                const float rstd = rsqrtf(row_sum16(q2) * (1.f / 128.f) + EPS);
                const u32x4 gv = gc[i];
                u32x4 r;
                r.x = pack2(bflo(ov.x) * rstd * ow0[0] * bflo(gv.x), bfhi(ov.x) * rstd * ow0[1] * bfhi(gv.x));
                r.y = pack2(bflo(ov.y) * rstd * ow0[2] * bflo(gv.y), bfhi(ov.y) * rstd * ow0[3] * bfhi(gv.y));
                r.z = pack2(bflo(ov.z) * rstd * ow1[0] * bflo(gv.z), bfhi(ov.z) * rstd * ow1[1] * bfhi(gv.z));
                r.w = pack2(bflo(ov.w) * rstd * ow1[2] * bflo(gv.w), bfhi(ov.w) * rstd * ow1[3] * bfhi(gv.w));
                *(u32x4*)(z + (size_t)(R0 + tok) * ZLD + ZG + h * 128 + c80) = r;
            }
        }
#undef SCAN_LOAD
    } else {
        f32x4 st[2][8];
#pragma unroll
        for (int t = 0; t < 2; ++t)
#pragma unroll
            for (int nt = 0; nt < 8; ++nt) st[t][nt] = zero4();
        const int dv0 = 32 * wid + r16;
#define SB_ __builtin_amdgcn_sched_barrier(0)
#define LD_ROWS2(dst, base, m0) _Pragma("unroll") for (int q_ = 0; q_ < 2; ++q_) _Pragma("unroll") for (int ks_ = 0; ks_ < 4; ++ks_) dst[q_ * 4 + ks_] = *(LAS bf16x8*)(base + (16 * ((m0) + q_) + r16) * 136 + ks_ * 32 + 8 * g)
#define LD_ROWS4(dst, base, m0) _Pragma("unroll") for (int q_ = 0; q_ < 4; ++q_) _Pragma("unroll") for (int ks_ = 0; ks_ < 2; ++ks_) dst[q_ * 2 + ks_] = *(LAS bf16x8*)(base + (16 * ((m0) + q_) + r16) * 72 + ks_ * 32 + 8 * g)
#pragma unroll 1
        for (int n = 0; n < 32; ++n) {
            const float last = lastbuf[(b * 32 + n) * 8 + h];
            bf16x8 sb[2][4];
#pragma unroll
            for (int t = 0; t < 2; ++t)
#pragma unroll
                for (int ks = 0; ks < 4; ++ks) sb[t][ks] = pack_pair(st[t][2 * ks], st[t][2 * ks + 1]);
            __syncthreads();
            bf16x8 fa[8], fb[8];
            f32x4 vn[2][4];
            LD_ROWS2(fa, Wl, 0); LD_ROWS2(fb, Wl, 2);
            SB_;
#pragma unroll
            for (int half = 0; half < 2; ++half) {
#pragma unroll
                for (int q = 0; q < 2; ++q) {
                    const int mt = 2 * half + q;
#pragma unroll
                    for (int t = 0; t < 2; ++t) {
                        f32x4 c = zero4();
#pragma unroll
                        for (int ks = 0; ks < 4; ++ks) c = MFMA16(half ? fb[q * 4 + ks] : fa[q * 4 + ks], sb[t][ks], c);
                        LAS u16* up = Ul + (16 * mt + 4 * g) * 136 + dv0 + 16 * t;
                        vn[t][mt] = (f32x4){bf2f(up[0]) - c[0], bf2f(up[136]) - c[1], bf2f(up[272]) - c[2], bf2f(up[408]) - c[3]};
                    }
                }
                if (half == 0) { SB_; LD_ROWS4(fa, KT, 0); SB_; }
            }
            bf16x8 vb[2][2];
#pragma unroll
            for (int t = 0; t < 2; ++t)
#pragma unroll
                for (int ks = 0; ks < 2; ++ks) vb[t][ks] = pack_pair(vn[t][2 * ks], vn[t][2 * ks + 1]);
            SB_;
            LD_ROWS4(fb, KT, 4);
            SB_;
#pragma unroll
            for (int half = 0; half < 2; ++half) {
#pragma unroll
                for (int q = 0; q < 4; ++q)
#pragma unroll
                    for (int t = 0; t < 2; ++t) {
                        f32x4 c = st[t][4 * half + q] * last;
#pragma unroll
                        for (int ks = 0; ks < 2; ++ks) c = MFMA16(half ? fb[q * 2 + ks] : fa[q * 2 + ks], vb[t][ks], c);
                        st[t][4 * half + q] = c;
                    }
                if (half == 0) { SB_; LD_ROWS2(fa, Ql, 0); SB_; } else { SB_; LD_ROWS2(fb, Ql, 2); SB_; }
            }
            f32x4 oa[2][4];
#pragma unroll
            for (int half = 0; half < 2; ++half) {
#pragma unroll
                for (int q = 0; q < 2; ++q)
#pragma unroll
                    for (int t = 0; t < 2; ++t) {
                        f32x4 c = zero4();
#pragma unroll
                        for (int ks = 0; ks < 4; ++ks) c = MFMA16(half ? fb[q * 4 + ks] : fa[q * 4 + ks], sb[t][ks], c);
                        oa[t][2 * half + q] = c;
                    }
                if (half == 0) { SB_; LD_ROWS4(fa, Al, 0); SB_; }
            }
            SB_;
#pragma unroll
            for (int mt = 0; mt < 4; ++mt)
#pragma unroll
                for (int t = 0; t < 2; ++t) {
                    f32x4 c = oa[t][mt];
#pragma unroll
                    for (int ks = 0; ks < 2; ++ks) c = MFMA16(fa[mt * 2 + ks], vb[t][ks], c);
                    const unsigned w0 = pack2(c[0], c[1]), w1 = pack2(c[2], c[3]);
                    LAS u16* op = Ol + (16 * mt + 4 * g) * 136 + dv0 + 16 * t;
                    op[0] = (u16)(w0 & 0xFFFFu); op[136] = (u16)(w0 >> 16); op[272] = (u16)(w1 & 0xFFFFu); op[408] = (u16)(w1 >> 16);
                }
            __syncthreads();
        }
#undef SB_
#undef LD_ROWS2
#undef LD_ROWS4
        float* So = a.out + OFF_GSP + (size_t)(b * 8 + h) * 16384;
#pragma unroll
        for (int t = 0; t < 2; ++t)
#pragma unroll
            for (int nt = 0; nt < 8; ++nt)
#pragma unroll
                for (int i = 0; i < 4; ++i) So[(size_t)(16 * nt + 4 * g + i) * 128 + dv0 + 16 * t] = st[t][nt][i];
    }
}

DI void swa_prompt_item(const Args& a, LAS unsigned char* lds, int it) {
    const int tid = otid(), lane = tid & 63, wid = tid >> 6, r16 = lane & 15, g = lane >> 4;
    const int b = it >> 6, kvh = (it >> 4) & 3, n = it & 15;
    u16* z = (u16*)(a.ws + WS_Z);
    LAS u16* Kl = (LAS u16*)lds;
    LAS u16* VTl = Kl + 256 * 72;
    LAS u16* Pl = VTl + 64 * 280 + wid * (16 * 168);
    const int gq = wid >> 1, th = wid & 1, qh = kvh * 4 + gq;
    bf16x8 qfa[4][2];
#pragma unroll
    for (int mtl = 0; mtl < 4; ++mtl)
#pragma unroll
        for (int ks = 0; ks < 2; ++ks) qfa[mtl][ks] = *(const bf16x8*)(z + ((size_t)(b * 2048 + n * 128 + 16 * (th * 4 + mtl)) + r16) * ZLD + ZSQ + qh * 64 + ks * 32 + g * 8);
#pragma unroll
    for (int i = 0; i < 4; ++i) {
        const int p = tid + 512 * i, key = p & 255, d8 = (p >> 8) * 8, srow = (n - 1) * 128 + key;
        u32x4 kv = (u32x4){0u, 0u, 0u, 0u}, vv = kv;
        if (srow >= 0) { const u16* base = z + (size_t)(b * 2048 + srow) * ZLD + kvh * 64 + d8; kv = *(const u32x4*)(base + ZSK); vv = *(const u32x4*)(base + ZSV); }
        *(LAS u32x4*)(Kl + key * 72 + d8) = kv;
        const unsigned e[4] = {vv.x, vv.y, vv.z, vv.w};
#pragma unroll
        for (int j = 0; j < 4; ++j) { VTl[(d8 + 2 * j) * 280 + key] = (u16)(e[j] & 0xFFFFu); VTl[(d8 + 2 * j + 1) * 280 + key] = (u16)(e[j] >> 16); }
    }
    for (int idx = tid; idx < 1536; idx += 512) { const int d = idx / 24; VTl[d * 280 + 256 + (idx - d * 24)] = 0; }
    __syncthreads();
    const float sink = a.in[19][qh];
#pragma unroll
    for (int mtl = 0; mtl < 4; ++mtl) {
        const int mt = th * 4 + mtl, tq0 = 16 * mt;
        const size_t rowA = (size_t)(b * 2048 + n * 128 + tq0);
        const bf16x8 qf[2] = {qfa[mtl][0], qfa[mtl][1]};
        f32x4 sc[9];
#pragma unroll
        for (int j = 0; j < 9; ++j) {
            f32x4 c = zero4();
#pragma unroll
            for (int ks = 0; ks < 2; ++ks) c = MFMA16(qf[ks], *(LAS bf16x8*)(Kl + (16 * (mt + j) + r16) * 72 + ks * 32 + g * 8), c);
            sc[j] = c;
        }
        float mx[4], sm[4];
#pragma unroll
        for (int i = 0; i < 4; ++i) mx[i] = sink;
#pragma unroll
        for (int j = 0; j < 9; ++j)
#pragma unroll
            for (int i = 0; i < 4; ++i) {
                const int tq = tq0 + 4 * g + i, kk = 16 * (mt + j) + r16;
                const bool valid = (kk > tq) && (kk <= tq + 128) && (n > 0 || kk >= 128);
                const float sv = valid ? sc[j][i] * 0.125f : -1e30f;
                sc[j][i] = sv; mx[i] = fmaxf(mx[i], sv);
            }
#pragma unroll
        for (int i = 0; i < 4; ++i) {
            float m = mx[i];
            mx[i] = row_max16(m); sm[i] = 0.f;
        }
#pragma unroll
        for (int j = 0; j < 9; ++j)
#pragma unroll
            for (int i = 0; i < 4; ++i) {
                const float p = (sc[j][i] > -1e29f) ? __expf(sc[j][i] - mx[i]) : 0.f;
                sm[i] += p;
                Pl[(4 * g + i) * 168 + 16 * j + r16] = f2bf(p);
            }
#pragma unroll
        for (int i = 0; i < 4; ++i) {
            Pl[(4 * g + i) * 168 + 144 + r16] = 0;
            const float s = row_sum16(sm[i]);
            sm[i] = 1.f / (s + __expf(sink - mx[i]));
        }
        f32x4 o[4];
#pragma unroll
        for (int nd = 0; nd < 4; ++nd) o[nd] = zero4();
#pragma unroll
        for (int ks = 0; ks < 5; ++ks) {
            const bf16x8 pa = *(LAS bf16x8*)(Pl + r16 * 168 + ks * 32 + g * 8);
#pragma unroll
            for (int nd = 0; nd < 4; ++nd) o[nd] = MFMA16(pa, *(LAS bf16x8*)(VTl + (16 * nd + r16) * 280 + 16 * mt + ks * 32 + g * 8), o[nd]);
        }
#pragma unroll
        for (int nd = 0; nd < 4; ++nd)
#pragma unroll
            for (int i = 0; i < 4; ++i) z[(rowA + 4 * g + i) * ZLD + ZSQ + qh * 64 + 16 * nd + r16] = f2bf(o[nd][i] * sm[i]);
    }
    __syncthreads();
}

DI void swa_sample_item(const Args& a, LAS unsigned char* lds, int it) {
    const int tid = otid(), lane = tid & 63, wid = tid >> 6;
    const int b = it >> 2, kvh = it & 3;
    u16* zr = (u16*)(a.ws + WS_Z) + (size_t)(NP + b) * ZLD;
    LAS float* ql = (LAS float*)lds;
    LAS float* ps = ql + 256;
    LAS float* pl = ps + 2048;
    LAS float* red = pl + 512;
    LAS float* po = red + 16;
    const int key = tid & 127, qt = tid >> 7;
    f32x4 kv[4];
    if (key < 127) { const float* kp = a.in[6] + ((size_t)(b * 128 + key + 1) * 4 + kvh) * 64 + qt * 16;
#pragma unroll
        for (int i = 0; i < 4; ++i) kv[i] = *(const f32x4*)(kp + 4 * i);
    } else { const u16* kp = zr + ZSK + kvh * 64 + qt * 16;
#pragma unroll
        for (int i = 0; i < 4; ++i) kv[i] = (f32x4){bf2f(kp[4 * i]), bf2f(kp[4 * i + 1]), bf2f(kp[4 * i + 2]), bf2f(kp[4 * i + 3])};
    }
    const int d4 = (tid & 15) * 4, kg = tid >> 4;
    f32x4 vv[4];
#pragma unroll
    for (int i = 0; i < 4; ++i) {
        const int kx = 4 * kg + i;
        if (kx < 127) vv[i] = *(const f32x4*)(a.in[7] + ((size_t)(b * 128 + kx + 1) * 4 + kvh) * 64 + d4);
        else { const u16* vp = zr + ZSV + kvh * 64 + d4; vv[i] = (f32x4){bf2f(vp[0]), bf2f(vp[1]), bf2f(vp[2]), bf2f(vp[3])}; }
    }
    if (tid < 256) ql[tid] = bf2f(zr[ZSQ + kvh * 256 + tid]);
    __syncthreads();
#pragma unroll
    for (int gq = 0; gq < 4; ++gq) {
        float s = 0.f;
#pragma unroll
        for (int i = 0; i < 4; ++i) { const f32x4 q4 = *(LAS f32x4*)(ql + gq * 64 + qt * 16 + 4 * i); s += q4[0] * kv[i][0] + q4[1] * kv[i][1] + q4[2] * kv[i][2] + q4[3] * kv[i][3]; }
        ps[(qt * 4 + gq) * 128 + key] = s;
    }
    __syncthreads();
    const int gq = tid >> 7;
    const float s = 0.125f * (ps[(0 * 4 + gq) * 128 + key] + ps[(1 * 4 + gq) * 128 + key] + ps[(2 * 4 + gq) * 128 + key] + ps[(3 * 4 + gq) * 128 + key]);
    const float sink = a.in[19][kvh * 4 + gq];
    float m = row_max16(s); m = fmaxf(m, __shfl_xor(m, 16)); m = fmaxf(m, __shfl_xor(m, 32));
    if (lane == 0) red[wid] = m;
    __syncthreads();
    m = fmaxf(fmaxf(red[2 * gq], red[2 * gq + 1]), sink);
    const float p = __expf(s - m);
    float psum = row_sum16(p); psum += __shfl_xor(psum, 16); psum += __shfl_xor(psum, 32);
    if (lane == 0) red[8 + wid] = psum;
    __syncthreads();
    pl[gq * 128 + key] = p * __builtin_amdgcn_rcpf(red[8 + 2 * gq] + red[8 + 2 * gq + 1] + __expf(sink - m));
    __syncthreads();
#pragma unroll
    for (int g2 = 0; g2 < 4; ++g2) {
        const f32x4 pw = *(LAS f32x4*)(pl + g2 * 128 + 4 * kg);
        *(LAS f32x4*)(po + (kg * 4 + g2) * 64 + d4) = vv[0] * pw[0] + vv[1] * pw[1] + vv[2] * pw[2] + vv[3] * pw[3];
    }
    __syncthreads();
    if (tid < 256) {
        float o = 0.f;
#pragma unroll
        for (int k2 = 0; k2 < 32; ++k2) o += po[k2 * 256 + tid];
        zr[ZSQ + kvh * 256 + tid] = f2bf(o);
    }
    __syncthreads();
}

DI void gdn_sample_item(const Args& a, LAS unsigned char* lds, int it) {
    const int tid = otid(), lane = tid & 63, wid = tid >> 6;
    const int b = it >> 3, h = it & 7, row = NP + b;
    u16* zr = (u16*)(a.ws + WS_Z) + (size_t)row * ZLD;
    const float* zb = (const float*)(a.ws + WS_ZB) + (size_t)row * 16;
    const float* cw = a.in[14];
    LAS float* act = (LAS float*)lds;
    LAS float* nrm = act + 384;
    LAS float* pkl = act + 512;
    LAS float* pql = pkl + 2048;
    const int dv4 = (tid & 31) * 4, dk0 = tid >> 5;
    const float* S0 = a.in[4] + (size_t)(b * 8 + h) * 16384;
    f32x4 sd[8];
#pragma unroll
    for (int i = 0; i < 8; ++i) sd[i] = __builtin_nontemporal_load((const f32x4*)(S0 + (size_t)(dk0 + 16 * i) * 128 + dv4));
    if (tid < 384) {
        const int col = (tid >> 7) * 1024 + h * 128 + (tid & 127);
        float x = cw[3 * 3072 + col] * bf2f(zr[col]);
#pragma unroll
        for (int j = 0; j < 3; ++j) x += cw[j * 3072 + col] * a.in[5][((size_t)b * 3 + j) * 3072 + col];
        act[tid] = silu(x);
    }
    __syncthreads();
    if (wid < 3) {
        const int o0 = wid == 2 ? 0 : wid * 128, o1 = wid == 2 ? 128 : wid * 128;
        float ss = act[o0 + lane] * act[o1 + lane] + act[o0 + 64 + lane] * act[o1 + 64 + lane];
#pragma unroll
        for (int o = 1; o < 64; o <<= 1) ss += __shfl_xor(ss, o);
        if (lane == 0) nrm[wid] = ss;
    }
    __syncthreads();
    const float qs = rsqrtf(nrm[0] + EPS) * 0.08838834764831845f, ksc = rsqrtf(nrm[1] + EPS), qk = nrm[2] * qs * ksc;
    const float beta = sigm(zb[h]);
    const float eg = __expf(-__expf(a.in[15][h]) * softplus(zb[8 + h] + a.in[16][h]));
    float* S1 = a.out + OFF_GSS + (size_t)(b * 8 + h) * 16384;
    f32x4 pk = zero4(), pq = zero4();
#pragma unroll
    for (int i = 0; i < 8; ++i) {
        const int dk = dk0 + 16 * i;
        sd[i] = sd[i] * eg;
        pk += sd[i] * (act[128 + dk] * ksc); pq += sd[i] * (act[dk] * qs);
    }
    *(LAS f32x4*)(pkl + dk0 * 128 + dv4) = pk; *(LAS f32x4*)(pql + dk0 * 128 + dv4) = pq;
    __syncthreads();
    f32x4 ksum = zero4(), qsum = zero4();
#pragma unroll
    for (int r = 0; r < 16; ++r) { ksum += *(LAS f32x4*)(pkl + r * 128 + dv4); qsum += *(LAS f32x4*)(pql + r * 128 + dv4); }
    f32x4 delta;
#pragma unroll
    for (int c = 0; c < 4; ++c) delta[c] = (act[256 + dv4 + c] - ksum[c]) * beta;
#pragma unroll
    for (int i = 0; i < 8; ++i) { const int dk = dk0 + 16 * i; __builtin_nontemporal_store(sd[i] + delta * (act[128 + dk] * ksc), (f32x4*)(S1 + (size_t)dk * 128 + dv4)); }
    if (tid < 32) {
        const f32x4 o = qsum + delta * qk;
        float ss = o[0] * o[0] + o[1] * o[1] + o[2] * o[2] + o[3] * o[3];
#pragma unroll
        for (int m = 1; m < 32; m <<= 1) ss += __shfl_xor(ss, m);
        const float rstd = rsqrtf(ss * (1.f / 128.f) + EPS);
        u16* gp = zr + ZG + h * 128 + dv4;
        const u32x2 gv = *(const u32x2*)gp;
        const float g0 = bflo(gv.x), g1 = bfhi(gv.x), g2 = bflo(gv.y), g3 = bfhi(gv.y);
        const f32x4 w = *(const f32x4*)(a.in[17] + dv4);
        *(u32x2*)gp = (u32x2){pack2(o[0] * rstd * w[0] * g0, o[1] * rstd * w[1] * g1), pack2(o[2] * rstd * w[2] * g2, o[3] * rstd * w[3] * g3)};
    }
    __syncthreads();
}

DI void state_copies(const Args& a, int vt, int nvt) {
    const u16* z = (const u16*)(a.ws + WS_Z);
    const u16* halo = (const u16*)(a.ws + WS_HALO);
    float* out = a.out;
    for (int i = vt; i < 8 * 3 * 3072; i += nvt) { const int b = i / 9216, r = i - b * 9216; out[OFF_GCP + i] = bf2f(halo[(size_t)((b * 32 + 31) * 3) * 3072 + r]); }
    for (int i = vt; i < 128 * 3 * 3072; i += nvt) {
        const int b = i / 9216, r = i - b * 9216, j = r / 3072, c = r - j * 3072;
        out[OFF_GCS + i] = (j < 2) ? a.in[5][((size_t)b * 3 + j + 1) * 3072 + c] : bf2f(z[(size_t)(NP + b) * ZLD + c]);
    }
    for (int i = vt; i < 8 * 128 * 256; i += nvt) {
        const int b = i >> 15, w = (i >> 8) & 127, c = i & 255;
        const u16* zr = z + (size_t)(b * 2048 + 1920 + w) * ZLD;
        out[OFF_KP + i] = bf2f(zr[ZSK + c]); out[OFF_VP + i] = bf2f(zr[ZSV + c]);
    }
    for (int i = vt; i < 128 * 128 * 64; i += nvt) {
        const int b = i >> 13, w = (i >> 6) & 127, c = (i & 63) * 4;
        f32x4 kv, vv;
        if (w < 127) { const size_t o = ((size_t)b * 128 + w + 1) * 256 + c; kv = *(const f32x4*)(a.in[6] + o); vv = *(const f32x4*)(a.in[7] + o); }
        else { const u16* zr = z + (size_t)(NP + b) * ZLD;
            kv = (f32x4){bf2f(zr[ZSK + c]), bf2f(zr[ZSK + c + 1]), bf2f(zr[ZSK + c + 2]), bf2f(zr[ZSK + c + 3])};
            vv = (f32x4){bf2f(zr[ZSV + c]), bf2f(zr[ZSV + c + 1]), bf2f(zr[ZSV + c + 2]), bf2f(zr[ZSV + c + 3])}; }
        __builtin_nontemporal_store(kv, (f32x4*)(out + OFF_KS + (size_t)i * 4)); __builtin_nontemporal_store(vv, (f32x4*)(out + OFF_VS + (size_t)i * 4));
    }
}

__global__ void __launch_bounds__(512, 2) fwd_megakernel(Args a) {
    extern __shared__ __attribute__((aligned(16))) unsigned char smem[];
    LAS unsigned char* lds = (LAS unsigned char*)smem;
    cg::grid_group grid = cg::this_grid();
    if (a.ws == nullptr) grid.sync();
    { volatile LAS unsigned* st_ = (volatile LAS unsigned*)(lds + LDS_XB); if (threadIdx.x < 4) st_[threadIdx.x] = 0u; }
    __syncthreads();
    const XcdBarrier xbar = xcd_barrier_post((unsigned*)(a.ws + WS_BAR), (volatile LAS unsigned*)(lds + LDS_XB));
    u16* H = (u16*)(a.ws + WS_H);
    u16* Z = (u16*)(a.ws + WS_Z);
    phase0(a, lds);
    xcd_barrier(xbar);
    phase_norm<0>(a);
    xcd_barrier(xbar);
    { EpiZ e; e.z = Z; e.gab = (u16*)a.out; e.zb = (float*)(a.ws + WS_ZB); e.halo = (u16*)(a.ws + WS_HALO);
      run_gemm(lds, H, 1024, (const u16*)(a.ws + WS_RA), 1024, MP, N1, 1024, e); }
    xcd_barrier(xbar);
    phase_prep(a, lds);
    xcd_barrier(xbar);
    if (blockIdx.x < 64) {
        phase_scan(a, lds, blockIdx.x);
        __syncthreads();
    } else {
        const int v = blockIdx.x - 64, nv = gridDim.x - 64, v2 = (v + 64) % nv;
        if (gridDim.x == 256) {
            const int xcd = blockIdx.x & 7, j = v >> 3;
            for (int m = j; m < 64; m += 24) swa_prompt_item(a, lds, (xcd + 8 * (m >> 4)) * 16 + (m & 15));
        } else {
            for (int it = v; it < 512; it += nv) swa_prompt_item(a, lds, it);
        }
        for (int it = v2; it < 1024; it += nv) gdn_sample_item(a, lds, it);
        for (int it = v2; it < 512; it += nv) swa_sample_item(a, lds, it);
        state_copies(a, v * 512 + otid(), nv * 512);
    }
    xcd_barrier(xbar);
    skinny_phase<0>(a, lds);
    { EpiMixBoth e; e.e0.mix = H; e.e0.gab = (const u16*)a.out; e.e1.mix = H; e.e1.gab = (const u16*)a.out;
      pg8::Gemm g; g.A = Z + ZG; g.Bt = (const u16*)(a.ws + WS_WA); g.A2 = Z + ZSQ; g.Bt2 = (const u16*)(a.ws + WS_WB); g.M = NP; g.N = 1024; g.K = 1024; g.lda = ZLD; g.ldb = 1024;
      MixOrder S; S.base.init(NP, 1024, (int)gridDim.x, (int)blockIdx.x);
      pg8::gemm_phase<EpiMixBoth, MixOrder, false>((PG8_LAS unsigned char*)lds, g, S, e, nullptr); }
    xcd_barrier(xbar);
    { EpiRes<0> e; e.out = a.out; e.xp = a.in[0]; e.xs = a.in[1]; e.mod = (const float*)(a.ws + WS_MOD); e.xh = nullptr; skinny_phase<1>(a, lds);
      run_gemm(lds, H, 1024, (const u16*)(a.ws + WS_WO), 1024, NP, 1024, 1024, e); }
    xcd_barrier(xbar);
    phase_norm<1>(a);
    xcd_barrier(xbar);
    { EpiPlain e; e.o = Z; e.ld = FF; run_gemm(lds, H, 1024, (const u16*)(a.ws + WS_WG), 1024, MP, FF, 1024, e); }
    xcd_barrier(xbar);
    { EpiAct e; e.act = Z + (size_t)MP * FF; e.gate = Z; e.cw = a.in[24]; e.cb = a.in[25]; e.sf = a.in[8]; e.out = a.out;
      run_gemm(lds, H, 1024, (const u16*)(a.ws + WS_WU), 1024, MP, FF, 1024, e); }
    xcd_barrier(xbar);
    { EpiRes<1> e; e.out = a.out; e.xp = a.in[0]; e.xs = a.in[1]; e.mod = (const float*)(a.ws + WS_MOD); e.xh = H; skinny_phase<2>(a, lds);
      run_gemm(lds, Z + (size_t)MP * FF, FF, (const u16*)(a.ws + WS_WD), FF, NP, 1024, FF, e); }
    xcd_barrier(xbar);
    phase_final(a);
}

extern "C" void kernel_launch(void* const* d_in, const int* in_sizes, int n_in, void* d_out, int out_size, void* d_ws, size_t ws_size, hipStream_t stream) {
    static int grid = 0;
    if (grid == 0) {
        if (n_in != 28 || ws_size < WS_END) { fprintf(stderr, "kernel_launch: expected 28 inputs and >= %zu bytes of workspace (got %d, %zu)\n", (size_t)WS_END, n_in, ws_size); grid = -1; return; }
        int dev = 0, cus = 0, per_cu = 0;
        hipGetDevice(&dev);
        hipDeviceGetAttribute(&cus, hipDeviceAttributeMultiprocessorCount, dev);
        if (hipFuncSetAttribute((const void*)fwd_megakernel, hipFuncAttributeMaxDynamicSharedMemorySize, LDS_BYTES) != hipSuccess) { fprintf(stderr, "kernel_launch: hipFuncSetAttribute failed\n"); grid = -1; return; }
        hipOccupancyMaxActiveBlocksPerMultiprocessor(&per_cu, (const void*)fwd_megakernel, 512, LDS_BYTES);
        if (per_cu < 1) fprintf(stderr, "kernel_launch: occupancy query says %d blocks per CU\n", per_cu);
        (void)hipGetLastError();
        grid = cus;
    }
    if (grid < 0) return;
    if (hipMemsetAsync((char*)d_ws + WS_BAR, 0, 16384, stream) != hipSuccess) { fprintf(stderr, "kernel_launch: memset of the barrier words failed\n"); return; }
    Args a{};
    for (int i = 0; i < 28; ++i) a.in[i] = (const float*)d_in[i];
    a.out = (float*)d_out; a.ws = (unsigned char*)d_ws;
    void* args[] = {&a};
    hipError_t e = hipLaunchCooperativeKernel((const void*)fwd_megakernel, dim3(grid), dim3(512), args, LDS_BYTES, stream);
    if (e != hipSuccess) fprintf(stderr, "cooperative launch failed: %s (grid %d)\n", hipGetErrorString(e), grid);
}
```
